# Optimizing an MI355X kernel written in HIP

```python
import math
import numpy as np
import jax
import jax.numpy as jnp
from jax import lax

D_MODEL = 2048
BATCH = 8
SEQ = 4096
DEPTH = 2

CTX_LEN = 256
GRID_W = 64
HEAD_DIM = 128
Q_BLOCK = 128
ROPE_THETA = 10000.0
EPS = 1e-6
NEG_INF = -1e30

A_HEADS = 8
A_KV_HEADS = 2
A_WINDOW = 128
B_HEADS = 4
C_HEADS = 8
C_KV_HEADS = 2
D_HEADS = 8
NA_ROWS = 8
NA_COLS = 16

EVEN_SPLITS = (A_HEADS * HEAD_DIM, A_KV_HEADS * HEAD_DIM, A_KV_HEADS * HEAD_DIM,
               B_HEADS * 2 * HEAD_DIM, B_HEADS * 2 * HEAD_DIM, B_HEADS * 2 * HEAD_DIM)
ODD_SPLITS = (C_HEADS * HEAD_DIM, C_KV_HEADS * HEAD_DIM, C_KV_HEADS * HEAD_DIM,
              D_HEADS * HEAD_DIM, D_HEADS * HEAD_DIM, D_HEADS * HEAD_DIM)
IN_WIDTH = 4608
MIX_WIDTH = 2048

N_EXPERTS = 16
EC_CAPACITY_FACTOR = 2
D_EXPERT = 1536

kernel_name = 'hybrid_window_diff_axial_natten_ecmoe_dit'


def rmsnorm(x, g):
    xf = x.astype(jnp.float32)
    y = xf * lax.rsqrt(jnp.mean(xf * xf, axis=-1, keepdims=True) + EPS)
    return y.astype(x.dtype) * g


def axial_rope_tables(n, dtype):
    t = jnp.arange(n, dtype=jnp.int32)
    row = (t // GRID_W).astype(jnp.float32)
    col = (t % GRID_W).astype(jnp.float32)
    n_freq = HEAD_DIM // 4
    inv = ROPE_THETA ** (-jnp.arange(n_freq, dtype=jnp.float32) / n_freq)
    ar = row[:, None] * inv
    ac = col[:, None] * inv
    ang = jnp.concatenate([ar, ar, ac, ac], axis=-1)
    return jnp.cos(ang).astype(dtype), jnp.sin(ang).astype(dtype)


def apply_rope(x, cos, sin):
    nf = HEAD_DIM // 4
    xr = x.reshape(x.shape[:-1] + (2, 2, nf))
    rot = jnp.stack([-xr[..., 1, :], xr[..., 0, :]], axis=-2).reshape(x.shape)
    shp = (x.shape[1],) + (1,) * (x.ndim - 3) + (HEAD_DIM,)
    return x * cos.reshape(shp) + rot * sin.reshape(shp)


def split_cols(p, sizes):
    offsets = np.cumsum(np.array(sizes))[:-1].tolist()
    return jnp.split(p, offsets, axis=-1)


def sweep_query_blocks(fn, *qs):
    b, s = qs[0].shape[:2]
    nb = s // Q_BLOCK
    blocks = tuple(jnp.moveaxis(q.reshape((b, nb, Q_BLOCK) + q.shape[2:]), 1, 0) for q in qs)
    out = lax.map(lambda a: fn(*a[0], a[1]), (blocks, jnp.arange(nb)))
    return jnp.moveaxis(out, 0, 1).reshape((b, s) + out.shape[3:])


def attend(q, k, v, scale, sink=None, mask=None):
    s = jnp.einsum('bqgrd,bkgd->bgrqk', q, k).astype(jnp.float32) * scale
    if mask is not None:
        s = jnp.where(mask, s, NEG_INF)
    if sink is not None:
        sk = jnp.broadcast_to(sink.astype(jnp.float32)[None, :, :, None, None], s.shape[:-1] + (1,))
        p = jax.nn.softmax(jnp.concatenate([s, sk], axis=-1), axis=-1)[..., :-1]
    else:
        p = jax.nn.softmax(s, axis=-1)
    return jnp.einsum('bgrqk,bkgd->bqgrd', p.astype(v.dtype), v)


def diff_attend(q1, q2, k1, k2, v, lam, scale):
    p1 = jax.nn.softmax(jnp.einsum('bqhd,bkhd->bhqk', q1, k1).astype(jnp.float32) * scale, axis=-1)
    p2 = jax.nn.softmax(jnp.einsum('bqhd,bkhd->bhqk', q2, k2).astype(jnp.float32) * scale, axis=-1)
    p = p1 - lam * p2
    return jnp.einsum('bhqk,bkhe->bqhe', p.astype(v.dtype), v)


def window_attention(q, k, v, k_ctx, v_ctx, sink, scale):
    s = q.shape[1]
    band = Q_BLOCK + 2 * A_WINDOW
    pad = ((0, 0), (A_WINDOW, A_WINDOW), (0, 0), (0, 0))
    k_pad = jnp.pad(k, pad)
    v_pad = jnp.pad(v, pad)
    ctx_mask = jnp.ones((Q_BLOCK, k_ctx.shape[1]), dtype=bool)

    def block(qb, i):
        start = i * Q_BLOCK
        kb = lax.dynamic_slice_in_dim(k_pad, start, band, axis=1)
        vb = lax.dynamic_slice_in_dim(v_pad, start, band, axis=1)
        qpos = start + jnp.arange(Q_BLOCK)
        kpos = start - A_WINDOW + jnp.arange(band)
        in_band = ((jnp.abs(qpos[:, None] - kpos[None, :]) <= A_WINDOW)
                   & (kpos >= 0)[None, :] & (kpos < s)[None, :])
        mask = jnp.concatenate([ctx_mask, in_band], axis=1)
        return attend(qb, jnp.concatenate([k_ctx, kb], axis=1), jnp.concatenate([v_ctx, vb], axis=1),
                      scale, sink, mask)

    return sweep_query_blocks(block, q)


def neighbourhood_attention(q, k, v, k_ctx, v_ctx, rpb, scale):
    b, s, h, d = q.shape
    rows = s // GRID_W
    kh = min(NA_ROWS, rows)
    n_ctx = k_ctx.shape[1]
    qg = q.reshape(b, rows, GRID_W, h, d)
    kg = k.reshape(b, rows, GRID_W, h, d)
    vg = v.reshape(b, rows, GRID_W, h, d)
    col = jnp.arange(GRID_W)
    cs = jnp.clip(col - NA_COLS // 2, 0, GRID_W - NA_COLS)
    col_mask = (col[None, :] >= cs[:, None]) & (col[None, :] < cs[:, None] + NA_COLS)
    col_idx = jnp.clip(col[None, :] - col[:, None], -(NA_COLS - 1), NA_COLS - 1) + NA_COLS - 1
    rpb_c = rpb[:, :, col_idx]

    def row_block(args):
        q_row, r = args
        rs = jnp.clip(r - kh // 2, 0, rows - kh)
        kb = lax.dynamic_slice_in_dim(kg, rs, kh, axis=1)
        vb = lax.dynamic_slice_in_dim(vg, rs, kh, axis=1)
        sc = jnp.einsum('bqhd,bawhd->bhqaw', q_row, kb).astype(jnp.float32) * scale
        roff = rs + jnp.arange(kh) - r + NA_ROWS - 1
        bias = jnp.transpose(rpb_c[:, roff], (0, 2, 1, 3)).astype(jnp.float32)
        sc = jnp.where(col_mask[:, None, :], sc + bias[None], NEG_INF)
        sc = sc.reshape(b, h, GRID_W, kh * GRID_W)
        sx = jnp.einsum('bqhd,bkhd->bhqk', q_row, k_ctx).astype(jnp.float32) * scale
        p = jax.nn.softmax(jnp.concatenate([sx, sc], axis=-1), axis=-1).astype(v.dtype)
        px = p[..., :n_ctx]
        pb = p[..., n_ctx:].reshape(b, h, GRID_W, kh, GRID_W)
        return (jnp.einsum('bhqk,bkhd->bqhd', px, v_ctx)
                + jnp.einsum('bhqaw,bawhd->bqhd', pb, vb))

    out = lax.map(row_block, (jnp.moveaxis(qg, 1, 0), jnp.arange(rows)))
    return jnp.moveaxis(out, 0, 1).reshape(b, s, h, d)


def mixer_window_diff(p_lat, p_ctx, cos, sin, sink, lam_q1, lam_k1, lam_q2, lam_k2, subln_w, lam_init, need_ctx):
    b, s, _ = p_lat.shape
    scale = HEAD_DIM ** -0.5
    ra = A_HEADS // A_KV_HEADS

    def heads(p):
        n = p.shape[1]
        qa, ka, va, qb, kb, vb = split_cols(p, EVEN_SPLITS)
        return (qa.reshape(b, n, A_KV_HEADS, ra, HEAD_DIM),
                ka.reshape(b, n, A_KV_HEADS, HEAD_DIM),
                va.reshape(b, n, A_KV_HEADS, HEAD_DIM),
                qb.reshape(b, n, B_HEADS, 2, HEAD_DIM),
                kb.reshape(b, n, B_HEADS, 2, HEAD_DIM),
                vb.reshape(b, n, B_HEADS, 2 * HEAD_DIM))

    qa, ka, va, qb, kb, vb = heads(p_lat)
    qa_x, ka_x, va_x, qb_x, kb_x, vb_x = heads(p_ctx)
    qa, ka, qb, kb = (apply_rope(t, cos, sin) for t in (qa, ka, qb, kb))
    sink_gr = sink.reshape(A_KV_HEADS, ra)
    o_a = window_attention(qa, ka, va, ka_x, va_x, sink_gr, scale)
    lam = (jnp.exp(jnp.sum(lam_q1.astype(jnp.float32) * lam_k1.astype(jnp.float32)))
           - jnp.exp(jnp.sum(lam_q2.astype(jnp.float32) * lam_k2.astype(jnp.float32))) + lam_init)
    k1_all = jnp.concatenate([kb_x[..., 0, :], kb[..., 0, :]], axis=1)
    k2_all = jnp.concatenate([kb_x[..., 1, :], kb[..., 1, :]], axis=1)
    v_all = jnp.concatenate([vb_x, vb], axis=1)
    o_b = sweep_query_blocks(lambda q1, q2, i: diff_attend(q1, q2, k1_all, k2_all, v_all, lam, scale),
                             qb[..., 0, :], qb[..., 1, :])
    o_b = rmsnorm(o_b, subln_w) * (1.0 - lam_init)
    out_lat = jnp.concatenate([o_a.reshape(b, s, -1), o_b.reshape(b, s, -1)], axis=-1)
    if not need_ctx:
        return out_lat, None
    n = p_ctx.shape[1]
    oa_x = attend(qa_x, ka_x, va_x, scale, sink_gr)
    ob_x = diff_attend(qb_x[..., 0, :], qb_x[..., 1, :], kb_x[..., 0, :], kb_x[..., 1, :], vb_x, lam, scale)
    ob_x = rmsnorm(ob_x, subln_w) * (1.0 - lam_init)
    out_ctx = jnp.concatenate([oa_x.reshape(b, n, -1), ob_x.reshape(b, n, -1)], axis=-1)
    return out_lat, out_ctx


def mixer_axial_neighbourhood(p_lat, p_ctx, cos, sin, q_norm, k_norm, rpb, need_ctx):
    b, s, _ = p_lat.shape
    scale = HEAD_DIM ** -0.5
    rc = C_HEADS // C_KV_HEADS

    def heads(p):
        n = p.shape[1]
        cq, ck, cv, dq, dk, dv = split_cols(p, ODD_SPLITS)
        return (rmsnorm(cq.reshape(b, n, C_KV_HEADS, rc, HEAD_DIM), q_norm),
                rmsnorm(ck.reshape(b, n, C_KV_HEADS, HEAD_DIM), k_norm),
                cv.reshape(b, n, C_KV_HEADS, HEAD_DIM),
                dq.reshape(b, n, D_HEADS, HEAD_DIM),
                dk.reshape(b, n, D_HEADS, HEAD_DIM),
                dv.reshape(b, n, D_HEADS, HEAD_DIM))

    cq, ck, cv, dq, dk, dv = heads(p_lat)
    cq_x, ck_x, cv_x, dq_x, dk_x, dv_x = heads(p_ctx)
    cq = apply_rope(cq, cos, sin)
    ck = apply_rope(ck, cos, sin)
    k_all = jnp.concatenate([ck_x, ck], axis=1)
    v_all = jnp.concatenate([cv_x, cv], axis=1)
    o_c = sweep_query_blocks(lambda q, i: attend(q, k_all, v_all, scale), cq)
    o_d = neighbourhood_attention(dq, dk, dv, dk_x, dv_x, rpb, scale)
    out_lat = jnp.concatenate([o_c.reshape(b, s, -1), o_d.reshape(b, s, -1)], axis=-1)
    if not need_ctx:
        return out_lat, None
    n = p_ctx.shape[1]
    oc_x = attend(cq_x, ck_x, cv_x, scale)
    od_x = attend(dq_x[:, :, :, None, :], dk_x, dv_x, scale)
    out_ctx = jnp.concatenate([oc_x.reshape(b, n, -1), od_x.reshape(b, n, -1)], axis=-1)
    return out_lat, out_ctx


def expert_choice_ffn(h, w_router, w_gate, w_up, w_down):
    b, n, _ = h.shape
    cap = max(1, EC_CAPACITY_FACTOR * n // N_EXPERTS)
    aff = jax.nn.softmax((h @ w_router).astype(jnp.float32), axis=-1)
    gate, idx = lax.top_k(jnp.swapaxes(aff, 1, 2), cap)
    bidx = jnp.arange(b)[:, None, None]
    xe = h[bidx, idx]
    hid = (jax.nn.silu(jnp.einsum('becd,edf->becf', xe, w_gate))
           * jnp.einsum('becd,edf->becf', xe, w_up))
    ye = jnp.einsum('becf,efd->becd', hid, w_down) * gate[..., None].astype(h.dtype)
    return jnp.zeros_like(h).at[bidx, idx].add(ye)


def lambda_init_for(layer):
    return 0.8 - 0.6 * math.exp(-0.3 * layer)


def setup_inputs(seed: int = 0) -> dict:
    key = jax.random.key(seed)
    ks = jax.random.split(key, 24)
    n_even = (DEPTH + 1) // 2
    n_odd = DEPTH // 2
    d = D_MODEL

    def nrm(k, shape, scale):
        return jax.random.normal(k, shape, jnp.float32) * scale

    return {
        'x': nrm(ks[0], (BATCH, SEQ, d), 1.0),
        'c': nrm(ks[1], (BATCH, d), 1.0),
        'ctx': nrm(ks[2], (BATCH, CTX_LEN, d), 1.0),
        'c_ctx': nrm(ks[3], (d,), 1.0),
        'w_ada': nrm(ks[4], (DEPTH, d, 6 * d), 0.5 * d ** -0.5),
        'b_ada': nrm(ks[5], (DEPTH, 6 * d), 0.01),
        'g_mix': 1.0 + nrm(ks[6], (DEPTH, d), 0.05),
        'g_ffn': 1.0 + nrm(ks[7], (DEPTH, d), 0.05),
        'w_in': nrm(ks[8], (DEPTH, d, IN_WIDTH), d ** -0.5),
        'w_out': nrm(ks[9], (DEPTH, MIX_WIDTH, d), MIX_WIDTH ** -0.5),
        'a_sink': nrm(ks[10], (n_even, A_HEADS), 0.5),
        'b_lam_q1': nrm(ks[11], (n_even, HEAD_DIM), 0.1),
        'b_lam_k1': nrm(ks[12], (n_even, HEAD_DIM), 0.1),
        'b_lam_q2': nrm(ks[13], (n_even, HEAD_DIM), 0.1),
        'b_lam_k2': nrm(ks[14], (n_even, HEAD_DIM), 0.1),
        'b_subln': 1.0 + nrm(ks[15], (n_even, 2 * HEAD_DIM), 0.05),
        'c_q_norm': 1.0 + nrm(ks[16], (n_odd, HEAD_DIM), 0.05),
        'c_k_norm': 1.0 + nrm(ks[17], (n_odd, HEAD_DIM), 0.05),
        'd_rpb': nrm(ks[18], (n_odd, D_HEADS, 2 * NA_ROWS - 1, 2 * NA_COLS - 1), 0.1),
        'w_router': nrm(ks[19], (DEPTH, d, N_EXPERTS), d ** -0.5),
        'w_gate': nrm(ks[20], (DEPTH, N_EXPERTS, d, D_EXPERT), d ** -0.5),
        'w_up': nrm(ks[21], (DEPTH, N_EXPERTS, d, D_EXPERT), d ** -0.5),
        'w_down': nrm(ks[22], (DEPTH, N_EXPERTS, D_EXPERT, d), D_EXPERT ** -0.5),
        'g_final': 1.0 + nrm(ks[23], (d,), 0.05),
    }


def reference(x, c, ctx, c_ctx, w_ada, b_ada, g_mix, g_ffn, w_in, w_out, a_sink,
              b_lam_q1, b_lam_k1, b_lam_q2, b_lam_k2, b_subln, c_q_norm, c_k_norm, d_rpb,
              w_router, w_gate, w_up, w_down, g_final):
    s = x.shape[1]
    cos, sin = axial_rope_tables(s, x.dtype)
    cond = jax.nn.silu(c)
    cond_x = jax.nn.silu(c_ctx)
    xc = ctx
    for l in range(DEPTH):
        need_ctx = l < DEPTH - 1
        e = l // 2
        mod = (cond @ w_ada[l] + b_ada[l])[:, None, :]
        mod_x = cond_x @ w_ada[l] + b_ada[l]
        sh1, sc1, gt1, sh2, sc2, gt2 = jnp.split(mod, 6, axis=-1)
        sh1x, sc1x, gt1x, sh2x, sc2x, gt2x = jnp.split(mod_x, 6, axis=-1)
        p = (rmsnorm(x, g_mix[l]) * (1 + sc1) + sh1) @ w_in[l]
        px = (rmsnorm(xc, g_mix[l]) * (1 + sc1x) + sh1x) @ w_in[l]
        if l % 2 == 0:
            o, ox = mixer_window_diff(p, px, cos, sin, a_sink[e], b_lam_q1[e], b_lam_k1[e],
                                      b_lam_q2[e], b_lam_k2[e], b_subln[e], lambda_init_for(l), need_ctx)
        else:
            o, ox = mixer_axial_neighbourhood(p, px, cos, sin, c_q_norm[e], c_k_norm[e], d_rpb[e], need_ctx)
        x = x + gt1 * (o @ w_out[l])
        h = rmsnorm(x, g_ffn[l]) * (1 + sc2) + sh2
        x = x + gt2 * expert_choice_ffn(h, w_router[l], w_gate[l], w_up[l], w_down[l])
        if need_ctx:
            xc = xc + gt1x * (ox @ w_out[l])
            hx = rmsnorm(xc, g_ffn[l]) * (1 + sc2x) + sh2x
            xc = xc + gt2x * expert_choice_ffn(hx, w_router[l], w_gate[l], w_up[l], w_down[l])
    return rmsnorm(x, g_final)
```

```cpp
#include <hip/hip_runtime.h>
#include <cstdio>
#include <cstdint>
#include <type_traits>

#ifndef MK_MULTI
#define MK_MULTI 0
#endif

#define LAS __attribute__((address_space(3)))
typedef unsigned short bf16_t;
typedef short bf16x8 __attribute__((ext_vector_type(8)));
typedef short s16x4 __attribute__((ext_vector_type(4)));
typedef float f32x4 __attribute__((ext_vector_type(4)));
typedef float f32x2 __attribute__((ext_vector_type(2)));
typedef float f32x16 __attribute__((ext_vector_type(16)));
typedef unsigned u32x4 __attribute__((ext_vector_type(4)));
typedef unsigned u32x2 __attribute__((ext_vector_type(2)));
typedef int i32x4 __attribute__((ext_vector_type(4)));
typedef int i32x8 __attribute__((ext_vector_type(8)));

constexpr int DM = 2048, NB = 8, SEQ = 4096, CTXL = 256, TPB = SEQ + CTXL, NROWS = NB * TPB;
constexpr int INW = 4608, NEXP = 16, DEXP = 1536, MODW = 6 * DM;
constexpr int MEXP_MAX = 4352;
constexpr float EPS = 1e-6f;
constexpr int NWAVES = 8, NTHR = 512;

constexpr size_t MiB = 1u << 20;
constexpr size_t WS_CTL = 0, CTL_ZERO_BYTES = 1 * MiB;
constexpr size_t WS_MOD = 1 * MiB;
constexpr size_t WS_AFFL = 2 * MiB;
constexpr size_t WS_AFFC = 4 * MiB;
constexpr size_t WS_SHD = 4 * MiB + 256 * 1024;
constexpr size_t WS_SO = 4 * MiB + 640 * 1024;
constexpr size_t WS_ROWS = 5 * MiB;
constexpr size_t WS_GATE = 5 * MiB + 512 * 1024;
constexpr size_t WS_SLOT = 6 * MiB;
constexpr size_t WS_SAX = 9 * MiB;
constexpr size_t WS_SAH = 9 * MiB + 256 * 1024;
constexpr size_t WS_SAS = 9 * MiB + 512 * 1024;
constexpr size_t WS_WSC = 9 * MiB + 896 * 1024;
constexpr size_t WS_XC = 10 * MiB;
constexpr size_t WS_WIN = 26 * MiB;
constexpr size_t WS_WOUT = 62 * MiB;
constexpr size_t WS_WGU = 78 * MiB;
constexpr size_t WS_K8 = 272 * MiB;
constexpr size_t WS_V8 = 288 * MiB;
constexpr size_t WS_K8D = 306 * MiB;
constexpr size_t WS_V8D = 342 * MiB;
constexpr size_t WS_WDN = 462 * MiB;
constexpr size_t WS_R1 = 654 * MiB;
constexpr size_t WS_R2 = 790 * MiB;
constexpr size_t WS_R3 = 1096 * MiB;
constexpr size_t WS_DLT = 1368 * MiB;
constexpr size_t WS_END = 1504 * MiB;

constexpr int RING_BYTES = 131072;
constexpr int TAB_OFF = 131072;
constexpr int LCTL_OFF = 146944;
constexpr int LDS_BYTES = 147456;

__device__ __forceinline__ unsigned cvtpk(float lo, float hi) { unsigned r; asm volatile("v_cvt_pk_bf16_f32 %0, %1, %2" : "=v"(r) : "v"(lo), "v"(hi)); return r; }
__device__ __forceinline__ float bflo(unsigned w) { return __uint_as_float(w << 16); }
__device__ __forceinline__ float bfhi(unsigned w) { return __uint_as_float(w & 0xffff0000u); }
__device__ __forceinline__ float wave_sum(float v) {
#pragma unroll
    for (int o = 1; o < 64; o <<= 1) v += __shfl_xor(v, o);
    return v;
}
__device__ __forceinline__ float wave_max(float v) {
#pragma unroll
    for (int o = 1; o < 64; o <<= 1) v = fmaxf(v, __shfl_xor(v, o));
    return v;
}
__device__ __forceinline__ f32x4 tof(const f32x4& a) { return a; }
__device__ __forceinline__ f32x4 tof(const i32x4& a) { return (f32x4){(float)a.x, (float)a.y, (float)a.z, (float)a.w}; }
__device__ __forceinline__ unsigned q8u(float x, float inv) { int q = __float2int_rn(x * inv); q = min(max(q, -127), 127); return (unsigned)q & 0xffu; }
__device__ __forceinline__ unsigned pack_i8x4(float a, float b, float c, float d, float inv) { return q8u(a, inv) | (q8u(b, inv) << 8) | (q8u(c, inv) << 16) | (q8u(d, inv) << 24); }
__device__ __forceinline__ float clamp_f8(float x) { return __builtin_amdgcn_fmed3f(x, -448.f, 448.f); }
__device__ __forceinline__ unsigned pack_f8x4(float a, float b, float c, float d, float inv) {
    int w = 0; w = __builtin_amdgcn_cvt_pk_fp8_f32(clamp_f8(a * inv), clamp_f8(b * inv), w, false); w = __builtin_amdgcn_cvt_pk_fp8_f32(clamp_f8(c * inv), clamp_f8(d * inv), w, true); return (unsigned)w; }
__device__ __forceinline__ unsigned pack_q4(float a, float b, float c, float d, float inv, bool f8) { const unsigned i = pack_i8x4(a, b, c, d, inv), f = pack_f8x4(a, b, c, d, inv); return f8 ? f : i; }
constexpr float HID_SCALE = 8.f;
constexpr float O8_SCALE = 64.f;
constexpr float Y_SCALE = 32.f;
__device__ __forceinline__ f32x4 unpack_f8x4(unsigned w) { const auto lo = __builtin_amdgcn_cvt_pk_f32_fp8((int)w, false), hi = __builtin_amdgcn_cvt_pk_f32_fp8((int)w, true); return (f32x4){lo[0], lo[1], hi[0], hi[1]}; }
__device__ __forceinline__ float amax4(const f32x4& v) { return fmaxf(fmaxf(fabsf(v.x), fabsf(v.y)), fmaxf(fabsf(v.z), fabsf(v.w))); }
__device__ __forceinline__ float silu_f(float x) { return x / (1.f + __expf(-x)); }
#define LDS_WAIT() asm volatile("s_waitcnt lgkmcnt(0)" ::: "memory")
#define VM_WAIT() asm volatile("s_waitcnt vmcnt(0)" ::: "memory")

struct Params {
    const float *x, *c, *ctx, *c_ctx, *w_ada, *b_ada, *g_mix, *g_ffn, *w_in, *w_out, *a_sink, *lq1, *lk1, *lq2, *lk2, *subln, *qn, *kn, *rpb, *w_router, *w_gate, *w_up, *w_down, *g_final;
    float* out; unsigned char* ws; int ph_lo, ph_hi;
};

#define XB_TMO      128
#define XB_XCNT(j)  (256  + 64 * (j))
#define XB_XSUB(j)  (1280 + 64 * (j))
#define XB_XGEN(j)  (2304 + 64 * (j))
#define XB_TOP      3328
#define XB_TOPGEN   3392
#define XCD_BAR_WORDS 3456
#define XB_SPIN_CAP (1u << 18)

__device__ __forceinline__ unsigned xb_ld(unsigned* p)              { return __hip_atomic_load(p, __ATOMIC_RELAXED, __HIP_MEMORY_SCOPE_AGENT); }
__device__ __forceinline__ unsigned xb_add(unsigned* p, unsigned v) { return __hip_atomic_fetch_add(p, v, __ATOMIC_RELAXED, __HIP_MEMORY_SCOPE_AGENT); }
__device__ __forceinline__ unsigned xb_xcc_id() { return (unsigned)__builtin_amdgcn_s_getreg((3 << 11) | 20) & 0xFu; }
#define XB_SPIN(cond, bar) do { unsigned _sp = 0; while (cond) { __builtin_amdgcn_s_sleep(1); \
    if ((++_sp & 255u) == 0u) { if (xb_ld(&(bar)[XB_TMO])) break; if (_sp > XB_SPIN_CAP) { atomicAdd(&(bar)[XB_TMO], 1u); break; } } } } while (0)

struct XcdBarrier { unsigned* bar; unsigned x; volatile LAS unsigned* st; };

__device__ __forceinline__ XcdBarrier xcd_barrier_post(unsigned* bar, volatile LAS unsigned* st) {
    XcdBarrier b; b.bar = bar; b.x = xb_xcc_id(); b.st = st;
    if (threadIdx.x == 0) (void)xb_add(&bar[XB_XCNT(b.x)], 1u);
    return b;
}
__device__ __forceinline__ void xcd_barrier_complete(unsigned* bar, unsigned x, unsigned& nloc, unsigned& nx) {
    const unsigned G = gridDim.x * gridDim.y * gridDim.z;
    unsigned sum, cnt, mine, sp = 0u;
    for (;;) {
        sum = 0u; cnt = 0u; mine = 0u;
#pragma unroll
        for (unsigned j = 0; j < 16; ++j) { const unsigned c = xb_ld(&bar[XB_XCNT(j)]); sum += c; cnt += (c > 0u) ? 1u : 0u; mine = (j == x) ? c : mine; }
        if (sum == G) break;
        __builtin_amdgcn_s_sleep(1);
        if ((++sp & 255u) == 0u) { if (xb_ld(&bar[XB_TMO])) break; if (sp > XB_SPIN_CAP) { atomicAdd(&bar[XB_TMO], 1u); break; } }
    }
    nloc = mine > 0u ? mine : 1u; nx = cnt > 0u ? cnt : 1u;
}
__device__ __forceinline__ void xcd_barrier(const XcdBarrier& b) {
    asm volatile("s_waitcnt vmcnt(0)" ::: "memory");
    __syncthreads();
    if (threadIdx.x == 0) {
        unsigned* bar = b.bar;
        __builtin_amdgcn_s_waitcnt(0);
        unsigned nloc = b.st[0], nx = b.st[1];
        if (nloc == 0u) { xcd_barrier_complete(bar, b.x, nloc, nx); b.st[0] = nloc; b.st[1] = nx; }
        const unsigned old = xb_add(&bar[XB_XSUB(b.x)], 1u);
        const unsigned gen = old / nloc;
        if (old + 1u == (gen + 1u) * nloc) {
            __builtin_amdgcn_fence(__ATOMIC_RELEASE, "agent");
            asm volatile("s_waitcnt vmcnt(0)" ::: "memory");
            const unsigned og = xb_add(&bar[XB_TOP], 1u);
            const unsigned tg = og / nx;
            if (og + 1u == (tg + 1u) * nx) xb_add(&bar[XB_TOPGEN], 1u);
            else XB_SPIN(xb_ld(&bar[XB_TOPGEN]) == tg, bar);
            __builtin_amdgcn_fence(__ATOMIC_ACQUIRE, "agent");
            xb_add(&bar[XB_XGEN(b.x)], 1u);
            asm volatile("s_waitcnt vmcnt(0)" ::: "memory");
        } else {
            XB_SPIN(xb_ld(&bar[XB_XGEN(b.x)]) == gen, bar);
            __builtin_amdgcn_fence(__ATOMIC_ACQUIRE, "agent");
            asm volatile("s_waitcnt vmcnt(0)" ::: "memory");
        }
    }
    __syncthreads();
}

namespace pg8 {
constexpr int BM = 256, BK = 64, HALF = 128, HTB = HALF * BK * 2, STAGE_BYTES = 8 * HTB, NXCD = 8, WGM = 8;
__device__ __forceinline__ int lds_byte(int r, int c) { const int st = (r >> 4) * 2 + (c >> 5), rr = r & 15, cc = c & 31, ob = rr * 64 + cc * 2; return st * 1024 + (ob ^ (((ob >> 9) & 1) << 5)); }
__device__ __forceinline__ void stage_rc(int b, int& R, int& C) { const int st = b / 1024, sb = b % 1024, swz = sb ^ (((sb >> 9) & 1) << 5); R = (st >> 1) * 16 + swz / 64; C = (st & 1) * 32 + (swz % 64) / 2; }
__device__ __forceinline__ int perm32(int rho) { const int n = rho >> 4, i = rho & 15; return 8 * (i >> 2) + 4 * n + (i & 3); }

struct Unit { int pm, pn, e; };

__device__ __forceinline__ bool static_tile(long L, int nM, int nN, int& pm, int& pn) {
    const int nwg = nM * nN; if (L >= nwg) return false;
    int wgid = (int)L; { const int q = nwg / NXCD, r = nwg % NXCD, xcd = wgid % NXCD, off = wgid / NXCD; wgid = (xcd < r ? xcd * (q + 1) : r * (q + 1) + (xcd - r) * q) + off; }
    const int nig = WGM * nN, gid = wgid / nig, fm = gid * WGM, gsz = (nM - fm) < WGM ? (nM - fm) : WGM;
    pm = fm + ((wgid % nig) % gsz); pn = (wgid % nig) / gsz; return true;
}
struct DenseOrder {
    int nM, nN, G, c, skipctx; const char* A; const char* Bt; size_t tstep;
    __device__ __forceinline__ bool next(int i, Unit& u) const {
        int pm, pn; if (!static_tile((long)i * G + c, nM, nN, pm, pn)) return false;
        u.pm = skipctx ? (pm >> 4) * 17 + 1 + (pm & 15) : pm; u.pn = pn; u.e = 0; return true; }
    __device__ __forceinline__ const char* a_base(const Unit& u) const { return A + (size_t)u.pm * tstep; }
    __device__ __forceinline__ const char* b_base(const Unit& u) const { return Bt + (size_t)u.pn * tstep; }
};
struct MoeOrder {
    int nMe, nN, G, c; const char* A; size_t a_estride; const char* Bt; size_t b_estride; size_t tstep;
    __device__ __forceinline__ bool next(int i, Unit& u) const {
        const int per_e = nMe * nN, nwg = per_e * NEXP; const long L = (long)i * G + c; if (L >= nwg) return false;
        int wgid = (int)L; { const int q = nwg / NXCD, r = nwg % NXCD, xcd = wgid % NXCD, off = wgid / NXCD; wgid = (xcd < r ? xcd * (q + 1) : r * (q + 1) + (xcd - r) * q) + off; }
        u.e = wgid / per_e; const int loc = wgid % per_e;
        const int nig = WGM * nN, gid = loc / nig, fm = gid * WGM, gsz = (nMe - fm) < WGM ? (nMe - fm) : WGM;
        u.pm = fm + ((loc % nig) % gsz); u.pn = (loc % nig) / gsz; return true; }
    __device__ __forceinline__ const char* a_base(const Unit& u) const { return A + (size_t)u.e * a_estride + (a_estride ? (size_t)u.pm * tstep : 0); }
    __device__ __forceinline__ const char* b_base(const Unit& u) const { return Bt + (size_t)u.e * b_estride + (size_t)u.pn * tstep; }
};

struct EpiP {
    static constexpr bool PERM = true; bf16_t* O; int rope; const float* sa; float sw;
    template <class AT> __device__ __forceinline__ void operator()(const AT (&acc)[2][2][4][2], const Unit& u, int wr, int wc, int fr, int fq) const {
        const int row0 = u.pm * BM + wr * 64 + fr, col0 = u.pn * BM + wc * 32 + 8 * fq;
        const int pt = u.pm % 17;
        const bool dorope = rope && pt != 0 && (u.pn <= 4 || (u.pn >= 6 && u.pn <= 13));
        const int jf = ((wc & 1) * 4 + fq) * 4;
        float inv[4];
#pragma unroll
        for (int i = 0; i < 4; ++i) inv[i] = exp2f(-(float)(jf + i) * (13.287712379549449f / 32.f));
#pragma unroll
        for (int ai = 0; ai < 2; ++ai)
#pragma unroll
            for (int m = 0; m < 4; ++m) { bf16_t* rowp = O + (size_t)(row0 + ai * HALF + m * 16) * INW + col0; const float rsc = sa[row0 + ai * HALF + m * 16] * sw;
                float cs[4], sn[4];
                if (dorope) { const int pos = (pt - 1) * 256 + wr * 64 + ai * HALF + m * 16 + fr; const float pp = (float)((wc >> 1) == 0 ? (pos >> 6) : (pos & 63));
#pragma unroll
                    for (int i = 0; i < 4; ++i) { const float ang = pp * inv[i]; cs[i] = __cosf(ang); sn[i] = __sinf(ang); } }
#pragma unroll
                for (int bj = 0; bj < 2; ++bj) { f32x4 v0 = tof(acc[ai][bj][m][0]) * rsc, v1 = tof(acc[ai][bj][m][1]) * rsc;
                    if (dorope) {
#pragma unroll
                        for (int i = 0; i < 4; ++i) { const float a = v0[i], b = v1[i]; v0[i] = a * cs[i] - b * sn[i]; v1[i] = b * cs[i] + a * sn[i]; } }
                    u32x4 w; w.x = cvtpk(v0[0], v0[1]); w.y = cvtpk(v0[2], v0[3]); w.z = cvtpk(v1[0], v1[1]); w.w = cvtpk(v1[2], v1[3]);
                    *(u32x4*)(rowp + bj * HALF) = w; } }
    }
};
struct EpiDelta {
    static constexpr bool PERM = true; bf16_t* D; const float* modl; const float* so; float sw;
    template <class AT> __device__ __forceinline__ void operator()(const AT (&acc)[2][2][4][2], const Unit& u, int wr, int wc, int fr, int fq) const {
        const int b = u.pm / 17, pt = u.pm % 17;
        const float* gt = modl + (size_t)(pt == 0 ? 8 : b) * MODW + 2 * DM;
        const int row0 = u.pm * BM + wr * 64 + fr, col0 = u.pn * BM + wc * 32 + 8 * fq;
        f32x4 g[2][2];
#pragma unroll
        for (int bj = 0; bj < 2; ++bj)
#pragma unroll
            for (int n = 0; n < 2; ++n) g[bj][n] = *(const f32x4*)(gt + col0 + bj * HALF + 4 * n) * sw;
#pragma unroll
        for (int ai = 0; ai < 2; ++ai)
#pragma unroll
            for (int m = 0; m < 4; ++m) { const int row = row0 + ai * HALF + m * 16; const float rs = so ? so[row] : 1.f; bf16_t* rowp = D + (size_t)row * DM + col0;
#pragma unroll
                for (int bj = 0; bj < 2; ++bj) { const f32x4 v0 = tof(acc[ai][bj][m][0]) * g[bj][0] * rs, v1 = tof(acc[ai][bj][m][1]) * g[bj][1] * rs;
                    u32x4 w; w.x = cvtpk(v0[0], v0[1]); w.y = cvtpk(v0[2], v0[3]); w.z = cvtpk(v1[0], v1[1]); w.w = cvtpk(v1[2], v1[3]);
                    *(u32x4*)(rowp + bj * HALF) = w; } }
    }
};
struct EpiSwiglu {
    static constexpr bool PERM = true; unsigned char* H; int mexp; const float* sas; const float* wsc;
    template <class AT> __device__ __forceinline__ void operator()(const AT (&acc)[2][2][4][2], const Unit& u, int wr, int wc, int fr, int fq) const {
        const int row0 = u.e * mexp + u.pm * BM + wr * 64 + fr, col0 = u.pn * 128 + wc * 16 + 4 * fq;
        const float sg = wsc[2 * u.e], su = wsc[2 * u.e + 1];
#pragma unroll
        for (int ai = 0; ai < 2; ++ai)
#pragma unroll
            for (int m = 0; m < 4; ++m) { unsigned char* rowp = H + (size_t)(row0 + ai * HALF + m * 16) * DEXP + col0; const float rs_ = sas[row0 + ai * HALF + m * 16];
#pragma unroll
                for (int bj = 0; bj < 2; ++bj) { const f32x4 g = tof(acc[ai][bj][m][0]) * (rs_ * sg), up = tof(acc[ai][bj][m][1]) * (rs_ * su); f32x4 h;
#pragma unroll
                    for (int q = 0; q < 4; ++q) h[q] = g[q] * __builtin_amdgcn_rcpf(1.f + __expf(-g[q])) * up[q];
                    *(unsigned*)(rowp + bj * 64) = pack_f8x4(h[0], h[1], h[2], h[3], HID_SCALE); } }
    }
};
struct EpiDown {
    static constexpr bool PERM = true; unsigned char* Y; const float* gate; int mexp; const float* wsc;
    template <class AT> __device__ __forceinline__ void operator()(const AT (&acc)[2][2][4][2], const Unit& u, int wr, int wc, int fr, int fq) const {
        const int row0 = u.e * mexp + u.pm * BM + wr * 64 + fr, col0 = u.pn * BM + wc * 32 + 8 * fq;
#pragma unroll
        for (int ai = 0; ai < 2; ++ai)
#pragma unroll
            for (int m = 0; m < 4; ++m) { const int row = row0 + ai * HALF + m * 16; const float gv = gate[row] * (wsc[u.e] * (Y_SCALE / HID_SCALE)); unsigned char* rowp = Y + (size_t)row * DM + col0;
#pragma unroll
                for (int bj = 0; bj < 2; ++bj) { const f32x4 v0 = tof(acc[ai][bj][m][0]) * gv, v1 = tof(acc[ai][bj][m][1]) * gv;
                    u32x2 w; w.x = pack_f8x4(v0[0], v0[1], v0[2], v0[3], 1.f); w.y = pack_f8x4(v1[0], v1[1], v1[2], v1[3], 1.f);
                    *(u32x2*)(rowp + bj * HALF) = w; } }
    }
};

__device__ __forceinline__ void mfma_f8(f32x4& acc, const i32x8 a, const i32x8 b) { asm volatile("v_mfma_f32_16x16x128_f8f6f4 %0, %1, %2, %0" : "+v"(acc) : "v"(a), "v"(b)); }
__device__ __forceinline__ void mfma_f8(i32x4& acc, const i32x8 a, const i32x8 b) { }
template <class Epi, class Sched, bool GATHER, bool I8, bool F8 = false>
__device__ __forceinline__ void gemm_phase(const int tid, LAS unsigned char* lds, const LAS unsigned* rowtab, const int KB, const Sched& S, const Epi& E) {
    const int wid = __builtin_amdgcn_readfirstlane(tid >> 6), lane = tid & 63, wr = wid >> 2, wc = wid & 3, fr = lane & 15, fq = lane >> 4;
    const int nt = KB / (BK * 2);
    const unsigned hstep = (unsigned)HALF * KB;
    const size_t kstep = (size_t)(BK * 2);
    unsigned voffB[2], vAc[2][2];
#pragma unroll
    for (int i = 0; i < 2; ++i) { int R, C; stage_rc(tid * 16 + i * 8192, R, C); const int Rb = Epi::PERM ? ((R & ~31) + perm32(R & 31)) : R;
        voffB[i] = (unsigned)(Rb * KB) + (unsigned)C * 2u; }
    const unsigned ldsw = (unsigned)wid * 1024u;
    const int aoff = lds_byte(wr * 64 + fr, fq * 8), boff = lds_byte(wc * 32 + fr, fq * 8);
#define PG8_SA(b, h) (((b) * 2 + (h)) * HTB)
#define PG8_SB(b, h) ((4 + (b) * 2 + (h)) * HTB)
#define PG8_STAGE(bufoff, gbase, voff) do { _Pragma("unroll") for (int _i = 0; _i < 2; ++_i) \
        __builtin_amdgcn_global_load_lds((const unsigned*)((const char*)(gbase) + (voff)[_i]), (LAS unsigned*)(lds + (bufoff) + ldsw + _i * 8192), 16, 0, 0); } while (0)
#define PG8_LDA(dst, b, h) do { _Pragma("unroll") for (int m = 0; m < 4; ++m) _Pragma("unroll") for (int k = 0; k < 2; ++k) dst[m][k] = *(const LAS bf16x8*)(lds + PG8_SA(b, h) + aoff + m * 2048 + k * 1024); } while (0)
#define PG8_LDB(dst, b, h) do { _Pragma("unroll") for (int n = 0; n < 2; ++n) _Pragma("unroll") for (int k = 0; k < 2; ++k) dst[n][k] = *(const LAS bf16x8*)(lds + PG8_SB(b, h) + boff + n * 2048 + k * 1024); } while (0)
#define PG8_MMA(ai, bj, At, Bt) do { __builtin_amdgcn_s_setprio(1); _Pragma("unroll") for (int m = 0; m < 4; ++m) _Pragma("unroll") for (int n = 0; n < 2; ++n) \
        if constexpr (F8) mfma_f8(acc[ai][bj][m][n], __builtin_shufflevector(__builtin_bit_cast(i32x4, Bt[n][0]), __builtin_bit_cast(i32x4, Bt[n][1]), 0, 1, 2, 3, 4, 5, 6, 7), \
            __builtin_shufflevector(__builtin_bit_cast(i32x4, At[m][0]), __builtin_bit_cast(i32x4, At[m][1]), 0, 1, 2, 3, 4, 5, 6, 7)); \
        else _Pragma("unroll") for (int k = 0; k < 2; ++k) \
        { if constexpr (I8) acc[ai][bj][m][n] = __builtin_amdgcn_mfma_i32_16x16x64_i8(__builtin_bit_cast(i32x4, Bt[n][k]), __builtin_bit_cast(i32x4, At[m][k]), acc[ai][bj][m][n], 0, 0, 0); \
          else acc[ai][bj][m][n] = __builtin_amdgcn_mfma_f32_16x16x32_bf16(Bt[n][k], At[m][k], acc[ai][bj][m][n], 0, 0, 0); } __builtin_amdgcn_s_setprio(0); } while (0)
#define PG8_WAIT_V(n) asm volatile("s_waitcnt vmcnt(" #n ")" ::: "memory")
#define PG8_WAIT_L(n) asm volatile("s_waitcnt lgkmcnt(" #n ")" ::: "memory")
#define PG8_BAR __builtin_amdgcn_s_barrier()
#define PG8_SCHED __builtin_amdgcn_sched_barrier(0)
#define PG8_LOADTAB(dst, ui_) do { _Pragma("unroll") for (int _i = 0; _i < 2; ++_i) { int _R, _C; stage_rc(tid * 16 + _i * 8192, _R, _C); _Pragma("unroll") for (int _h = 0; _h < 2; ++_h) \
        dst[_h][_i] = GATHER ? rowtab[(ui_) * 256 + _h * HALF + _R] + (unsigned)_C * 2u : (unsigned)((_h * HALF + _R) * KB) + (unsigned)_C * 2u; } } while (0)
    Unit cur, nxt; int ui = 0;
    if (!S.next(0, cur)) return;
    typedef typename std::conditional<I8 && !F8, i32x4, f32x4>::type acc_t;
    acc_t acc[2][2][4][2];
#pragma unroll
    for (int a = 0; a < 2; ++a)
#pragma unroll
        for (int b = 0; b < 2; ++b)
#pragma unroll
            for (int m = 0; m < 4; ++m)
#pragma unroll
                for (int n = 0; n < 2; ++n) acc[a][b][m][n] = acc_t{};
    bf16x8 At[4][2], B0[2][2], B1[2][2];
    const char* cA = S.a_base(cur); const char* cB = S.b_base(cur);
    PG8_LOADTAB(vAc, 0);
    PG8_STAGE(PG8_SB(0, 0), cB, voffB); PG8_STAGE(PG8_SB(0, 1), cB + hstep, voffB); PG8_STAGE(PG8_SA(0, 0), cA, vAc[0]); PG8_STAGE(PG8_SA(0, 1), cA, vAc[1]);
    if (wr == 1) PG8_BAR;
    PG8_WAIT_V(2); PG8_BAR;
    PG8_STAGE(PG8_SB(1, 0), cB + kstep, voffB); PG8_STAGE(PG8_SA(1, 0), cA + kstep, vAc[0]); PG8_STAGE(PG8_SB(1, 1), cB + hstep + kstep, voffB);
    PG8_WAIT_V(6); PG8_BAR;
    for (;;) {
        const bool has_next = S.next(ui + 1, nxt);
        const char* nA = has_next ? S.a_base(nxt) : cA; const char* nB = has_next ? S.b_base(nxt) : cB;
        for (int t = 0; t < nt; t += 2) {
            const bool last = (t == nt - 2);
            const char* a1 = cA + (size_t)(t + 1) * kstep;
            const char* a2 = last ? nA : cA + (size_t)(t + 2) * kstep; const char* b2 = last ? nB : cB + (size_t)(t + 2) * kstep;
            const char* a3 = a2 + kstep; const char* b3 = b2 + kstep;
            PG8_LDB(B0, 0, 0); PG8_LDB(B1, 0, 1); PG8_SCHED; PG8_LDA(At, 0, 0); PG8_STAGE(PG8_SA(1, 1), a1, vAc[1]);
            if (GATHER) { if (last && has_next) { PG8_LOADTAB(vAc, ui + 1); } }
            PG8_WAIT_V(8); PG8_WAIT_L(0); PG8_BAR; PG8_MMA(0, 0, At, B0); PG8_MMA(0, 1, At, B1); PG8_BAR; PG8_SCHED;
            PG8_LDA(At, 0, 1); PG8_STAGE(PG8_SB(0, 0), b2, voffB); PG8_STAGE(PG8_SB(0, 1), b2 + hstep, voffB); PG8_STAGE(PG8_SA(0, 0), a2, vAc[0]);
            PG8_WAIT_V(8); PG8_WAIT_L(0); PG8_BAR; PG8_MMA(1, 0, At, B0); PG8_MMA(1, 1, At, B1); PG8_BAR; PG8_SCHED;
            PG8_LDB(B0, 1, 0); PG8_LDB(B1, 1, 1); PG8_SCHED; PG8_LDA(At, 1, 0); PG8_STAGE(PG8_SA(0, 1), a2, vAc[1]);
            PG8_WAIT_V(8); PG8_WAIT_L(0); PG8_BAR; PG8_MMA(0, 0, At, B0); PG8_MMA(0, 1, At, B1); PG8_BAR; PG8_SCHED;
            PG8_LDA(At, 1, 1); PG8_STAGE(PG8_SB(1, 0), b3, voffB); PG8_STAGE(PG8_SB(1, 1), b3 + hstep, voffB); PG8_STAGE(PG8_SA(1, 0), a3, vAc[0]);
            PG8_WAIT_V(8); PG8_WAIT_L(0); PG8_BAR; PG8_MMA(1, 0, At, B0); PG8_MMA(1, 1, At, B1); PG8_BAR; PG8_SCHED;
        }
        if (wr == 0) PG8_BAR;
        E(acc, cur, wr, wc, fr, fq);
        if (!has_next) break;
#pragma unroll
        for (int a = 0; a < 2; ++a)
#pragma unroll
            for (int b = 0; b < 2; ++b)
#pragma unroll
                for (int m = 0; m < 4; ++m)
#pragma unroll
                    for (int n = 0; n < 2; ++n) acc[a][b][m][n] = acc_t{};
        cur = nxt; cA = nA; cB = nB; ++ui;
        if (wr == 1) PG8_BAR;
    }
    PG8_WAIT_V(0);
    PG8_BAR;
#undef PG8_SA
#undef PG8_SB
#undef PG8_STAGE
#undef PG8_LDA
#undef PG8_LDB
#undef PG8_MMA
#undef PG8_WAIT_V
#undef PG8_WAIT_L
#undef PG8_BAR
#undef PG8_SCHED
#undef PG8_LOADTAB
}
}

namespace att {
constexpr int D = 128, NW = 8, QBLK = 32, KVBLK = 64, LDP = INW;
constexpr float SCALE = 0.088388347648318440f;
constexpr float THR = 8.f;
constexpr int NBUF = 3;
constexpr int SHM_V = KVBLK * D * 2, SHM_K = KVBLK * D * 2, SHM_ATTN = NBUF * SHM_V + NBUF * SHM_K + NW * 64 * 4;
constexpr int BIAS_OFF = 100352;
#define KSWZ(row, colB) ((row) * 256 + ((colB) ^ (((row) & 7) << 4)))
#define SBAR() __builtin_amdgcn_sched_barrier(0)
__device__ __forceinline__ int crow(int r, int hi) { return (r & 3) + 8 * (r >> 2) + 4 * hi; }

struct AUnit { int qrow0, qcol, kcol, vcol, kbase, NT, seg2row, mode, pa, pb, head, ocol, outf32, has_sink; float sink; };

template <bool FIXREF = false> __device__ __forceinline__ void partialSM(f32x16& p0, f32x16& p1, float& m_reg, float& mn, float& alpha) {
  constexpr float C = SCALE * 1.4426950408889634f;
  if constexpr (FIXREF) { mn = m_reg; alpha = 1.f;
#pragma unroll
    for (int r = 0; r < 16; ++r) p0[r] = __builtin_amdgcn_exp2f(p0[r]);
    return; }
  float pmax = p0[0];
#pragma unroll
  for (int r = 1; r < 16; ++r) pmax = fmaxf(pmax, p0[r]);
#pragma unroll
  for (int r = 0; r < 16; ++r) pmax = fmaxf(pmax, p1[r]);
  { auto rr = __builtin_amdgcn_permlane32_swap(__float_as_uint(pmax), __float_as_uint(pmax), false, false);
    pmax = fmaxf(__uint_as_float(rr[0]), __uint_as_float(rr[1])); }
  if (__builtin_expect(__all(pmax - m_reg <= THR / SCALE), 1)) { mn = m_reg; alpha = 1.f; }
  else { mn = fmaxf(m_reg, pmax); alpha = __builtin_amdgcn_exp2f((m_reg - mn) * C); m_reg = mn; }
  float mnC = -mn * C;
#pragma unroll
  for (int r = 0; r < 16; ++r) p0[r] = fmaf(p0[r], C, mnC);
#pragma unroll
  for (int r = 0; r < 16; ++r) p1[r] = fmaf(p1[r], C, mnC);
#pragma unroll
  for (int r = 0; r < 16; ++r) p0[r] = __builtin_amdgcn_exp2f(p0[r]);
}
__device__ __forceinline__ void firstSM(f32x16& p0, f32x16& p1, float& m_reg) {
  float pmax = p0[0];
#pragma unroll
  for (int r = 1; r < 16; ++r) pmax = fmaxf(pmax, p0[r]);
#pragma unroll
  for (int r = 0; r < 16; ++r) pmax = fmaxf(pmax, p1[r]);
  { auto rr = __builtin_amdgcn_permlane32_swap(__float_as_uint(pmax), __float_as_uint(pmax), false, false);
    pmax = fmaxf(__uint_as_float(rr[0]), __uint_as_float(rr[1])); }
  m_reg = pmax;
#pragma unroll
  for (int r = 0; r < 16; ++r) p0[r] = __builtin_amdgcn_exp2f(p0[r] - pmax);
#pragma unroll
  for (int r = 0; r < 16; ++r) p1[r] -= pmax;
}
__device__ __forceinline__ void finishSM(f32x16& p0, f32x16& p1, float alpha, float& l_reg, bf16x8& pa0, bf16x8& pa1, bf16x8& pa2, bf16x8& pa3) {
#pragma unroll
  for (int r = 0; r < 16; ++r) p1[r] = __builtin_amdgcn_exp2f(p1[r]);
  float ps = 0;
#pragma unroll
  for (int r = 0; r < 16; ++r) ps += p0[r];
#pragma unroll
  for (int r = 0; r < 16; ++r) ps += p1[r];
  { auto rr = __builtin_amdgcn_permlane32_swap(__float_as_uint(ps), __float_as_uint(ps), false, false);
    ps = __uint_as_float(rr[0]) + __uint_as_float(rr[1]); }
  l_reg = l_reg * alpha + ps;
#define PK4(P, BASE, OUT) do { unsigned a0 = cvtpk(P[BASE + 0], P[BASE + 1]), a1 = cvtpk(P[BASE + 2], P[BASE + 3]);   \
    unsigned b0 = cvtpk(P[BASE + 4], P[BASE + 5]), b1 = cvtpk(P[BASE + 6], P[BASE + 7]);                              \
    auto r0 = __builtin_amdgcn_permlane32_swap(a0, b0, false, false); auto r1 = __builtin_amdgcn_permlane32_swap(a1, b1, false, false); \
    u32x4 w = {r0[0], r1[0], r0[1], r1[1]}; OUT = *reinterpret_cast<bf16x8*>(&w); } while (0)
  PK4(p0, 0, pa0); PK4(p0, 8, pa1); PK4(p1, 0, pa2); PK4(p1, 8, pa3);
#undef PK4
}
__device__ __forceinline__ void qkt(f32x16& p0, f32x16& p1, const LAS char* Ks, const bf16x8* qr, int r32, int hi, const f32x16& init) {
  p0 = init; p1 = init;
#pragma unroll
  for (int d0 = 0; d0 < 8; ++d0) { int cb = (d0 * 16 + hi * 8) * 2;
    bf16x8 b0 = *reinterpret_cast<const LAS bf16x8*>(Ks + KSWZ(r32, cb));
    bf16x8 b1 = *reinterpret_cast<const LAS bf16x8*>(Ks + KSWZ(32 + r32, cb));
    p0 = __builtin_amdgcn_mfma_f32_32x32x16_bf16(b0, qr[d0], p0, 0, 0, 0);
    p1 = __builtin_amdgcn_mfma_f32_32x32x16_bf16(b1, qr[d0], p1, 0, 0, 0); }
}
__device__ __forceinline__ int v_st(int k, int c) { const int kk = (k & ~0xC) | ((k & 4) << 1) | ((k & 8) >> 1); return ((kk >> 3) * 4 + (c >> 5)) * 512 + ((kk & 7) * 32 + (c & 31)) * 2; }
__device__ __forceinline__ int v_rd_base(int lane) { return ((lane & 3) << 3) | (((lane >> 2) & 3) << 6) | (((lane >> 4) & 1) << 5) | (((lane >> 5) & 1) << 8); }
constexpr int v_rd_off(int d0, int ks, int half) { return d0 * 512 + ks * 4096 + half * 2048; }
template <int OFF> __device__ __forceinline__ s16x4 tr_read(int vb) {
  s16x4 r; asm volatile("ds_read_b64_tr_b16 %0, %1 offset:%2" : "=&v"(r) : "v"(vb), "i"(OFF) : "memory"); return r;
}
template <int D0> __device__ __forceinline__ void pv_one(f32x16& od, int vb, bf16x8 pa0, bf16x8 pa1, bf16x8 pa2, bf16x8 pa3) {
  const s16x4 l0 = tr_read<v_rd_off(D0, 0, 0)>(vb), h0 = tr_read<v_rd_off(D0, 0, 1)>(vb), l1 = tr_read<v_rd_off(D0, 1, 0)>(vb), h1 = tr_read<v_rd_off(D0, 1, 1)>(vb);
  const s16x4 l2 = tr_read<v_rd_off(D0, 2, 0)>(vb), h2 = tr_read<v_rd_off(D0, 2, 1)>(vb), l3 = tr_read<v_rd_off(D0, 3, 0)>(vb), h3 = tr_read<v_rd_off(D0, 3, 1)>(vb);
  asm volatile("s_waitcnt lgkmcnt(0)" ::: "memory"); SBAR();
#define PK(L, H) (bf16x8){L[0], L[1], L[2], L[3], H[0], H[1], H[2], H[3]}
  od = __builtin_amdgcn_mfma_f32_32x32x16_bf16(pa0, PK(l0, h0), od, 0, 0, 0);
  od = __builtin_amdgcn_mfma_f32_32x32x16_bf16(pa1, PK(l1, h1), od, 0, 0, 0);
  od = __builtin_amdgcn_mfma_f32_32x32x16_bf16(pa2, PK(l2, h2), od, 0, 0, 0);
  od = __builtin_amdgcn_mfma_f32_32x32x16_bf16(pa3, PK(l3, h3), od, 0, 0, 0);
#undef PK
}
__device__ __forceinline__ void pv_d0(f32x16* o, int vb, bf16x8 pa0, bf16x8 pa1, bf16x8 pa2, bf16x8 pa3) {
  pv_one<0>(o[0], vb, pa0, pa1, pa2, pa3); pv_one<1>(o[1], vb, pa0, pa1, pa2, pa3); pv_one<2>(o[2], vb, pa0, pa1, pa2, pa3); pv_one<3>(o[3], vb, pa0, pa1, pa2, pa3);
}
template <int MODE> __device__ __forceinline__ void mask_tile(f32x16& p0, f32x16& p1, const AUnit& u, int j, int wid, int r32, int hi, const LAS float* btab) {
  if (MODE == 0 || j < 4) return;
  if (MODE == 1) {
    const int qpos = u.pa + wid * 32 + r32, k0 = u.pb + (j - 4) * 64 + 4 * hi;
#pragma unroll
    for (int r = 0; r < 16; ++r) { const int d = qpos - (k0 + (r & 3) + 8 * (r >> 2));
      p0[r] = (d <= 128 && d >= -128) ? p0[r] : -1e30f; const int d1 = d - 32; p1[r] = (d1 <= 128 && d1 >= -128) ? p1[r] : -1e30f; }
  } else {
    const int qr = u.pa + (wid >> 1), qc = (wid & 1) * 32 + r32, kr = u.pb + (j - 4);
    const int rs = min(max(qr - 4, 0), 56), cs = min(max(qc - 8, 0), 48);
    const bool rowok = (kr >= rs) && (kr < rs + 8);
    const LAS float* tb = btab + u.head * 480 + (kr - qr + 7) * 32 + (15 - qc) + 4 * hi;
#pragma unroll
    for (int r = 0; r < 16; ++r) { const int kc = (r & 3) + 8 * (r >> 2), kf = kc + 4 * hi;
      const float b0 = tb[kc], b1 = tb[kc + 32];
      p0[r] = (rowok && kf >= cs && kf < cs + 16) ? p0[r] + b0 : -1e30f;
      p1[r] = (rowok && kf + 32 >= cs && kf + 32 < cs + 16) ? p1[r] + b1 : -1e30f; }
  }
}

__device__ __forceinline__ void store_o8(unsigned char* Ow, const f32x16 (&o)[4], const float (&rli)[16], const int r32, const int hi) {
  const int qi = r32 & 3; const unsigned sel = (unsigned)qi | ((unsigned)(4 + qi) << 8) | 0x0c0c0000u;
  unsigned char* base = Ow + qi * 32 + (r32 & ~3);
#pragma unroll
  for (int r = 0; r < 16; ++r) { const float sc = rli[r] * O8_SCALE;
    int w = 0; w = __builtin_amdgcn_cvt_pk_fp8_f32(clamp_f8(o[0][r] * sc), clamp_f8(o[1][r] * sc), w, false); w = __builtin_amdgcn_cvt_pk_fp8_f32(clamp_f8(o[2][r] * sc), clamp_f8(o[3][r] * sc), w, true);
    const unsigned p0 = (unsigned)__builtin_amdgcn_update_dpp(0, w, 0x00, 0xf, 0xf, false), p1 = (unsigned)__builtin_amdgcn_update_dpp(0, w, 0x55, 0xf, 0xf, false);
    const unsigned p2 = (unsigned)__builtin_amdgcn_update_dpp(0, w, 0xaa, 0xf, 0xf, false), p3 = (unsigned)__builtin_amdgcn_update_dpp(0, w, 0xff, 0xf, 0xf, false);
    const unsigned t01 = __builtin_amdgcn_perm(p1, p0, sel), t23 = __builtin_amdgcn_perm(p3, p2, sel);
    *reinterpret_cast<unsigned*>(base + (size_t)crow(r, hi) * DM) = t01 | (t23 << 16); }
}
template <int MODE, int SDEPTH> __device__ __forceinline__ void attn_unit(const AUnit& u, const bf16_t* __restrict__ P, bf16_t* __restrict__ O, float* __restrict__ OB, LAS char* lds) {
  int tid = threadIdx.x; asm volatile("" : "+v"(tid));
  const int wid = tid >> 6, lane = tid & 63, r32 = lane & 31, hi = lane >> 5;
  LAS char* V_lds = lds; LAS char* K_lds = lds + NBUF * SHM_V;
  LAS float* ws = (LAS float*)(lds + NBUF * SHM_V + NBUF * SHM_K) + wid * 64; LAS float* li_l = ws; LAS float* al_l = ws + 32;
  const LAS float* btab = (const LAS float*)(lds + BIAS_OFF);
  float m_reg = -1e30f, l_reg = 0; f32x16 o[4] = {}; bf16x8 qr[8];
  const bf16_t* Qw = P + (size_t)(u.qrow0 + wid * QBLK + r32) * LDP + u.qcol + hi * 8;
#pragma unroll
  for (int d0 = 0; d0 < 8; ++d0) qr[d0] = *reinterpret_cast<const bf16x8*>(Qw + d0 * 16);
  f32x16 acc0 = {};
  {
    constexpr float C = SCALE * 1.4426950408889634f;
#pragma unroll
    for (int d0 = 0; d0 < 8; ++d0) { const u32x4 w = __builtin_bit_cast(u32x4, qr[d0]); u32x4 o_;
      o_.x = cvtpk(bflo(w.x) * C, bfhi(w.x) * C); o_.y = cvtpk(bflo(w.y) * C, bfhi(w.y) * C); o_.z = cvtpk(bflo(w.z) * C, bfhi(w.z) * C); o_.w = cvtpk(bflo(w.w) * C, bfhi(w.w) * C);
      qr[d0] = __builtin_bit_cast(bf16x8, o_); } }
  const char* Kh = (const char*)(P + (size_t)u.kbase * LDP + u.kcol); const char* Vh = (const char*)(P + (size_t)u.kbase * LDP + u.vcol);
  const int wv = __builtin_amdgcn_readfirstlane(tid >> 6);
  const unsigned koff0 = (unsigned)((tid >> 4) * (LDP * 2)) + (unsigned)(((tid & 15) * 16) ^ (((tid >> 4) & 7) << 4));
  const int vs_ = tid >> 5, vkk = (vs_ >> 2) * 8 + ((tid & 31) >> 2), vk0 = (vkk & ~0xC) | ((vkk & 4) << 1) | ((vkk & 8) >> 1), vc0 = (vs_ & 3) * 32 + (tid & 3) * 8;
  const unsigned voff0 = (unsigned)(vk0 * (LDP * 2)) + (unsigned)(vc0 * 2);
  constexpr unsigned RS32 = 32u * LDP * 2u;
  const int vb0 = (int)(unsigned)(uintptr_t)V_lds + v_rd_base(lane);
#define KROW(j) ((j) < 4 ? (j) * 64 : u.seg2row + ((j) - 4) * 64)
#define GLDS(gp, lp) __builtin_amdgcn_global_load_lds((const unsigned*)(gp), (LAS unsigned*)(lp), 16, 0, 0)
#define DMA(slot, k0) do { const size_t _kb = (size_t)(k0) * (LDP * 2); LAS char* _kd = K_lds + (slot) * SHM_K + wv * 1024; LAS char* _vd = V_lds + (slot) * SHM_V + wv * 1024; \
    GLDS(Kh + _kb + koff0, _kd); GLDS(Kh + _kb + koff0 + RS32, _kd + 8192); GLDS(Vh + _kb + voff0, _vd); GLDS(Vh + _kb + voff0 + RS32, _vd + 8192); } while (0)
#define DWAIT() asm volatile("s_waitcnt vmcnt(0)" ::: "memory")
#define RESC(a) do { if (__any((a) < 1.f)) { if (hi == 0) al_l[r32] = (a); asm volatile("s_waitcnt lgkmcnt(0)" ::: "memory"); \
    _Pragma("unroll") for (int d = 0; d < 4; ++d) _Pragma("unroll") for (int r = 0; r < 16; ++r) o[d][r] *= al_l[crow(r, hi)]; } } while (0)
  f32x16 pA0, pA1, pB0, pB1; float mnA, mnB, alA, alB; bf16x8 pa0, pa1, pa2, pa3; const int NT = u.NT;
  int bp = 0, bc = 1, bn = 2;
  DMA(0, 0); DWAIT(); __syncthreads();
  qkt(pA0, pA1, K_lds, qr, r32, hi, acc0);
  { firstSM(pA0, pA1, m_reg); mnA = m_reg; alA = 1.f;
#pragma unroll
    for (int r = 0; r < 16; ++r) acc0[r] = -m_reg; }
  DMA(1, KROW(1)); DWAIT(); __syncthreads();
#define TILE_OK(j_) (MODE != 2 || (j_) < 4 || (u.pb + (j_) - 4 >= nb_rs && u.pb + (j_) - 4 < nb_rs + 8))
  const int nb_rs = min(max(u.pa + (wv >> 1) - 4, 0), 56);
  bool okA = true, okB = true;
  for (int j = 1; j + 1 < NT; j += 2) {
    DMA(bn, KROW(j + 1));
    okB = TILE_OK(j);
    SBAR(); if (okB) qkt(pB0, pB1, K_lds + bc * SHM_K, qr, r32, hi, acc0);
    if (okA) { finishSM(pA0, pA1, alA, l_reg, pa0, pa1, pa2, pa3); SBAR();
      pv_d0(o, vb0 + bp * (int)SHM_V, pa0, pa1, pa2, pa3); }
    if (okB) { mask_tile<MODE>(pB0, pB1, u, j, wid, r32, hi, btab); partialSM<true>(pB0, pB1, m_reg, mnB, alB); }
    DWAIT(); __syncthreads();
    bp = bc; bc = bn; bn = (bn == NBUF - 1) ? 0 : bn + 1;
    if (j + 2 < NT) DMA(bn, KROW(j + 2));
    okA = TILE_OK(j + 1);
    SBAR(); if (okA) qkt(pA0, pA1, K_lds + bc * SHM_K, qr, r32, hi, acc0);
    if (okB) { finishSM(pB0, pB1, alB, l_reg, pa0, pa1, pa2, pa3); SBAR();
      pv_d0(o, vb0 + bp * (int)SHM_V, pa0, pa1, pa2, pa3); }
    if (okA) { mask_tile<MODE>(pA0, pA1, u, j + 1, wid, r32, hi, btab); partialSM<true>(pA0, pA1, m_reg, mnA, alA); }
    DWAIT(); __syncthreads();
    bp = bc; bc = bn; bn = (bn == NBUF - 1) ? 0 : bn + 1;
  }
  okB = TILE_OK(NT - 1);
  SBAR(); if (okB) qkt(pB0, pB1, K_lds + bc * SHM_K, qr, r32, hi, acc0);
  if (okA) { finishSM(pA0, pA1, alA, l_reg, pa0, pa1, pa2, pa3); SBAR();
    pv_d0(o, vb0 + bp * (int)SHM_V, pa0, pa1, pa2, pa3); }
  if (okB) { mask_tile<MODE>(pB0, pB1, u, NT - 1, wid, r32, hi, btab); partialSM<true>(pB0, pB1, m_reg, mnB, alB);
    finishSM(pB0, pB1, alB, l_reg, pa0, pa1, pa2, pa3); SBAR();
    pv_d0(o, vb0 + bc * (int)SHM_V, pa0, pa1, pa2, pa3); }
#undef TILE_OK
  if (u.has_sink) l_reg += __builtin_amdgcn_exp2f(u.sink * 1.4426950408889634f - m_reg);
  if (hi == 0) li_l[r32] = l_reg; asm volatile("s_waitcnt lgkmcnt(0)" ::: "memory");
  float rli[16];
#pragma unroll
  for (int r = 0; r < 16; ++r) rli[r] = __builtin_amdgcn_rcpf(li_l[crow(r, hi)]);
  if (u.outf32) {
    float* Ow = OB + (size_t)(u.qrow0 + wid * QBLK) * DM + u.ocol;
#pragma unroll
    for (int r = 0; r < 16; ++r) { const int orow = crow(r, hi);
#pragma unroll
      for (int d0 = 0; d0 < 4; ++d0) Ow[(size_t)orow * DM + d0 * 32 + r32] = o[d0][r] * rli[r]; }
  } else {
    if constexpr (MODE == 2) {
      store_o8(reinterpret_cast<unsigned char*>(O) + (size_t)(u.qrow0 + wid * QBLK) * DM + u.ocol, o, rli, r32, hi);
    } else {
    bf16_t* Ow = O + (size_t)(u.qrow0 + wid * QBLK) * DM + u.ocol;
#pragma unroll
    for (int r = 0; r < 16; ++r) { const int orow = crow(r, hi);
#pragma unroll
      for (int d0 = 0; d0 < 4; ++d0) { const float v = o[d0][r] * rli[r]; Ow[(size_t)orow * DM + d0 * 32 + r32] = (bf16_t)(cvtpk(v, v) & 0xffffu); } }
    }
  }
  __syncthreads();
#undef KROW
#undef GLDS
#undef DMA
#undef DWAIT
#undef RESC
}
constexpr int SHM8 = 8192;
__device__ __forceinline__ void mfma8_32(f32x16& acc, const i32x8 a, const i32x8 b) { asm volatile("v_mfma_f32_32x32x64_f8f6f4 %0, %1, %2, %0" : "+v"(acc) : "v"(a), "v"(b)); }
__device__ __forceinline__ i32x8 cat8(const i32x4 a, const i32x4 b) { return __builtin_shufflevector(a, b, 0, 1, 2, 3, 4, 5, 6, 7); }
__device__ __forceinline__ int cvt4_f8(float a, float b, float c, float d) { int w = 0; w = __builtin_amdgcn_cvt_pk_fp8_f32(a, b, w, false); w = __builtin_amdgcn_cvt_pk_fp8_f32(c, d, w, true); return w; }
__device__ __forceinline__ void mfma8_32c(f32x16& d, const i32x8 a, const i32x8 b, const f32x16& c) { asm volatile("v_mfma_f32_32x32x64_f8f6f4 %0, %1, %2, %3" : "=&v"(d) : "v"(a), "v"(b), "v"(c)); }
__device__ __forceinline__ void kfrag8(i32x8 (&kf)[4], const LAS char* Ks, int r32, int hi) {
  const int x0 = r32 & 7; const LAS char* k0 = Ks + r32 * 128; const LAS char* k1 = k0 + 32 * 128;
#define KF8(kp, s) cat8(*reinterpret_cast<const LAS i32x4*>((kp) + (((4 * (s) + 2 * hi) ^ x0) << 4)), *reinterpret_cast<const LAS i32x4*>((kp) + (((4 * (s) + 2 * hi + 1) ^ x0) << 4)))
  kf[0] = KF8(k0, 0); kf[1] = KF8(k1, 0); kf[2] = KF8(k0, 1); kf[3] = KF8(k1, 1);
#undef KF8
}
__device__ __forceinline__ void qkmma8(f32x16& p0, f32x16& p1, const i32x8 (&kf)[4], const i32x8 (&q8)[2], const f32x16& init) {
  mfma8_32c(p0, kf[0], q8[0], init); mfma8_32c(p1, kf[1], q8[0], init); mfma8_32(p0, kf[2], q8[1]); mfma8_32(p1, kf[3], q8[1]);
}
__device__ __forceinline__ void qkt8(f32x16& p0, f32x16& p1, const LAS char* Ks, const i32x8 (&q8)[2], int r32, int hi, const f32x16& init) {
  i32x8 kf[4]; kfrag8(kf, Ks, r32, hi); qkmma8(p0, p1, kf, q8, init);
}
__device__ __forceinline__ void finishSM8(f32x16& p0, f32x16& p1, float& l_reg, i32x8& pf) {
#pragma unroll
  for (int r = 0; r < 16; ++r) p1[r] = __builtin_amdgcn_exp2f(p1[r]);
  float ps = 0;
#pragma unroll
  for (int r = 0; r < 16; ++r) ps += p0[r];
#pragma unroll
  for (int r = 0; r < 16; ++r) ps += p1[r];
  { auto rr = __builtin_amdgcn_permlane32_swap(__float_as_uint(ps), __float_as_uint(ps), false, false);
    ps = __uint_as_float(rr[0]) + __uint_as_float(rr[1]); }
  l_reg += ps;
#pragma unroll
  for (int i = 0; i < 4; ++i) { pf[i] = cvt4_f8(p0[4 * i], p0[4 * i + 1], p0[4 * i + 2], p0[4 * i + 3]); pf[4 + i] = cvt4_f8(p1[4 * i], p1[4 * i + 1], p1[4 * i + 2], p1[4 * i + 3]); }
}
__device__ __forceinline__ void vfrag8(i32x8 (&vf)[4], const LAS char* Vs, int r32, int hi) {
  const int xs = (r32 >> 1) & 3; const LAS char* vp = Vs + r32 * 64;
#pragma unroll
  for (int d0 = 0; d0 < 4; ++d0) vf[d0] = cat8(*reinterpret_cast<const LAS i32x4*>(vp + d0 * 2048 + (((2 * hi) ^ xs) << 4)), *reinterpret_cast<const LAS i32x4*>(vp + d0 * 2048 + (((2 * hi + 1) ^ xs) << 4)));
}
__device__ __forceinline__ void pvmma8(f32x16* o, const i32x8 (&vf)[4], const i32x8 pf) {
#pragma unroll
  for (int d0 = 0; d0 < 4; ++d0) mfma8_32(o[d0], pf, vf[d0]);
}
__device__ __forceinline__ void pv8(f32x16* o, const LAS char* Vs, const i32x8 pf, int r32, int hi) { i32x8 vf[4]; vfrag8(vf, Vs, r32, hi); pvmma8(o, vf, pf); }
template <int MODE> __device__ __forceinline__ void attn_unit_c8(const AUnit& u, const bf16_t* __restrict__ P, const unsigned char* __restrict__ Kh, const unsigned char* __restrict__ Vh, const float* __restrict__ qn, bf16_t* __restrict__ O, LAS char* lds) {
  int tid = threadIdx.x; asm volatile("" : "+v"(tid));
  const int wid = tid >> 6, lane = tid & 63, r32 = lane & 31, hi = lane >> 5;
  const int wv = __builtin_amdgcn_readfirstlane(tid >> 6);
  LAS char* V_lds = lds; LAS char* K_lds = lds + 6 * SHM8;
  LAS float* li_l = (LAS float*)(lds + 12 * SHM8) + wid * 64;
  float m_reg = -1e30f, l_reg = 0; f32x16 o[4] = {}; i32x8 q8[2];
  if constexpr (MODE != 0) {
    const bf16_t* Qw = P + (size_t)(u.qrow0 + wid * QBLK + r32) * LDP + u.qcol + hi * 32; constexpr float C = SCALE * 1.4426950408889634f;
#pragma unroll
    for (int s = 0; s < 2; ++s)
#pragma unroll
      for (int c = 0; c < 4; ++c) { const u32x4 w = *reinterpret_cast<const u32x4*>(Qw + s * 64 + c * 8);
        q8[s][2 * c] = cvt4_f8(bflo(w.x) * C, bfhi(w.x) * C, bflo(w.y) * C, bfhi(w.y) * C); q8[s][2 * c + 1] = cvt4_f8(bflo(w.z) * C, bfhi(w.z) * C, bflo(w.w) * C, bfhi(w.w) * C); }
  } else
  { const bf16_t* Qw = P + (size_t)(u.qrow0 + wid * QBLK + r32) * LDP + u.qcol + hi * 16; constexpr float C = SCALE * 1.4426950408889634f;
    float xa[2][16], xb[2][16]; float ss = 0.f;
#pragma unroll
    for (int s = 0; s < 2; ++s)
#pragma unroll
      for (int c = 0; c < 2; ++c) { const u32x4 wa = *reinterpret_cast<const u32x4*>(Qw + s * 64 + c * 8), wb = *reinterpret_cast<const u32x4*>(Qw + s * 64 + 32 + c * 8);
        xa[s][8 * c + 0] = bflo(wa.x); xa[s][8 * c + 1] = bfhi(wa.x); xa[s][8 * c + 2] = bflo(wa.y); xa[s][8 * c + 3] = bfhi(wa.y); xa[s][8 * c + 4] = bflo(wa.z); xa[s][8 * c + 5] = bfhi(wa.z); xa[s][8 * c + 6] = bflo(wa.w); xa[s][8 * c + 7] = bfhi(wa.w);
        xb[s][8 * c + 0] = bflo(wb.x); xb[s][8 * c + 1] = bfhi(wb.x); xb[s][8 * c + 2] = bflo(wb.y); xb[s][8 * c + 3] = bfhi(wb.y); xb[s][8 * c + 4] = bflo(wb.z); xb[s][8 * c + 5] = bfhi(wb.z); xb[s][8 * c + 6] = bflo(wb.w); xb[s][8 * c + 7] = bfhi(wb.w); }
#pragma unroll
    for (int s = 0; s < 2; ++s)
#pragma unroll
      for (int j = 0; j < 16; ++j) ss += xa[s][j] * xa[s][j] + xb[s][j] * xb[s][j];
    { auto rr = __builtin_amdgcn_permlane32_swap(__float_as_uint(ss), __float_as_uint(ss), false, false); ss = __uint_as_float(rr[0]) + __uint_as_float(rr[1]); }
    const float rq = rsqrtf(ss * (1.f / 128.f) + EPS) * C;
    const int pos = u.pa + wid * QBLK + r32;
#pragma unroll
    for (int s = 0; s < 2; ++s) { const float pp = (float)(s == 0 ? (pos >> 6) : (pos & 63));
#pragma unroll
      for (int j = 0; j < 16; ++j) { const float ga = qn[64 * s + 16 * hi + j], gb = qn[64 * s + 32 + 16 * hi + j];
        const float ang = pp * exp2f(-(float)(16 * hi + j) * (13.287712379549449f / 32.f)); const float cs_ = __cosf(ang), sn_ = __sinf(ang);
        const float a = xa[s][j] * rq * ga, b = xb[s][j] * rq * gb; xa[s][j] = a * cs_ - b * sn_; xb[s][j] = b * cs_ + a * sn_; }
#pragma unroll
      for (int i = 0; i < 4; ++i) { q8[s][i] = cvt4_f8(xa[s][4 * i], xa[s][4 * i + 1], xa[s][4 * i + 2], xa[s][4 * i + 3]); q8[s][4 + i] = cvt4_f8(xb[s][4 * i], xb[s][4 * i + 1], xb[s][4 * i + 2], xb[s][4 * i + 3]); } } }
  const unsigned koff = (unsigned)((tid >> 3) * 128 + (((tid & 7) ^ ((tid >> 3) & 7)) << 4));
  const unsigned voff = (unsigned)((tid >> 2) * 64 + (((tid & 3) ^ ((tid >> 3) & 3)) << 4));
#define GLDS(gp, lp) __builtin_amdgcn_global_load_lds((const unsigned*)(gp), (LAS unsigned*)(lp), 16, 0, 0)
  const int tb = MODE == 1 ? (u.seg2row >> 6) - 4 : 0;
#define DMA8(ss_, j_) do { _Pragma("unroll") for (int _h = 0; _h < 2; ++_h) { const int _j = (j_) + _h, _t = _j < 4 ? _j : _j + tb; \
    GLDS(Kh + (size_t)_t * 8192 + koff, K_lds + ((ss_) * 2 + _h) * SHM8 + wv * 1024); GLDS(Vh + (size_t)_t * 8192 + voff, V_lds + ((ss_) * 2 + _h) * SHM8 + wv * 1024); } } while (0)
#define MASK8(p0_, p1_, j_) do { if constexpr (MODE == 1) mask_tile<1>(p0_, p1_, u, (j_), wid, r32, hi, (const LAS float*)nullptr); } while (0)
#define DWAIT() asm volatile("s_waitcnt vmcnt(0)" ::: "memory")
#define EXP16(p_) do { _Pragma("unroll") for (int r = 0; r < 16; ++r) p_[r] = __builtin_amdgcn_exp2f(p_[r]); } while (0)
  f32x16 pA0, pA1, pB0, pB1, acc0 = {}; i32x8 pf; const int NT = u.NT;
  DMA8(0, 0); DMA8(1, 2); DWAIT(); __syncthreads();
  qkt8(pA0, pA1, K_lds, q8, r32, hi, acc0);
  asm volatile("s_nop 7\n\ts_nop 7\n\ts_nop 7\n\ts_nop 7\n\ts_nop 7\n\ts_nop 7" : "+v"(pA0), "+v"(pA1));
  firstSM(pA0, pA1, m_reg);
#pragma unroll
  for (int r = 0; r < 16; ++r) acc0[r] = -m_reg;
  int s0 = 0, s1 = 1, s2 = 2;
  for (int j = 1; j + 1 < NT; j += 2) {
    if (j + 3 < NT) DMA8(s2, j + 3);
    { i32x8 vf[4]; SBAR(); { i32x8 kf[4]; kfrag8(kf, K_lds + (s0 * 2 + 1) * SHM8, r32, hi); qkmma8(pB0, pB1, kf, q8, acc0); }
      vfrag8(vf, V_lds + (s0 * 2) * SHM8, r32, hi);
      finishSM8(pA0, pA1, l_reg, pf); SBAR();
      pvmma8(o, vf, pf); }
    MASK8(pB0, pB1, j); EXP16(pB0);
    { i32x8 vf[4]; SBAR(); { i32x8 kf[4]; kfrag8(kf, K_lds + (s1 * 2) * SHM8, r32, hi); qkmma8(pA0, pA1, kf, q8, acc0); }
      vfrag8(vf, V_lds + (s0 * 2 + 1) * SHM8, r32, hi);
      finishSM8(pB0, pB1, l_reg, pf); SBAR();
      pvmma8(o, vf, pf); }
    MASK8(pA0, pA1, j + 1); EXP16(pA0);
    DWAIT(); __syncthreads();
    { const int t_ = s0; s0 = s1; s1 = s2; s2 = t_; }
  }
  SBAR(); qkt8(pB0, pB1, K_lds + (s0 * 2 + 1) * SHM8, q8, r32, hi, acc0);
  finishSM8(pA0, pA1, l_reg, pf); SBAR();
  pv8(o, V_lds + (s0 * 2) * SHM8, pf, r32, hi);
  MASK8(pB0, pB1, NT - 1); EXP16(pB0);
  finishSM8(pB0, pB1, l_reg, pf); SBAR();
  pv8(o, V_lds + (s0 * 2 + 1) * SHM8, pf, r32, hi);
  asm volatile("s_nop 7\n\ts_nop 7\n\ts_nop 7\n\ts_nop 7\n\ts_nop 7\n\ts_nop 7" : "+v"(o[0]), "+v"(o[1]), "+v"(o[2]), "+v"(o[3]));
  if (MODE == 1 && u.has_sink) l_reg += __builtin_amdgcn_exp2f(u.sink * 1.4426950408889634f - m_reg);
  if (hi == 0) li_l[r32] = l_reg; asm volatile("s_waitcnt lgkmcnt(0)" ::: "memory");
  float rli[16];
#pragma unroll
  for (int r = 0; r < 16; ++r) rli[r] = __builtin_amdgcn_rcpf(li_l[crow(r, hi)]);
  if constexpr (MODE == 3) { float* Ow = reinterpret_cast<float*>(O) + (size_t)(u.qrow0 + wid * QBLK) * DM + u.ocol;
#pragma unroll
    for (int r = 0; r < 16; ++r) { const int orow = crow(r, hi);
#pragma unroll
      for (int d0 = 0; d0 < 4; ++d0) Ow[(size_t)orow * DM + d0 * 32 + r32] = o[d0][r] * rli[r]; }
  } else
  if constexpr (MODE == 1) { bf16_t* Ow = O + (size_t)(u.qrow0 + wid * QBLK) * DM + u.ocol;
#pragma unroll
    for (int r = 0; r < 16; ++r) { const int orow = crow(r, hi);
#pragma unroll
      for (int d0 = 0; d0 < 4; ++d0) { const float v = o[d0][r] * rli[r]; Ow[(size_t)orow * DM + d0 * 32 + r32] = (bf16_t)(cvtpk(v, v) & 0xffffu); } }
  } else
  store_o8(reinterpret_cast<unsigned char*>(O) + (size_t)(u.qrow0 + wid * QBLK) * DM + u.ocol, o, rli, r32, hi);
  __syncthreads();
#undef GLDS
#undef DMA8
#undef MASK8
#undef DWAIT
#undef EXP16
}
__device__ __forceinline__ void attn_unit_b(const AUnit& u, const bf16_t* __restrict__ P, float* __restrict__ OB, LAS char* lds) {
  int tid = threadIdx.x; asm volatile("" : "+v"(tid));
  const int lane = tid & 63, r32 = lane & 31, hi = lane >> 5;
  const int wv = __builtin_amdgcn_readfirstlane(tid >> 6), rg = wv & 3, kh = wv >> 2;
  LAS char* K_lds = lds; LAS char* V_lds = lds + 2 * SHM_K;
  LAS char* Pex = lds + 2 * SHM_K + 4 * SHM_V;
  LAS float* st = (LAS float*)(lds + 2 * SHM_K + 4 * SHM_V + 2 * 8 * 2048);
  f32x16 o[4] = {}; bf16x8 qr[8];
  { const bf16_t* Qw = P + (size_t)(u.qrow0 + rg * QBLK + r32) * LDP + u.qcol + hi * 8; constexpr float C = SCALE * 1.4426950408889634f;
#pragma unroll
    for (int d0 = 0; d0 < 8; ++d0) { const u32x4 w = __builtin_bit_cast(u32x4, *reinterpret_cast<const bf16x8*>(Qw + d0 * 16)); u32x4 o_;
      o_.x = cvtpk(bflo(w.x) * C, bfhi(w.x) * C); o_.y = cvtpk(bflo(w.y) * C, bfhi(w.y) * C); o_.z = cvtpk(bflo(w.z) * C, bfhi(w.z) * C); o_.w = cvtpk(bflo(w.w) * C, bfhi(w.w) * C);
      qr[d0] = __builtin_bit_cast(bf16x8, o_); } }
  const char* Kh = (const char*)(P + (size_t)u.kbase * LDP + u.kcol); const char* Vh = (const char*)(P + (size_t)u.kbase * LDP + u.vcol);
  const unsigned koff0 = (unsigned)((tid >> 4) * (LDP * 2)) + (unsigned)(((tid & 15) * 16) ^ (((tid >> 4) & 7) << 4));
  const int vs_ = tid >> 5, vkk = (vs_ >> 2) * 8 + ((tid & 31) >> 2), vk0 = (vkk & ~0xC) | ((vkk & 4) << 1) | ((vkk & 8) >> 1), vc0 = (vs_ & 3) * 32 + (tid & 3) * 8;
  const unsigned voff0 = (unsigned)(vk0 * (LDP * 2)) + (unsigned)(vc0 * 2);
  constexpr unsigned RS32 = 32u * LDP * 2u;
  const int vrd = (int)(unsigned)(uintptr_t)V_lds + kh * (int)SHM_V + v_rd_base(lane);
#define GLDS(gp, lp) __builtin_amdgcn_global_load_lds((const unsigned*)(gp), (LAS unsigned*)(lp), 16, 0, 0)
#define DMAK(slot, k0) do { const size_t _kb = (size_t)(k0) * (LDP * 2); LAS char* _kd = K_lds + (slot) * SHM_K + wv * 1024; GLDS(Kh + _kb + koff0, _kd); GLDS(Kh + _kb + koff0 + RS32, _kd + 8192); } while (0)
#define DMAV(slot, k0) do { const size_t _kb = (size_t)(k0) * (LDP * 2); LAS char* _vd = V_lds + (slot) * (2 * SHM_V) + wv * 1024; \
    GLDS(Vh + _kb + voff0, _vd); GLDS(Vh + _kb + voff0 + RS32, _vd + 8192); GLDS(Vh + _kb + voff0 + 256, _vd + SHM_V); GLDS(Vh + _kb + voff0 + RS32 + 256, _vd + SHM_V + 8192); } while (0)
#define DWAIT() asm volatile("s_waitcnt vmcnt(0)" ::: "memory")
#define LWAIT() asm volatile("s_waitcnt lgkmcnt(0)" ::: "memory")
#define QKH(s_, ks, init_) do { f32x16 _s1 = {}; s_ = init_; const LAS char* _K = K_lds + (ks) * SHM_K; bf16x8 _kf[8]; \
    _Pragma("unroll") for (int d0 = 0; d0 < 8; ++d0) _kf[d0] = *reinterpret_cast<const LAS bf16x8*>(_K + KSWZ(kh * 32 + r32, (d0 * 16 + hi * 8) * 2)); \
    _Pragma("unroll") for (int d0 = 0; d0 < 8; d0 += 2) { s_ = __builtin_amdgcn_mfma_f32_32x32x16_bf16(_kf[d0], qr[d0], s_, 0, 0, 0); _s1 = __builtin_amdgcn_mfma_f32_32x32x16_bf16(_kf[d0 + 1], qr[d0 + 1], _s1, 0, 0, 0); } \
    _Pragma("unroll") for (int r = 0; r < 16; ++r) s_[r] += _s1[r]; } while (0)
#define PK4(Pv, BASE, OUT) do { unsigned a0 = cvtpk(Pv[BASE + 0], Pv[BASE + 1]), a1 = cvtpk(Pv[BASE + 2], Pv[BASE + 3]);   \
    unsigned b0 = cvtpk(Pv[BASE + 4], Pv[BASE + 5]), b1 = cvtpk(Pv[BASE + 6], Pv[BASE + 7]);                              \
    auto r0 = __builtin_amdgcn_permlane32_swap(a0, b0, false, false); auto r1 = __builtin_amdgcn_permlane32_swap(a1, b1, false, false); \
    u32x4 w = {r0[0], r1[0], r0[1], r1[1]}; OUT = *reinterpret_cast<bf16x8*>(&w); } while (0)
#define SOFT_PUB(s_, f0_, f1_, par) do { _Pragma("unroll") for (int r = 0; r < 16; ++r) { s_[r] = __builtin_amdgcn_exp2f(s_[r]); lsum += s_[r]; } \
    PK4(s_, 0, f0_); PK4(s_, 8, f1_); LAS char* _px = Pex + (par) * 16384 + wv * 2048 + lane * 16; *(LAS bf16x8*)_px = f0_; *(LAS bf16x8*)(_px + 1024) = f1_; } while (0)
  const int NT = u.NT; float lsum = 0.f; bf16x8 own0, own1; f32x16 sc, acc0 = {};
  DMAK(0, 0); DMAV(0, 0); DMAK(1, 64); DWAIT(); __syncthreads();
  QKH(sc, 0, acc0);
  { float pmax = sc[0];
#pragma unroll
    for (int r = 1; r < 16; ++r) pmax = fmaxf(pmax, sc[r]);
    { auto rr = __builtin_amdgcn_permlane32_swap(__float_as_uint(pmax), __float_as_uint(pmax), false, false); pmax = fmaxf(__uint_as_float(rr[0]), __uint_as_float(rr[1])); }
    if (hi == 0) st[wv * 64 + r32] = pmax; LWAIT(); __syncthreads();
    const float mref = fmaxf(pmax, st[(wv ^ 4) * 64 + r32]); LWAIT();
#pragma unroll
    for (int r = 0; r < 16; ++r) { acc0[r] = -mref; sc[r] -= mref; } }
  SOFT_PUB(sc, own0, own1, 0);
  LWAIT(); __syncthreads();
  for (int j = 0; j < NT; ++j) {
    if (j + 2 < NT) DMAK(j & 1, (j + 2) * 64);
    if (j + 1 < NT) DMAV((j + 1) & 1, (j + 1) * 64);
    const LAS char* _pq = Pex + (j & 1) * 16384 + (wv ^ 4) * 2048 + lane * 16;
    const bf16x8 q0 = *(const LAS bf16x8*)_pq, q1 = *(const LAS bf16x8*)(_pq + 1024);
    const bf16x8 pa0 = kh ? q0 : own0, pa1 = kh ? q1 : own1, pa2 = kh ? own0 : q0, pa3 = kh ? own1 : q1;
    pv_d0(o, vrd + (j & 1) * (2 * (int)SHM_V), pa0, pa1, pa2, pa3);
    if (j + 1 < NT) { QKH(sc, (j + 1) & 1, acc0); SOFT_PUB(sc, own0, own1, (j + 1) & 1); }
    LWAIT(); DWAIT(); __syncthreads();
  }
  { auto rr = __builtin_amdgcn_permlane32_swap(__float_as_uint(lsum), __float_as_uint(lsum), false, false); lsum = __uint_as_float(rr[0]) + __uint_as_float(rr[1]); }
  if (hi == 0) st[wv * 64 + r32] = lsum; LWAIT(); __syncthreads();
  float rli[16];
#pragma unroll
  for (int r = 0; r < 16; ++r) rli[r] = __builtin_amdgcn_rcpf(st[wv * 64 + crow(r, hi)] + st[(wv ^ 4) * 64 + crow(r, hi)]);
  float* Ow = OB + (size_t)(u.qrow0 + rg * QBLK) * DM + u.ocol + kh * 128;
#pragma unroll
  for (int r = 0; r < 16; ++r) { const int orow = crow(r, hi);
#pragma unroll
    for (int d0 = 0; d0 < 4; ++d0) Ow[(size_t)orow * DM + d0 * 32 + r32] = o[d0][r] * rli[r]; }
  LWAIT(); __syncthreads();
#undef GLDS
#undef DMAK
#undef DMAV
#undef DWAIT
#undef LWAIT
#undef QKH
#undef PK4
#undef SOFT_PUB
}
}

struct Ctx {
    LAS unsigned char* lds; int tid, lane, wave, G, bid, gw, NGW;
    float* mod; float* affl; float* affc; int* rows; float* gate; int* slot; float* xc; float* sax; float* sah; float* sas; float* wsc; float* shd; signed char* hid8; float* so; signed char* o8; bf16_t* dlt;
    bf16_t *win, *wout, *wgu, *wdn, *r1, *r2, *hid, *y; float* ob; unsigned char* y8; unsigned char* k8; unsigned char* v8; unsigned char* k8d; unsigned char* v8d;
};

__device__ __forceinline__ Ctx make_ctx(const Params& p, LAS unsigned char* lds) {
    Ctx F; int tid = threadIdx.x; asm volatile("" : "+v"(tid));
    unsigned long long wsb = (unsigned long long)p.ws; asm volatile("" : "+s"(wsb)); __attribute__((address_space(1))) unsigned char* ws = (__attribute__((address_space(1))) unsigned char*)wsb;
    int bid = blockIdx.x; asm volatile("" : "+s"(bid));
    F.lds = lds; F.tid = tid; F.lane = tid & 63; F.wave = __builtin_amdgcn_readfirstlane(tid >> 6);
    F.G = gridDim.x; F.bid = bid; F.gw = bid * NWAVES + F.wave; F.NGW = F.G * NWAVES;
    F.mod = (float*)(ws + WS_MOD); F.affl = (float*)(ws + WS_AFFL); F.affc = (float*)(ws + WS_AFFC); F.rows = (int*)(ws + WS_ROWS); F.gate = (float*)(ws + WS_GATE);
    F.slot = (int*)(ws + WS_SLOT); F.xc = (float*)(ws + WS_XC); F.sax = (float*)(ws + WS_SAX); F.sah = (float*)(ws + WS_SAH); F.sas = (float*)(ws + WS_SAS); F.wsc = (float*)(ws + WS_WSC); F.shd = (float*)(ws + WS_SHD); F.hid8 = (signed char*)(ws + WS_R2 + 204 * MiB); F.so = (float*)(ws + WS_SO); F.o8 = (signed char*)(ws + WS_R3); F.dlt = (bf16_t*)(ws + WS_DLT);
    F.win = (bf16_t*)(ws + WS_WIN); F.wout = (bf16_t*)(ws + WS_WOUT); F.wgu = (bf16_t*)(ws + WS_WGU); F.wdn = (bf16_t*)(ws + WS_WDN);
    F.r1 = (bf16_t*)(ws + WS_R1); F.r2 = (bf16_t*)(ws + WS_R2); F.hid = (bf16_t*)(ws + WS_R2); F.y = (bf16_t*)(ws + WS_R3); F.y8 = (unsigned char*)(ws + WS_R3); F.k8 = (unsigned char*)(ws + WS_K8); F.v8 = (unsigned char*)(ws + WS_V8); F.k8d = (unsigned char*)(ws + WS_K8D); F.v8d = (unsigned char*)(ws + WS_V8D); F.ob = (float*)(ws + WS_R3);
    return F;
}
__device__ __forceinline__ void transpose_item_i8(const float* __restrict__ src, int K, int N, signed char* __restrict__ dst, int rs, int roff, LAS float* scr, int idx, int lane, const float inv, const bool f8 = false) {
    const int nblk = N >> 6, kb = idx / nblk, nb = idx - kb * nblk, k0 = kb * 64, n0 = nb * 64;
    const int kr = lane >> 4, nc = (lane & 15) * 4;
    const float* s = src + (size_t)(k0 + kr) * N + n0 + nc;
    f32x4 v[16];
#pragma unroll
    for (int i = 0; i < 16; ++i) v[i] = __builtin_nontemporal_load((const f32x4*)(s + (size_t)(4 * i) * N));
#pragma unroll
    for (int i = 0; i < 16; ++i) { LAS float* q = scr + (kr + 4 * i) * 65 + nc; q[0] = v[i].x; q[1] = v[i].y; q[2] = v[i].z; q[3] = v[i].w; }
    LDS_WAIT();
    const int c = lane & 3;
#pragma unroll
    for (int j = 0; j < 4; ++j) { const int n = (lane >> 2) + 16 * j; const LAS float* q = scr + (16 * c) * 65 + n;
        u32x4 o; o.x = pack_q4(q[0], q[65], q[130], q[195], inv, f8); o.y = pack_q4(q[260], q[325], q[390], q[455], inv, f8);
        o.z = pack_q4(q[520], q[585], q[650], q[715], inv, f8); o.w = pack_q4(q[780], q[845], q[910], q[975], inv, f8);
        const int ng = n0 + n; int row;
        if (rs > 0) row = (ng >> 2) * rs + roff + (ng & 3);
        else { const bool roped = ng < 1280 || (ng >= 1536 && ng < 3584); const int d = ng & 127;
            row = roped ? (ng & ~127) + (d & 64) + ((d & 31) >> 2) * 8 + ((d >> 5) & 1) * 4 + (d & 3) : ng; }
        *(u32x4*)(dst + (size_t)row * K + k0 + 16 * c) = o; }
    LDS_WAIT();
}
#ifndef CV_INTERLEAVE
#define CV_INTERLEAVE 1
#endif
constexpr int CV_IN = 32 * 72, CV_OUT = 32 * 32, CV_E = 768, CV_PER_L = CV_IN + CV_OUT + 3 * NEXP * CV_E, CV_TOTAL = 2 * CV_PER_L, CV_FIRST = CV_INTERLEAVE ? CV_IN : CV_TOTAL;
__device__ __forceinline__ void conv_item(const Params& p, const Ctx& F, LAS float* scr, const int it, const int lane) {
    const int l = it / CV_PER_L; int r = it - l * CV_PER_L;
    if (r < CV_IN) { transpose_item_i8(p.w_in + (size_t)l * DM * INW, DM, INW, (signed char*)F.win + (size_t)l * INW * DM, l == 0 ? -1 : 4, 0, scr, r, lane, 1.f / F.wsc[l]); return; } r -= CV_IN;
    if (r < CV_OUT) { transpose_item_i8(p.w_out + (size_t)l * DM * DM, DM, DM, (signed char*)F.wout + (size_t)l * DM * DM, 4, 0, scr, r, lane, 1.f / F.wsc[98 + l], l == 1); return; } r -= CV_OUT;
    const int ty = r / (NEXP * CV_E), e = (r % (NEXP * CV_E)) / CV_E, idx = r % CV_E; const size_t le = (size_t)l * NEXP + e;
    if (ty == 0) transpose_item_i8(p.w_gate + le * DM * DEXP, DM, DEXP, (signed char*)F.wgu + le * 3072 * DM, 8, 0, scr, idx, lane, 1.f / F.wsc[2 + 2 * le]);
    else if (ty == 1) transpose_item_i8(p.w_up + le * DM * DEXP, DM, DEXP, (signed char*)F.wgu + le * 3072 * DM, 8, 4, scr, idx, lane, 1.f / F.wsc[3 + 2 * le]);
    else transpose_item_i8(p.w_down + le * DEXP * DM, DEXP, DM, (signed char*)F.wdn + le * DM * DEXP, 4, 0, scr, idx, lane, 1.f / F.wsc[66 + le], true);
}

__device__ __forceinline__ void conv_some(const Params& p, const Ctx& F, int& cv_it, const int k) {
    int t2 = threadIdx.x; asm volatile("" : "+v"(t2));
    const int lane = t2 & 63, wave = __builtin_amdgcn_readfirstlane(t2 >> 6);
    LAS float* scr = (LAS float*)(F.lds + wave * 16640);
    for (int q = 0; q < k && cv_it < CV_TOTAL; ++q, cv_it += F.NGW) conv_item(p, F, scr, cv_it, lane);
}

__device__ __forceinline__ void phase_prologue(const Params& p, const Ctx& F) {
    for (int item = F.bid; item < 192; item += F.G) {
        LAS float* sl = (LAS float*)F.lds; LAS float* red = (LAS float*)(F.lds + 73728);
        for (int i = F.tid; i < 9 * DM; i += NTHR) { const int r = i >> 11, d = i & 2047; const float v = r < 8 ? p.c[r * DM + d] : p.c_ctx[d]; sl[i] = silu_f(v); }
        __syncthreads();
        const int l = item / 96, cb = item % 96;
        const float* W = p.w_ada + ((size_t)l * DM + F.wave * 256) * MODW + cb * 128 + 2 * F.lane;
        float a0[9], a1[9];
#pragma unroll
        for (int r = 0; r < 9; ++r) { a0[r] = 0.f; a1[r] = 0.f; }
#pragma unroll 8
        for (int d = 0; d < 256; ++d) { const f32x2 w = *(const f32x2*)(W + (size_t)d * MODW);
#pragma unroll
            for (int r = 0; r < 9; ++r) { const float s = sl[r * DM + F.wave * 256 + d]; a0[r] += s * w.x; a1[r] += s * w.y; } }
#pragma unroll
        for (int r = 0; r < 9; ++r) { red[(F.wave * 9 + r) * 128 + 2 * F.lane] = a0[r]; red[(F.wave * 9 + r) * 128 + 2 * F.lane + 1] = a1[r]; }
        __syncthreads();
        for (int i = F.tid; i < 9 * 128; i += NTHR) { const int r = i >> 7, cc = i & 127; float s = p.b_ada[l * MODW + cb * 128 + cc];
#pragma unroll
            for (int w = 0; w < 8; ++w) s += red[(w * 9 + r) * 128 + cc];
            F.mod[(size_t)(l * 9 + r) * MODW + cb * 128 + cc] = s; }
        __syncthreads();
    }
    for (int m = F.bid; m < 100; m += F.G) {
        LAS float* red = (LAS float*)F.lds;
        const float* W; int N;
        if (m < 2) { W = p.w_in + (size_t)m * DM * INW; N = INW; }
        else if (m >= 98) { W = p.w_out + (size_t)(m - 98) * DM * DM; N = DM; }
        else if (m >= 66) { W = p.w_down + (size_t)(m - 66) * DEXP * DM; N = DM; }
        else { const int le = (m - 2) >> 1; W = ((m & 1) ? p.w_up : p.w_gate) + (size_t)le * DM * DEXP; N = DEXP; }
        float ss = 0.f;
        for (int i = F.tid; i < 8 * N; i += NTHR) { const float v = W[i]; ss += v * v; }
        ss = wave_sum(ss);
        if (F.lane == 0) red[F.wave] = ss;
        __syncthreads();
        if (F.tid == 0) { float t = 0.f;
#pragma unroll
            for (int w = 0; w < 8; ++w) t += red[w];
            F.wsc[m] = fmaxf(6.0f * sqrtf(t / (float)(8 * N)) * (1.f / 127.f), 1e-30f); }
        __syncthreads();
    }
}

__device__ __forceinline__ void row_ptrs(const Params& p, const Ctx& F, const int l, const int b, const int t, const float*& xs, float*& xd) {
    const unsigned long long blat = (l <= 1) ? (unsigned long long)p.x : (unsigned long long)p.out, bctx = (l <= 1) ? (unsigned long long)p.ctx : (unsigned long long)F.xc;
    const bool isctx = t < CTXL;
    const size_t roff = isctx ? ((size_t)b * CTXL + t) * DM : ((size_t)b * SEQ + (t - CTXL)) * DM;
    xs = (const float*)(isctx ? bctx : blat) + roff;
    xd = (isctx ? F.xc : p.out) + roff;
}
__device__ __forceinline__ void gather_y1(const Ctx& F, const int s, f32x4 (&acc)[8]) {
#pragma unroll
    for (int j = 0; j < 8; ++j) acc[j] = (f32x4){0.f, 0.f, 0.f, 0.f};
#pragma unroll 2
    for (int e = 0; e < 16; ++e) { const int se = __builtin_amdgcn_readlane(s, e);
        if (se >= 0) { const unsigned char* yr = F.y8 + (size_t)se * DM + 4 * F.lane;
#pragma unroll
            for (int j = 0; j < 8; ++j) { const unsigned w = __builtin_nontemporal_load((const unsigned*)(yr + 256 * j)); acc[j] += unpack_f8x4(w); } } }
}
__device__ __forceinline__ void gather_y(const Ctx& F, const int s, f32x4 (&acc)[8]) {
#pragma unroll
    for (int j = 0; j < 8; ++j) acc[j] = (f32x4){0.f, 0.f, 0.f, 0.f};
    unsigned m = (unsigned)__ballot(s >= 0) & 0xffffu;
    while (m) {
        const int e0 = __builtin_ctz(m); m &= m - 1;
        const bool two = m != 0; const int e1 = two ? __builtin_ctz(m) : e0; if (two) m &= m - 1;
        const int s0 = __builtin_amdgcn_readlane(s, e0), s1 = __builtin_amdgcn_readlane(s, e1);
        const unsigned char* y0 = F.y8 + (size_t)s0 * DM + 4 * F.lane; const unsigned char* y1 = F.y8 + (size_t)s1 * DM + 4 * F.lane;
        unsigned w0[8], w1[8];
#pragma unroll
        for (int j = 0; j < 8; ++j) w0[j] = __builtin_nontemporal_load((const unsigned*)(y0 + 256 * j));
#pragma unroll
        for (int j = 0; j < 8; ++j) w1[j] = __builtin_nontemporal_load((const unsigned*)(y1 + 256 * j));
        const float k1 = two ? 1.f : 0.f;
#pragma unroll
        for (int j = 0; j < 8; ++j) { acc[j] += unpack_f8x4(w0[j]); acc[j] += unpack_f8x4(w1[j]) * k1; }
    }
}
__device__ __forceinline__ void phase_norm1(const Params& p, const Ctx& F, const int l) {
    const bool fin = (l == 2), comb = (l > 0);
    if (l == 0) { LAS float* scr = (LAS float*)(F.lds + F.wave * 16640); for (int it = F.gw; it < CV_FIRST; it += F.NGW) conv_item(p, F, scr, it, F.lane); }
    const int b = F.gw & 7, tstride = F.NGW >> 3;
    int cur_m = -1; f32x4 A[8], Bv[8];
    int t = F.gw >> 3; if (fin) { while (t < CTXL) t += tstride; }
    f32x4 vn[8], accn[8]; u32x2 dn[8]; int sn = -1;
#pragma unroll
    for (int j = 0; j < 8; ++j) dn[j] = (u32x2){0u, 0u};
#pragma unroll
    for (int j = 0; j < 8; ++j) accn[j] = (f32x4){0.f, 0.f, 0.f, 0.f};
    if (t < TPB) { const float* xs; float* xd; row_ptrs(p, F, l, b, t, xs, xd);
#pragma unroll
        for (int j = 0; j < 8; ++j) vn[j] = __builtin_nontemporal_load((const f32x4*)xs + F.lane + 64 * j);
        if (comb) {
#pragma unroll
            for (int j = 0; j < 8; ++j) dn[j] = __builtin_nontemporal_load((const u32x2*)(F.dlt + ((size_t)b * TPB + t) * DM + 4 * F.lane + 256 * j)); }
        if (comb) { int s0 = -1; if (F.lane < 16) s0 = F.slot[(unsigned)((b * 16 + F.lane) * TPB + t)]; { if (fin) gather_y1(F, s0, accn); else gather_y(F, s0, accn); }
            if (t + tstride < TPB && F.lane < 16) sn = F.slot[(unsigned)((b * 16 + F.lane) * TPB + t + tstride)]; } }
    for (; t < TPB; t += tstride) {
        const bool isctx = t < CTXL;
        const int mrow = isctx ? 8 : b;
        const float* xs; float* xd; row_ptrs(p, F, l, b, t, xs, xd);
        f32x4 v[8];
#pragma unroll
        for (int j = 0; j < 8; ++j) v[j] = vn[j] + (f32x4){bflo(dn[j].x), bfhi(dn[j].x), bflo(dn[j].y), bfhi(dn[j].y)};
        if (comb) {
            const float* gt = F.mod + (size_t)((l - 1) * 9 + mrow) * MODW + 5 * DM;
#pragma unroll
            for (int j = 0; j < 8; ++j) { v[j] += *((const f32x4*)gt + F.lane + 64 * j) * accn[j] * (1.f / Y_SCALE); if (!fin) *((f32x4*)xd + F.lane + 64 * j) = v[j]; }
        }
        { const int t2 = t + tstride;
          if (t2 < TPB) { const float* xs2; float* xd2; row_ptrs(p, F, l, b, t2, xs2, xd2);
#pragma unroll
            for (int j = 0; j < 8; ++j) vn[j] = __builtin_nontemporal_load((const f32x4*)xs2 + F.lane + 64 * j);
            if (comb) {
#pragma unroll
                for (int j = 0; j < 8; ++j) dn[j] = __builtin_nontemporal_load((const u32x2*)(F.dlt + ((size_t)b * TPB + t2) * DM + 4 * F.lane + 256 * j)); }
            if (comb) { { if (fin) gather_y1(F, sn, accn); else gather_y(F, sn, accn); } const int t3 = t2 + tstride; sn = -1; if (t3 < TPB && F.lane < 16) sn = F.slot[(unsigned)((b * 16 + F.lane) * TPB + t3)]; } } }
        if (mrow != cur_m) { cur_m = mrow;
            if (!fin) {
                const float* mr = F.mod + (size_t)(l * 9 + mrow) * MODW;
#pragma unroll
                for (int j = 0; j < 8; ++j) { const f32x4 g = *((const f32x4*)(p.g_mix + l * DM) + F.lane + 64 * j), sc = *((const f32x4*)(mr + DM) + F.lane + 64 * j);
                    A[j] = g * (sc + 1.f); Bv[j] = *((const f32x4*)mr + F.lane + 64 * j); }
            }
        }
        float ss = 0.f;
#pragma unroll
        for (int j = 0; j < 8; ++j) ss += (v[j].x * v[j].x + v[j].y * v[j].y) + (v[j].z * v[j].z + v[j].w * v[j].w);
        const float rstd = rsqrtf(wave_sum(ss) * (1.f / DM) + EPS);
        if (fin) {
#pragma unroll
            for (int j = 0; j < 8; ++j) __builtin_nontemporal_store(v[j] * rstd * *((const f32x4*)p.g_final + F.lane + 64 * j), (f32x4*)xd + F.lane + 64 * j);
        } else {
            float am = 0.f;
#pragma unroll
            for (int j = 0; j < 8; ++j) { v[j] = v[j] * rstd * A[j] + Bv[j]; am = fmaxf(am, amax4(v[j])); }
            am = fmaxf(wave_max(am), 1e-20f); const float inv = 127.f / am;
            unsigned* xn = (unsigned*)((signed char*)F.r1 + ((size_t)b * TPB + t) * DM) + F.lane;
#pragma unroll
            for (int j = 0; j < 8; ++j) __builtin_nontemporal_store(pack_i8x4(v[j].x, v[j].y, v[j].z, v[j].w, inv), xn + 64 * j);
            if (F.lane == 0) F.sax[b * TPB + t] = am * (1.f / 127.f);
        }
    }
}

__device__ __forceinline__ void v8_tiles_n(const Ctx& F, const int col0, const int nh, unsigned char* dstb) {
        for (int it = F.gw; it < NB * nh * 68; it += F.NGW) {
            const int tile = it % 68, bk = it / 68, kvh = bk % nh, b = bk / nh;
            const bf16_t* srcv = F.r2 + (size_t)(b * TPB + tile * 64) * INW + col0 + kvh * 128 + 2 * F.lane;
            unsigned w[64];
#pragma unroll
            for (int kk = 0; kk < 64; ++kk) w[kk] = *(const unsigned*)(srcv + (size_t)kk * INW);
            unsigned char* dst = dstb + (size_t)it * 8192 + F.lane * 128;
#pragma unroll
            for (int half = 0; half < 2; ++half)
#pragma unroll
                for (int q = 0; q < 4; ++q) { u32x4 o;
#pragma unroll
                    for (int a = 0; a < 4; ++a) { const int s0 = 16 * q + 4 * a, hi_ = s0 >> 5, j = s0 & 31, key = 32 * (j >> 4) + 8 * ((j >> 2) & 3) + 4 * hi_;
                        float f[4];
#pragma unroll
                        for (int i = 0; i < 4; ++i) f[i] = half ? bfhi(w[key + i]) : bflo(w[key + i]);
                        o[a] = pack_f8x4(f[0], f[1], f[2], f[3], 1.f); }
                    *(u32x4*)(dst + half * 64 + q * 16) = o; }
        }
}
__device__ __forceinline__ void v8_tiles(const Ctx& F) { v8_tiles_n(F, 1280, 2, F.v8); }
__device__ __forceinline__ void phase_qkfix(const Params& p, const Ctx& F, const int l) {
    LAS f32x2* cs = (LAS f32x2*)F.lds;
    for (int i = F.tid; i < 2048; i += NTHR) { const int pp = i >> 5, fi = i & 31; const float inv = exp2f(-(float)fi * (13.287712379549449f / 32.f)); const float ang = (float)pp * inv;
        cs[i] = (f32x2){__cosf(ang), __sinf(ang)}; }
    __syncthreads();
    const int NV = l == 0 ? 26 : 2, nrows = l == 0 ? NB * SEQ : NROWS;
    const long total = (long)nrows * NV;
    const int sub = F.lane >> 4, jl = F.lane & 15, ax = jl >> 3, f0 = (jl & 7) * 4;
    for (long V0 = (long)F.gw * 4; V0 < total; V0 += (long)F.NGW * 4) {
        const long V = V0 + sub; const bool valid = V < total; const long Vc = valid ? V : 0;
        const int rr = (int)(Vc / NV), v = (int)(Vc % NV);
        int R, pos; bool lat;
        if (l == 0) { const int b = rr >> 12, s = rr & 4095; R = b * TPB + CTXL + s; pos = s; lat = true; }
        else { R = rr; const int t = rr % TPB; lat = t >= CTXL; pos = t - CTXL; }
        const int col = l == 0 ? v * 128 + (v >= 10 ? 256 : 0) : (8 + v) * 128;
        bf16_t* ptr = F.r2 + (size_t)R * INW + col + ax * 64 + f0;
        const u32x2 wl = *(const u32x2*)ptr, wh = *(const u32x2*)(ptr + 32);
        float xl[4] = {bflo(wl.x), bfhi(wl.x), bflo(wl.y), bfhi(wl.y)}, xh[4] = {bflo(wh.x), bfhi(wh.x), bflo(wh.y), bfhi(wh.y)};
        if (l == 1) {
            float ss = 0.f;
#pragma unroll
            for (int q = 0; q < 4; ++q) ss += xl[q] * xl[q] + xh[q] * xh[q];
            ss += __shfl_xor(ss, 1); ss += __shfl_xor(ss, 2); ss += __shfl_xor(ss, 4); ss += __shfl_xor(ss, 8);
            const float rstd = rsqrtf(ss * (1.f / 128.f) + EPS);
            const float* g = p.kn + ax * 64 + f0;
#pragma unroll
            for (int q = 0; q < 4; ++q) { xl[q] = xl[q] * rstd * g[q]; xh[q] = xh[q] * rstd * g[32 + q]; }
        }
        if (lat) {
            const int pp = ax == 0 ? (pos >> 6) : (pos & 63);
#pragma unroll
            for (int q = 0; q < 4; ++q) { const f32x2 c = cs[pp * 32 + f0 + q]; const float a = xl[q], bq = xh[q]; xl[q] = a * c.x - bq * c.y; xh[q] = bq * c.x + a * c.y; }
        }
        if (valid) {
            if (l == 0) { u32x2 o; o.x = cvtpk(xl[0], xl[1]); o.y = cvtpk(xl[2], xl[3]); *(u32x2*)ptr = o; o.x = cvtpk(xh[0], xh[1]); o.y = cvtpk(xh[2], xh[3]); *(u32x2*)(ptr + 32) = o; }
            else { unsigned char* k8 = F.k8 + ((size_t)v * NROWS + R) * 128 + ax * 64 + (f0 >> 4) * 32 + (f0 & 15);
                *(unsigned*)k8 = pack_f8x4(xl[0], xl[1], xl[2], xl[3], 1.f); *(unsigned*)(k8 + 16) = pack_f8x4(xh[0], xh[1], xh[2], xh[3], 1.f); } }
    }
    if (l == 1) v8_tiles(F);
}

__device__ __forceinline__ void bfinal_tile(const Params& p, const Ctx& F, const int qrow0, const int h) {
    int t2 = threadIdx.x; asm volatile("" : "+v"(t2));
    const int lane = t2 & 63, wave = __builtin_amdgcn_readfirstlane(t2 >> 6);
    const float lam_init = 0.2f;
    float s1 = p.lq1[lane] * p.lk1[lane] + p.lq1[lane + 64] * p.lk1[lane + 64], s2 = p.lq2[lane] * p.lk2[lane] + p.lq2[lane + 64] * p.lk2[lane + 64];
    s1 = wave_sum(s1); s2 = wave_sum(s2);
    const float lam = expf(s1) - expf(s2) + lam_init;
    const int sub = lane >> 4, jl = lane & 15;
    f32x4 g[4];
#pragma unroll
    for (int q = 0; q < 4; ++q) g[q] = *(const f32x4*)(p.subln + jl * 4 + 64 * q) * (1.f - lam_init);
    for (int it = 0; it < 8; ++it) {
        const int R = qrow0 + wave * 32 + it * 4 + sub;
        const float* o1 = F.ob + (size_t)R * DM + h * 512 + jl * 4; const float* o2 = o1 + 256;
        f32x4 v[4]; float ss = 0.f;
#pragma unroll
        for (int q = 0; q < 4; ++q) { v[q] = *(const f32x4*)(o1 + 64 * q) - lam * *(const f32x4*)(o2 + 64 * q); ss += (v[q].x * v[q].x + v[q].y * v[q].y) + (v[q].z * v[q].z + v[q].w * v[q].w); }
        ss += __shfl_xor(ss, 1); ss += __shfl_xor(ss, 2); ss += __shfl_xor(ss, 4); ss += __shfl_xor(ss, 8);
        const float rstd = rsqrtf(ss * (1.f / 256.f) + EPS);
        bf16_t* o = F.r1 + (size_t)R * DM + 1024 + h * 256 + jl * 4;
#pragma unroll
        for (int q = 0; q < 4; ++q) { const f32x4 y = v[q] * rstd * g[q]; u32x2 w; w.x = cvtpk(y.x, y.y); w.y = cvtpk(y.z, y.w); *(u32x2*)(o + 64 * q) = w; }
    }
}

__device__ __forceinline__ void phase_attn(const Params& p, const Ctx& F, const int l) {
    LAS char* lds = (LAS char*)F.lds;
    if (l == 1) { LAS float* bt = (LAS float*)(lds + att::BIAS_OFF);
        for (int i = F.tid; i < 8 * 480; i += NTHR) { const int h = i / 480, rem = i % 480, ro = rem >> 5, cc = rem & 31; bt[i] = cc < 31 ? p.rpb[(h * 15 + ro) * 31 + cc] * 1.4426950408889634f : 0.f; }
        __syncthreads(); }
    const int vcu = (F.G % 8 == 0) ? (F.bid % 8) * (F.G / 8) + F.bid / 8 : F.bid;
    constexpr int CV_PER_UNIT = 3;
    int cv_it = CV_FIRST + F.gw, cv_slot = 0;
    unsigned* a8cnt = (unsigned*)(p.ws + WS_CTL) + 8192;
    if (l == 0) {
        { const int sub = F.lane >> 4, jl = F.lane & 15;
          for (int it = F.gw * 4 + sub; it < NROWS * 2; it += F.NGW * 4) { const int R = it >> 1, kvh = it & 1;
            const u32x4 w = *(const u32x4*)(F.r2 + (size_t)R * INW + 1024 + kvh * 128 + jl * 8);
            u32x2 o; o.x = pack_f8x4(bflo(w.x), bfhi(w.x), bflo(w.y), bfhi(w.y), 1.f); o.y = pack_f8x4(bflo(w.z), bfhi(w.z), bflo(w.w), bfhi(w.w), 1.f);
            *(u32x2*)(F.k8 + ((size_t)kvh * NROWS + R) * 128 + jl * 8) = o; } }
        v8_tiles(F);
        { const int sub = F.lane >> 4, jl = F.lane & 15;
          for (int it = F.gw * 4 + sub; it < NROWS * 8; it += F.NGW * 4) { const int R = it >> 3, h = it & 7;
            const u32x4 w = *(const u32x4*)(F.r2 + (size_t)R * INW + 2560 + h * 128 + jl * 8);
            u32x2 o; o.x = pack_f8x4(bflo(w.x), bfhi(w.x), bflo(w.y), bfhi(w.y), 1.f); o.y = pack_f8x4(bflo(w.z), bfhi(w.z), bflo(w.w), bfhi(w.w), 1.f);
            *(u32x2*)(F.k8d + ((size_t)h * NROWS + R) * 128 + jl * 8) = o; } }
        v8_tiles_n(F, 3584, 8, F.v8d);
        asm volatile("s_waitcnt vmcnt(0)" ::: "memory"); __syncthreads();
        if (F.tid == 0) { __builtin_amdgcn_fence(__ATOMIC_RELEASE, "agent"); __hip_atomic_fetch_add(a8cnt, 1u, __ATOMIC_RELAXED, __HIP_MEMORY_SCOPE_AGENT); }
    }
    {
    if (l == 0) {
        for (int su = vcu; su < 544; su += F.G) {
            const bool lat = su < 512; int b, h, qt;
            if (lat) { qt = su & 15; h = (su >> 4) & 3; b = su >> 6; } else { const int uu = su - 512; qt = 0; h = uu & 3; b = uu >> 2; }
            const int qrow0 = b * TPB + (lat ? CTXL + qt * 256 : 0);
            for (int sp = 0; sp < 4; ++sp) {
                att::AUnit u; u.mode = 0; u.pa = 0; u.pb = 0; u.head = 0; u.has_sink = 0; u.sink = 0.f; u.seg2row = CTXL; u.kbase = b * TPB; u.outf32 = 1;
                if (false) {
                    const int mp = 0, rh = sp & 1;
                    u.qrow0 = qrow0 + rh * 128; u.qcol = 1536 + h * 256 + mp * 128; u.kcol = 2560 + h * 256 + mp * 128; u.vcol = 3584 + h * 256; u.NT = 68; u.ocol = h * 512 + mp * 256;
                    att::attn_unit_b(u, F.r2, F.ob, lds);
                } else if (lat) {
                    const int vh = sp & 1, mp = sp >> 1;
                    if (sp == 0) { if (F.tid == 0) { unsigned spn = 0; while (__hip_atomic_load(a8cnt, __ATOMIC_RELAXED, __HIP_MEMORY_SCOPE_AGENT) < (unsigned)F.G) { __builtin_amdgcn_s_sleep(2); if (++spn > (1u << 24)) break; }
                            __builtin_amdgcn_fence(__ATOMIC_ACQUIRE, "agent"); }
                        __syncthreads(); }
                    u.qrow0 = qrow0; u.qcol = 1536 + h * 256 + mp * 128; u.NT = 68; u.ocol = h * 512 + mp * 256 + vh * 128;
                    att::attn_unit_c8<3>(u, F.r2, F.k8d + ((size_t)(h * 2 + mp) * NROWS + u.kbase) * 128, F.v8d + (size_t)(b * 8 + h * 2 + vh) * (68 * 8192), nullptr, (bf16_t*)F.ob, lds);
                } else {
                    const int mp = sp >> 1, vh = sp & 1;
                    u.qrow0 = qrow0; u.qcol = 1536 + h * 256 + mp * 128; u.NT = 4; u.ocol = h * 512 + mp * 256 + vh * 128;
                    att::attn_unit_c8<3>(u, F.r2, F.k8d + ((size_t)(h * 2 + mp) * NROWS + u.kbase) * 128, F.v8d + (size_t)(b * 8 + h * 2 + vh) * (68 * 8192), nullptr, (bf16_t*)F.ob, lds);
                }
                if (((cv_slot++ ^ vcu) & 1) == 0) { conv_some(p, F, cv_it, 2 * CV_PER_UNIT); __syncthreads(); }
            }
            VM_WAIT(); __syncthreads();
            bfinal_tile(p, F, qrow0, h);
        }
        for (int ui = vcu; ui < 64; ui += F.G) {
            att::AUnit u; u.mode = 0; u.pa = 0; u.pb = 0; u.head = 0; u.outf32 = 0; u.seg2row = CTXL;
            const int h = ui & 7, b = ui >> 3;
            u.qrow0 = b * TPB; u.kbase = b * TPB;
            u.qcol = h * 128; u.kcol = 1024 + (h >> 2) * 128; u.vcol = 1280 + (h >> 2) * 128; u.ocol = h * 128;
            u.has_sink = 1; u.sink = p.a_sink[h]; u.NT = 4;
            att::attn_unit<0, 1>(u, F.r2, F.r1, F.ob, lds);
        }
    } else {
        for (int ui = vcu; ui < 1024; ui += F.G) {
            att::AUnit u; u.mode = 0; u.pa = 0; u.pb = 0; u.head = 0; u.has_sink = 0; u.sink = 0.f; u.outf32 = 0; u.seg2row = CTXL; u.NT = 68;
            const int qt = ui & 15, h = (ui >> 4) & 7, b = ui >> 7;
            u.qrow0 = b * TPB + CTXL + qt * 256; u.kbase = b * TPB;
            u.qcol = h * 128; u.kcol = 1024 + (h >> 2) * 128; u.vcol = 1280 + (h >> 2) * 128; u.ocol = h * 128;
            u.pa = qt * 256;
            att::attn_unit_c8<0>(u, F.r2, F.k8 + ((size_t)(h >> 2) * NROWS + u.kbase) * 128, F.v8 + (size_t)(b * 2 + (h >> 2)) * (68 * 8192), p.qn, (bf16_t*)F.o8, lds);
        }
    } }
    if (l == 0) {
    if (F.tid == 0) { unsigned sp = 0; while (__hip_atomic_load(a8cnt, __ATOMIC_RELAXED, __HIP_MEMORY_SCOPE_AGENT) < (unsigned)F.G) { __builtin_amdgcn_s_sleep(2); if (++sp > (1u << 24)) break; }
        __builtin_amdgcn_fence(__ATOMIC_ACQUIRE, "agent"); }
    __syncthreads();
    for (int ui = vcu; ui < 1024; ui += F.G) {
        att::AUnit u; u.mode = 1; u.head = 0; u.outf32 = 0;
        const int qt = ui & 15, h = (ui >> 4) & 7, b = ui >> 7;
        u.qrow0 = b * TPB + CTXL + qt * 256; u.kbase = b * TPB;
        u.qcol = h * 128; u.kcol = 1024 + (h >> 2) * 128; u.vcol = 1280 + (h >> 2) * 128; u.ocol = h * 128;
        u.has_sink = 1; u.sink = p.a_sink[h];
        const int s0 = qt * 256, lo = max(0, s0 - 128), hi2 = min(SEQ, s0 + 384); u.NT = 4 + (hi2 - lo) / 64; u.seg2row = CTXL + lo; u.pa = s0; u.pb = lo;
        att::attn_unit_c8<1>(u, F.r2, F.k8 + ((size_t)(h >> 2) * NROWS + u.kbase) * 128, F.v8 + (size_t)(b * 2 + (h >> 2)) * (68 * 8192), nullptr, F.r1, lds);
        if (((cv_slot++ ^ vcu) & 1) == 0) { conv_some(p, F, cv_it, 2 * CV_PER_UNIT); __syncthreads(); }
    }
    conv_some(p, F, cv_it, 1 << 20);
    __syncthreads(); }
    else {
    for (int ui = vcu; ui < 1024; ui += F.G) {
        att::AUnit u; u.mode = 2; u.has_sink = 0; u.sink = 0.f; u.outf32 = 0;
        const int qt = ui & 15, h = (ui >> 4) & 7, b = ui >> 7;
        u.qrow0 = b * TPB + CTXL + qt * 256; u.kbase = b * TPB;
        u.qcol = 1536 + h * 128; u.kcol = 2560 + h * 128; u.vcol = 3584 + h * 128; u.ocol = 1024 + h * 128; u.head = h;
        const int r0 = qt * 4; int lo = min(max(r0 - 4, 0), 56), hi2 = min(max(r0 - 1, 0), 56) + 7; if (((hi2 - lo + 1) & 1) != 0) { if (hi2 < 63) ++hi2; else --lo; }
        u.NT = 4 + (hi2 - lo + 1); u.seg2row = CTXL + lo * 64; u.pa = r0; u.pb = lo;
        att::attn_unit<2, 1>(u, F.r2, (bf16_t*)F.o8, F.ob, lds);
    } }
}

__device__ __forceinline__ void router_tail(const Ctx& F, const float (&lg)[16], const int b, const int t, const bool valid) {
    const bool b5 = (F.lane & 32) != 0, b4 = (F.lane & 16) != 0, b3 = (F.lane & 8) != 0, b2 = (F.lane & 4) != 0;
    float r8[8], r4[4], r2[2];
#pragma unroll
    for (int e = 0; e < 8; ++e) { const float keep = b5 ? lg[e + 8] : lg[e], send = b5 ? lg[e] : lg[e + 8]; r8[e] = keep + __shfl_xor(send, 32); }
#pragma unroll
    for (int e = 0; e < 4; ++e) { const float keep = b4 ? r8[e + 4] : r8[e], send = b4 ? r8[e] : r8[e + 4]; r4[e] = keep + __shfl_xor(send, 16); }
#pragma unroll
    for (int e = 0; e < 2; ++e) { const float keep = b3 ? r4[e + 2] : r4[e], send = b3 ? r4[e] : r4[e + 2]; r2[e] = keep + __shfl_xor(send, 8); }
    float lgt; { const float keep = b2 ? r2[1] : r2[0], send = b2 ? r2[0] : r2[1]; lgt = keep + __shfl_xor(send, 4); }
    lgt += __shfl_xor(lgt, 2); lgt += __shfl_xor(lgt, 1);
    float mx = lgt;
    mx = fmaxf(mx, __shfl_xor(mx, 4)); mx = fmaxf(mx, __shfl_xor(mx, 8)); mx = fmaxf(mx, __shfl_xor(mx, 16)); mx = fmaxf(mx, __shfl_xor(mx, 32));
    const float ex = expf(lgt - mx); float sum = ex;
    sum += __shfl_xor(sum, 4); sum += __shfl_xor(sum, 8); sum += __shfl_xor(sum, 16); sum += __shfl_xor(sum, 32);
    if (valid && (F.lane & 3) == 0) { const float af = ex / sum; const int e = F.lane >> 2;
        if (t < CTXL) F.affc[((size_t)(b * 16 + e)) * CTXL + t] = af; else F.affl[((size_t)(b * 16 + e)) * SEQ + (t - CTXL)] = af; }
}
__device__ __forceinline__ void phase_norm2(const Params& p, const Ctx& F, const int l) {
    LAS float* wr = (LAS float*)F.lds;
    for (int i = F.tid; i < DM * NEXP; i += NTHR) { const int d = i >> 4, e = i & 15; wr[e * DM + d] = p.w_router[(size_t)l * DM * NEXP + i]; }
    __syncthreads();
    const int b = F.gw & 7, tstride = F.NGW >> 3;
    int cur_m = -1; f32x4 A[8], Bv[8];
    int t = F.gw >> 3; if (l == 1) { while (t < CTXL) t += tstride; }
    while (t < TPB) {
        const bool isctx = t < CTXL;
        const int mrow = isctx ? 8 : b;
        const int tB = t + tstride;
        const bool two = !isctx && tB < TPB;
        f32x2 vv[8][4];
        { const float* xlat = l == 0 ? p.x : p.out; const float* xctx = l == 0 ? p.ctx : F.xc;
          const float* xs0 = isctx ? xctx + ((size_t)b * CTXL + t) * DM : xlat + ((size_t)b * SEQ + (t - CTXL)) * DM;
          const float* xs1 = two ? xlat + ((size_t)b * SEQ + (tB - CTXL)) * DM : xs0;
          const bf16_t* d0p = F.dlt + ((size_t)b * TPB + t) * DM + 4 * F.lane; const bf16_t* d1p = F.dlt + ((size_t)b * TPB + (two ? tB : t)) * DM + 4 * F.lane;
#pragma unroll
          for (int j = 0; j < 8; ++j) { f32x4 x0 = __builtin_nontemporal_load((const f32x4*)xs0 + F.lane + 64 * j), x1 = __builtin_nontemporal_load((const f32x4*)xs1 + F.lane + 64 * j);
              const u32x2 e0 = __builtin_nontemporal_load((const u32x2*)(d0p + 256 * j)), e1 = __builtin_nontemporal_load((const u32x2*)(d1p + 256 * j));
              x0 += (f32x4){bflo(e0.x), bfhi(e0.x), bflo(e0.y), bfhi(e0.y)}; x1 += (f32x4){bflo(e1.x), bfhi(e1.x), bflo(e1.y), bfhi(e1.y)};
#pragma unroll
              for (int c = 0; c < 4; ++c) vv[j][c] = (f32x2){x0[c], x1[c]}; } }
        if (mrow != cur_m) { cur_m = mrow; const float* mr = F.mod + (size_t)(l * 9 + mrow) * MODW;
#pragma unroll
            for (int j = 0; j < 8; ++j) { const f32x4 g = *((const f32x4*)(p.g_ffn + l * DM) + F.lane + 64 * j), sc = *((const f32x4*)(mr + 4 * DM) + F.lane + 64 * j);
                A[j] = g * (sc + 1.f); Bv[j] = *((const f32x4*)(mr + 3 * DM) + F.lane + 64 * j); } }
        f32x2 ss = {0.f, 0.f};
#pragma unroll
        for (int j = 0; j < 8; ++j)
#pragma unroll
            for (int c = 0; c < 4; ++c) ss += vv[j][c] * vv[j][c];
        const f32x2 rstd = {rsqrtf(wave_sum(ss.x) * (1.f / DM) + EPS), rsqrtf(wave_sum(ss.y) * (1.f / DM) + EPS)};
        f32x2 am = {0.f, 0.f};
#pragma unroll
        for (int j = 0; j < 8; ++j)
#pragma unroll
            for (int c = 0; c < 4; ++c) { vv[j][c] = vv[j][c] * rstd * A[j][c] + Bv[j][c]; am = __builtin_elementwise_max(am, __builtin_elementwise_abs(vv[j][c])); }
        const float am0 = fmaxf(wave_max(am.x), 1e-20f), am1 = fmaxf(wave_max(am.y), 1e-20f), inv0 = 127.f / am0, inv1 = 127.f / am1;
        unsigned* hn0 = (unsigned*)((signed char*)F.r1 + ((size_t)b * TPB + t) * DM) + F.lane;
        unsigned* hn1 = (unsigned*)((signed char*)F.r1 + ((size_t)b * TPB + (two ? tB : t)) * DM) + F.lane;
#pragma unroll
        for (int j = 0; j < 8; ++j) { __builtin_nontemporal_store(pack_i8x4(vv[j][0].x, vv[j][1].x, vv[j][2].x, vv[j][3].x, inv0), hn0 + 64 * j);
            if (two) __builtin_nontemporal_store(pack_i8x4(vv[j][0].y, vv[j][1].y, vv[j][2].y, vv[j][3].y, inv1), hn1 + 64 * j); }
        if (F.lane == 0) { F.sah[b * TPB + t] = am0 * (1.f / 127.f); if (two) F.sah[b * TPB + tB] = am1 * (1.f / 127.f); }
        f32x2 lg[16];
        unsigned wro = (unsigned)(uintptr_t)wr; asm volatile("" : "+v"(wro));
        const LAS float* wr2 = (const LAS float*)(uintptr_t)wro;
#pragma unroll
        for (int e = 0; e < 16; ++e) { f32x2 a = {0.f, 0.f};
#pragma unroll
            for (int j = 0; j < 8; ++j) { const f32x4 w = *((const LAS f32x4*)(wr2 + e * DM) + F.lane + 64 * j);
#pragma unroll
                for (int c = 0; c < 4; ++c) a += vv[j][c] * w[c]; }
            lg[e] = a; }
        float lg0[16], lg1[16];
#pragma unroll
        for (int e = 0; e < 16; ++e) { lg0[e] = lg[e].x; lg1[e] = lg[e].y; }
        router_tail(F, lg0, b, t, true);
        router_tail(F, lg1, b, tB, two);
        t += two ? 2 * tstride : tstride;
    }
}

__device__ __forceinline__ void phase_oq(const Params& p, const Ctx& F, const int l) {
    for (int R = F.gw; R < NROWS; R += F.NGW) {
        if (l == 1 && (R % TPB) < CTXL) continue;
        const bf16_t* src = F.r1 + (size_t)R * DM + 8 * F.lane;
        u32x4 w[4];
#pragma unroll
        for (int j = 0; j < 4; ++j) w[j] = __builtin_nontemporal_load((const u32x4*)(src + 512 * j));
        float v[4][8], am = 0.f;
#pragma unroll
        for (int j = 0; j < 4; ++j) { v[j][0] = bflo(w[j].x); v[j][1] = bfhi(w[j].x); v[j][2] = bflo(w[j].y); v[j][3] = bfhi(w[j].y); v[j][4] = bflo(w[j].z); v[j][5] = bfhi(w[j].z); v[j][6] = bflo(w[j].w); v[j][7] = bfhi(w[j].w);
#pragma unroll
            for (int q = 0; q < 8; ++q) am = fmaxf(am, fabsf(v[j][q])); }
        am = fmaxf(wave_max(am), 1e-20f); const float inv = 127.f / am;
        signed char* dst = F.o8 + (size_t)R * DM + 8 * F.lane;
#pragma unroll
        for (int j = 0; j < 4; ++j) { u32x2 o; o.x = pack_i8x4(v[j][0], v[j][1], v[j][2], v[j][3], inv); o.y = pack_i8x4(v[j][4], v[j][5], v[j][6], v[j][7], inv); *(u32x2*)(dst + 512 * j) = o; }
        if (F.lane == 0) F.so[R] = am * (1.f / 127.f);
    }
}

__device__ __forceinline__ void phase_hidq(const Params& p, const Ctx& F, const int l) {
    const int nrows = 16 * (l == 0 ? 4352 : 4096);
    for (int R = F.gw; R < nrows; R += F.NGW) {
        const bf16_t* src = F.hid + (size_t)R * DEXP + 8 * F.lane;
        u32x4 w[3]; float v[3][8]; float am = 0.f;
#pragma unroll
        for (int j = 0; j < 3; ++j) w[j] = __builtin_nontemporal_load((const u32x4*)(src + 512 * j));
#pragma unroll
        for (int j = 0; j < 3; ++j) { v[j][0] = bflo(w[j].x); v[j][1] = bfhi(w[j].x); v[j][2] = bflo(w[j].y); v[j][3] = bfhi(w[j].y); v[j][4] = bflo(w[j].z); v[j][5] = bfhi(w[j].z); v[j][6] = bflo(w[j].w); v[j][7] = bfhi(w[j].w);
#pragma unroll
            for (int q = 0; q < 8; ++q) am = fmaxf(am, fabsf(v[j][q])); }
        am = fmaxf(wave_max(am), 1e-20f); const float inv = 127.f / am;
        signed char* dst = F.hid8 + (size_t)R * DEXP + 8 * F.lane;
#pragma unroll
        for (int j = 0; j < 3; ++j) { u32x2 o; o.x = pack_i8x4(v[j][0], v[j][1], v[j][2], v[j][3], inv); o.y = pack_i8x4(v[j][4], v[j][5], v[j][6], v[j][7], inv); *(u32x2*)(dst + 512 * j) = o; }
        if (F.lane == 0) F.shd[R] = am * (1.f / 127.f);
    }
}

__device__ __forceinline__ void phase_topk(const Params& p, const Ctx& F, const int l) {
    LAS unsigned* cnt = (LAS unsigned*)F.lds;
    const int nunits = l == 0 ? 256 : 128, mexp = l == 0 ? 4352 : 4096;
    for (int ui = F.bid; ui < nunits; ui += F.G) {
        const bool lat = ui < 128; const int uu = ui & 127, b = uu >> 4, e = uu & 15;
        const int ntok = lat ? SEQ : CTXL, cap = lat ? 512 : 32;
        const float* aff = lat ? F.affl + (size_t)(b * 16 + e) * SEQ : F.affc + (size_t)(b * 16 + e) * CTXL;
        const int rowbase = l == 0 ? (lat ? 256 + b * 512 : b * 32) : b * 512;
        if (F.tid < 64) cnt[F.tid] = 0u;
        unsigned key[8];
#pragma unroll
        for (int i = 0; i < 8; ++i) { const int n = i * NTHR + F.tid; key[i] = n < ntok ? __float_as_uint(aff[n]) : 0u; }
        __syncthreads();
        unsigned prefix = 0u;
        for (int bit = 30; bit >= 0; --bit) {
            const unsigned cand = prefix | (1u << bit); unsigned c = 0u;
#pragma unroll
            for (int i = 0; i < 8; ++i) c += (unsigned)__popcll(__ballot(key[i] >= cand));
            if (F.lane == 0) __hip_atomic_fetch_add(&cnt[bit], c, __ATOMIC_RELAXED, __HIP_MEMORY_SCOPE_WORKGROUP);
            __syncthreads();
            if (cnt[bit] >= (unsigned)cap) prefix = cand;
        }
#pragma unroll
        for (int i = 0; i < 8; ++i) { const int n = i * NTHR + F.tid;
            if (n < ntok) { int slot = -1;
                if (key[i] > prefix) slot = (int)__hip_atomic_fetch_add(&cnt[32], 1u, __ATOMIC_RELAXED, __HIP_MEMORY_SCOPE_WORKGROUP);
                key[i] = (key[i] > prefix) ? (0x80000000u | (unsigned)slot) : (key[i] == prefix ? 0x40000000u : 0u); } else key[i] = 0u; }
        __syncthreads();
        const unsigned cgt = cnt[32];
#pragma unroll
        for (int i = 0; i < 8; ++i) { const int n = i * NTHR + F.tid;
            if (n < ntok) { int slot = -1;
                if (key[i] & 0x80000000u) slot = (int)(key[i] & 0xffffu);
                else if (key[i] & 0x40000000u) { const unsigned s2 = cgt + __hip_atomic_fetch_add(&cnt[33], 1u, __ATOMIC_RELAXED, __HIP_MEMORY_SCOPE_WORKGROUP); if (s2 < (unsigned)cap) slot = (int)s2; }
                const int t = lat ? CTXL + n : n;
                int yrow = -1;
                if (slot >= 0) { const int rr = rowbase + slot; yrow = e * mexp + rr; F.rows[e * MEXP_MAX + rr] = b * TPB + t; F.gate[e * mexp + rr] = aff[n]; F.sas[e * mexp + rr] = F.sah[b * TPB + t]; }
                F.slot[((size_t)(b * 16 + e)) * TPB + t] = yrow; } }
        __syncthreads();
    }
}

__global__ void __launch_bounds__(NTHR, 2) fwd_kernel(Params p) {
    extern __shared__ __attribute__((aligned(16))) unsigned char lds_raw[];
    unsigned char* ws = p.ws;
    LAS unsigned char* const lds0 = (LAS unsigned char*)lds_raw;
    volatile LAS unsigned* lctl = (volatile LAS unsigned*)(lds0 + LCTL_OFF);
    if (threadIdx.x < 128) lctl[threadIdx.x] = 0u;
    __syncthreads();
#if MK_MULTI
#define GRID_BAR() do { } while (0)
#else
    XcdBarrier bar = xcd_barrier_post((unsigned*)(ws + WS_CTL) + 4096, lctl + 8);
#define GRID_BAR() xcd_barrier(bar)
#endif
    const int lo = p.ph_lo, hi = p.ph_hi;
#define IN(k) (lo <= (k) && (k) < hi)
#define SEAM(k) do { if (IN((k) + 1)) GRID_BAR(); } while (0)
#ifndef PHMASK
#define PHMASK 0xfff
#endif
#define EN(s) (((PHMASK) >> (s)) & 1)
#ifndef REP_PRO
#define REP_PRO 1
#endif
#ifndef REP_HEAVY
#define REP_HEAVY 1
#endif
#ifndef REP_THIN
#define REP_THIN 1
#endif
#ifndef REP_ATT
#define REP_ATT 1
#endif

    if (EN(0) && IN(0)) { for (int rep = 0; rep < REP_PRO; ++rep) { const Ctx F = make_ctx(p, lds0); phase_prologue(p, F); __syncthreads(); } SEAM(0); }

    for (int l = 0; l < 2; ++l) {
        const int pb = 1 + l * 11;
        const int mexp = l == 0 ? 4352 : 4096;
        if (EN(1) && IN(pb + 0)) { for (int rep = 0; rep < (l == 0 ? REP_THIN : 1); ++rep) { const Ctx F = make_ctx(p, lds0); phase_norm1(p, F, l); } SEAM(pb + 0); }
        if (EN(2) && IN(pb + 1)) {
            const Ctx F = make_ctx(p, lds0);
            pg8::DenseOrder S{NROWS / 256, INW / 256, F.G, F.bid, 0, (const char*)F.r1, (const char*)F.win + (size_t)l * INW * DM, (size_t)256 * DM};
            pg8::EpiP E{F.r2, l == 0 ? 1 : 0, F.sax, F.wsc[l]};
            for (int rep = 0; rep < REP_HEAVY; ++rep) pg8::gemm_phase<pg8::EpiP, pg8::DenseOrder, false, true>(F.tid, F.lds, nullptr, DM, S, E);
            SEAM(pb + 1);
        }
        if (EN(3) && IN(pb + 2) && l == 1) { const Ctx F = make_ctx(p, lds0); phase_qkfix(p, F, l); SEAM(pb + 2); }
        if (EN(4) && IN(pb + 3)) { for (int rep = 0; rep < REP_ATT; ++rep) { const Ctx F = make_ctx(p, lds0); phase_attn(p, F, l); } SEAM(pb + 3); }
        if (EN(6) && IN(pb + 4) && l == 0) { const Ctx F = make_ctx(p, lds0); phase_oq(p, F, l); SEAM(pb + 4); }
        if (EN(6) && IN(pb + 5)) {
            const Ctx F = make_ctx(p, lds0);
            pg8::DenseOrder S{l == 0 ? NROWS / 256 : NB * 16, DM / 256, F.G, F.bid, l, (const char*)F.o8, (const char*)F.wout + (size_t)l * DM * DM, (size_t)256 * DM};
            if (l == 0) { pg8::EpiDelta E{F.dlt, F.mod + (size_t)l * 9 * MODW, F.so, F.wsc[98 + l]};
                pg8::gemm_phase<pg8::EpiDelta, pg8::DenseOrder, false, true>(F.tid, F.lds, nullptr, DM, S, E); }
            else { pg8::EpiDelta E{F.dlt, F.mod + (size_t)l * 9 * MODW, nullptr, F.wsc[98 + l] * (1.f / O8_SCALE)};
                pg8::gemm_phase<pg8::EpiDelta, pg8::DenseOrder, false, true, true>(F.tid, F.lds, nullptr, DM, S, E); }
            SEAM(pb + 5);
        }
        if (EN(7) && IN(pb + 6)) { for (int rep = 0; rep < REP_THIN; ++rep) { const Ctx F = make_ctx(p, lds0); phase_norm2(p, F, l); __syncthreads(); } SEAM(pb + 6); }
        if (EN(8) && IN(pb + 7)) { for (int rep = 0; rep < REP_THIN; ++rep) { const Ctx F = make_ctx(p, lds0); phase_topk(p, F, l); } SEAM(pb + 7); }
        if (EN(9) && IN(pb + 8)) {
            const Ctx F = make_ctx(p, lds0);
            pg8::MoeOrder S{mexp / 256, 3072 / 256, F.G, F.bid, (const char*)F.r1, 0, (const char*)F.wgu + (size_t)l * NEXP * 3072 * DM, (size_t)3072 * DM, (size_t)256 * DM};
            LAS unsigned* tab = (LAS unsigned*)(F.lds + TAB_OFF);
            { unsigned rv[14];
#pragma unroll
              for (int i = 0; i < 14; ++i) { pg8::Unit u; rv[i] = 0u; if (S.next(i, u) && F.tid < 256) rv[i] = (unsigned)F.rows[u.e * MEXP_MAX + u.pm * 256 + F.tid]; }
#pragma unroll
              for (int i = 0; i < 14; ++i) if (F.tid < 256) tab[i * 256 + F.tid] = rv[i] * (unsigned)DM; }
            __syncthreads();
            pg8::EpiSwiglu E{(unsigned char*)F.hid8, mexp, F.sas, F.wsc + 2 + 32 * l};
            for (int rep = 0; rep < REP_HEAVY; ++rep) pg8::gemm_phase<pg8::EpiSwiglu, pg8::MoeOrder, true, true>(F.tid, F.lds, tab, DM, S, E);
            SEAM(pb + 8);
        }
        if (EN(10) && IN(pb + 10)) {
            const Ctx F = make_ctx(p, lds0);
            pg8::MoeOrder S{mexp / 256, DM / 256, F.G, F.bid, (const char*)F.hid8, (size_t)mexp * DEXP, (const char*)F.wdn + (size_t)l * NEXP * DM * DEXP, (size_t)DM * DEXP, (size_t)256 * DEXP};
            pg8::EpiDown E{F.y8, F.gate, mexp, F.wsc + 66 + 16 * l};
            pg8::gemm_phase<pg8::EpiDown, pg8::MoeOrder, false, true, true>(F.tid, F.lds, nullptr, DEXP, S, E);
            SEAM(pb + 10);
        }
    }
    if (EN(11) && IN(23)) { const Ctx F = make_ctx(p, lds0); phase_norm1(p, F, 2); }
#undef IN
#undef SEAM
}

extern "C" void kernel_launch(void* const* d_in, const int* in_sizes, int n_in, void* d_out, int out_size, void* d_ws, size_t ws_size, hipStream_t stream) {
    static int grid = 0;
    if (grid == 0) {
        if (n_in != 24 || out_size != NB * SEQ * DM || ws_size < WS_END) { fprintf(stderr, "kernel_launch: unexpected shapes: n_in %d out %d ws %zu (need %zu)\n", n_in, out_size, ws_size, (size_t)WS_END); grid = -1; return; }
        int dev = 0, cus = 0, per_cu = 0;
        if (hipGetDevice(&dev) != hipSuccess || hipDeviceGetAttribute(&cus, hipDeviceAttributeMultiprocessorCount, dev) != hipSuccess) { fprintf(stderr, "kernel_launch: device query failed\n"); grid = -1; return; }
        if (hipFuncSetAttribute((const void*)fwd_kernel, hipFuncAttributeMaxDynamicSharedMemorySize, LDS_BYTES) != hipSuccess) { fprintf(stderr, "kernel_launch: hipFuncSetAttribute failed\n"); grid = -1; return; }
        if (hipOccupancyMaxActiveBlocksPerMultiprocessor(&per_cu, (const void*)fwd_kernel, NTHR, LDS_BYTES) != hipSuccess || per_cu < 1) fprintf(stderr, "kernel_launch: note: occupancy query reports %d\n", per_cu);
        (void)hipGetLastError();
        grid = cus;
    }
    if (grid < 0) return;
    if (hipMemsetAsync((char*)d_ws + WS_CTL, 0, CTL_ZERO_BYTES, stream) != hipSuccess) { fprintf(stderr, "kernel_launch: memset failed\n"); return; }
    Params p{};
    const float** pp = (const float**)&p;
    for (int i = 0; i < 24; ++i) pp[i] = (const float*)d_in[i];
    p.out = (float*)d_out; p.ws = (unsigned char*)d_ws;
#if MK_MULTI
    for (int ph = 0; ph < 24; ++ph) { p.ph_lo = ph; p.ph_hi = ph + 1;
        hipLaunchKernelGGL(fwd_kernel, dim3(grid), dim3(NTHR), LDS_BYTES, stream, p); }
#elif defined(PROBE_K)
    p.ph_lo = 0; p.ph_hi = PROBE_K + 1;
    hipLaunchKernelGGL(fwd_kernel, dim3(grid), dim3(NTHR), LDS_BYTES, stream, p);
    (void)hipMemsetAsync((char*)d_ws + WS_CTL, 0, CTL_ZERO_BYTES, stream);
    p.ph_lo = PROBE_K2; p.ph_hi = 24;
    hipLaunchKernelGGL(fwd_kernel, dim3(grid), dim3(NTHR), LDS_BYTES, stream, p);
#else
    p.ph_lo = 0; p.ph_hi = 24;
    hipLaunchKernelGGL(fwd_kernel, dim3(grid), dim3(NTHR), LDS_BYTES, stream, p);
#endif
    const hipError_t le = hipPeekAtLastError();
    if (le != hipSuccess) fprintf(stderr, "kernel_launch: launch failed: %s\n", hipGetErrorName(le));
}
```

```cpp
#include <hip/hip_runtime.h>
#include <cstdio>
#include <cstdint>
#include <type_traits>

#ifndef MK_MULTI
#define MK_MULTI 0
#endif

#define LAS __attribute__((address_space(3)))
typedef unsigned short bf16_t;
typedef short bf16x8 __attribute__((ext_vector_type(8)));
typedef short s16x4 __attribute__((ext_vector_type(4)));
typedef float f32x4 __attribute__((ext_vector_type(4)));
typedef float f32x2 __attribute__((ext_vector_type(2)));
typedef float f32x16 __attribute__((ext_vector_type(16)));
typedef unsigned u32x4 __attribute__((ext_vector_type(4)));
typedef unsigned u32x2 __attribute__((ext_vector_type(2)));
typedef int i32x4 __attribute__((ext_vector_type(4)));
typedef int i32x8 __attribute__((ext_vector_type(8)));

constexpr int DM = 2048, NB = 8, SEQ = 4096, CTXL = 256, TPB = SEQ + CTXL, NROWS = NB * TPB;
constexpr int INW = 4608, NEXP = 16, DEXP = 1536, MODW = 6 * DM;
constexpr int MEXP_MAX = 4352;
constexpr float EPS = 1e-6f;
constexpr int NWAVES = 8, NTHR = 512;

constexpr size_t MiB = 1u << 20;
constexpr size_t WS_CTL = 0, CTL_ZERO_BYTES = 1 * MiB;
constexpr size_t WS_MOD = 1 * MiB;
constexpr size_t WS_AFFL = 2 * MiB;
constexpr size_t WS_AFFC = 4 * MiB;
constexpr size_t WS_SHD = 4 * MiB + 256 * 1024;
constexpr size_t WS_SO = 4 * MiB + 640 * 1024;
constexpr size_t WS_ROWS = 5 * MiB;
constexpr size_t WS_GATE = 5 * MiB + 512 * 1024;
constexpr size_t WS_SLOT = 6 * MiB;
constexpr size_t WS_SAX = 9 * MiB;
constexpr size_t WS_SAH = 9 * MiB + 256 * 1024;
constexpr size_t WS_SAS = 9 * MiB + 512 * 1024;
constexpr size_t WS_WSC = 9 * MiB + 896 * 1024;
constexpr size_t WS_XC = 10 * MiB;
constexpr size_t WS_WIN = 26 * MiB;
constexpr size_t WS_WOUT = 62 * MiB;
constexpr size_t WS_WGU = 78 * MiB;
constexpr size_t WS_K8 = 272 * MiB;
constexpr size_t WS_V8 = 288 * MiB;
constexpr size_t WS_K8D = 306 * MiB;
constexpr size_t WS_V8D = 342 * MiB;
constexpr size_t WS_WDN = 462 * MiB;
constexpr size_t WS_R1 = 654 * MiB;
constexpr size_t WS_R2 = 790 * MiB;
constexpr size_t WS_R3 = 1096 * MiB;
constexpr size_t WS_DLT = 1368 * MiB;
constexpr size_t WS_END = 1504 * MiB;

constexpr int RING_BYTES = 131072;
constexpr int TAB_OFF = 131072;
constexpr int LCTL_OFF = 146944;
constexpr int LDS_BYTES = 147456;

__device__ __forceinline__ unsigned cvtpk(float lo, float hi) { unsigned r; asm volatile("v_cvt_pk_bf16_f32 %0, %1, %2" : "=v"(r) : "v"(lo), "v"(hi)); return r; }
__device__ __forceinline__ float bflo(unsigned w) { return __uint_as_float(w << 16); }
__device__ __forceinline__ float bfhi(unsigned w) { return __uint_as_float(w & 0xffff0000u); }
__device__ __forceinline__ float wave_sum(float v) {
#pragma unroll
    for (int o = 1; o < 64; o <<= 1) v += __shfl_xor(v, o);
    return v;
}
__device__ __forceinline__ float wave_max(float v) {
#pragma unroll
    for (int o = 1; o < 64; o <<= 1) v = fmaxf(v, __shfl_xor(v, o));
    return v;
}
__device__ __forceinline__ f32x4 tof(const f32x4& a) { return a; }
__device__ __forceinline__ f32x4 tof(const i32x4& a) { return (f32x4){(float)a.x, (float)a.y, (float)a.z, (float)a.w}; }
__device__ __forceinline__ unsigned q8u(float x, float inv) { int q = __float2int_rn(x * inv); q = min(max(q, -127), 127); return (unsigned)q & 0xffu; }
__device__ __forceinline__ unsigned pack_i8x4(float a, float b, float c, float d, float inv) { return q8u(a, inv) | (q8u(b, inv) << 8) | (q8u(c, inv) << 16) | (q8u(d, inv) << 24); }
__device__ __forceinline__ float clamp_f8(float x) { return __builtin_amdgcn_fmed3f(x, -448.f, 448.f); }
__device__ __forceinline__ unsigned pack_f8x4(float a, float b, float c, float d, float inv) {
    int w = 0; w = __builtin_amdgcn_cvt_pk_fp8_f32(clamp_f8(a * inv), clamp_f8(b * inv), w, false); w = __builtin_amdgcn_cvt_pk_fp8_f32(clamp_f8(c * inv), clamp_f8(d * inv), w, true); return (unsigned)w; }
__device__ __forceinline__ unsigned pack_q4(float a, float b, float c, float d, float inv, bool f8) { const unsigned i = pack_i8x4(a, b, c, d, inv), f = pack_f8x4(a, b, c, d, inv); return f8 ? f : i; }
constexpr float HID_SCALE = 8.f;
constexpr float O8_SCALE = 64.f;
constexpr float Y_SCALE = 32.f;
__device__ __forceinline__ f32x4 unpack_f8x4(unsigned w) { const auto lo = __builtin_amdgcn_cvt_pk_f32_fp8((int)w, false), hi = __builtin_amdgcn_cvt_pk_f32_fp8((int)w, true); return (f32x4){lo[0], lo[1], hi[0], hi[1]}; }
__device__ __forceinline__ float amax4(const f32x4& v) { return fmaxf(fmaxf(fabsf(v.x), fabsf(v.y)), fmaxf(fabsf(v.z), fabsf(v.w))); }
__device__ __forceinline__ float silu_f(float x) { return x / (1.f + __expf(-x)); }
#define LDS_WAIT() asm volatile("s_waitcnt lgkmcnt(0)" ::: "memory")
#define VM_WAIT() asm volatile("s_waitcnt vmcnt(0)" ::: "memory")

struct Params {
    const float *x, *c, *ctx, *c_ctx, *w_ada, *b_ada, *g_mix, *g_ffn, *w_in, *w_out, *a_sink, *lq1, *lk1, *lq2, *lk2, *subln, *qn, *kn, *rpb, *w_router, *w_gate, *w_up, *w_down, *g_final;
    float* out; unsigned char* ws; int ph_lo, ph_hi;
};

#define XB_TMO      128
#define XB_XCNT(j)  (256  + 64 * (j))
#define XB_XSUB(j)  (1280 + 64 * (j))
#define XB_XGEN(j)  (2304 + 64 * (j))
#define XB_TOP      3328
#define XB_TOPGEN   3392
#define XCD_BAR_WORDS 3456
#define XB_SPIN_CAP (1u << 18)

__device__ __forceinline__ unsigned xb_ld(unsigned* p)              { return __hip_atomic_load(p, __ATOMIC_RELAXED, __HIP_MEMORY_SCOPE_AGENT); }
__device__ __forceinline__ unsigned xb_add(unsigned* p, unsigned v) { return __hip_atomic_fetch_add(p, v, __ATOMIC_RELAXED, __HIP_MEMORY_SCOPE_AGENT); }
__device__ __forceinline__ unsigned xb_xcc_id() { return (unsigned)__builtin_amdgcn_s_getreg((3 << 11) | 20) & 0xFu; }
#define XB_SPIN(cond, bar) do { unsigned _sp = 0; while (cond) { __builtin_amdgcn_s_sleep(1); \
    if ((++_sp & 255u) == 0u) { if (xb_ld(&(bar)[XB_TMO])) break; if (_sp > XB_SPIN_CAP) { atomicAdd(&(bar)[XB_TMO], 1u); break; } } } } while (0)

struct XcdBarrier { unsigned* bar; unsigned x; volatile LAS unsigned* st; };

__device__ __forceinline__ XcdBarrier xcd_barrier_post(unsigned* bar, volatile LAS unsigned* st) {
    XcdBarrier b; b.bar = bar; b.x = xb_xcc_id(); b.st = st;
    if (threadIdx.x == 0) (void)xb_add(&bar[XB_XCNT(b.x)], 1u);
    return b;
}
__device__ __forceinline__ void xcd_barrier_complete(unsigned* bar, unsigned x, unsigned& nloc, unsigned& nx) {
    const unsigned G = gridDim.x * gridDim.y * gridDim.z;
    unsigned sum, cnt, mine, sp = 0u;
    for (;;) {
        sum = 0u; cnt = 0u; mine = 0u;
#pragma unroll
        for (unsigned j = 0; j < 16; ++j) { const unsigned c = xb_ld(&bar[XB_XCNT(j)]); sum += c; cnt += (c > 0u) ? 1u : 0u; mine = (j == x) ? c : mine; }
        if (sum == G) break;
        __builtin_amdgcn_s_sleep(1);
        if ((++sp & 255u) == 0u) { if (xb_ld(&bar[XB_TMO])) break; if (sp > XB_SPIN_CAP) { atomicAdd(&bar[XB_TMO], 1u); break; } }
    }
    nloc = mine > 0u ? mine : 1u; nx = cnt > 0u ? cnt : 1u;
}
__device__ __forceinline__ void xcd_barrier(const XcdBarrier& b) {
    asm volatile("s_waitcnt vmcnt(0)" ::: "memory");
    __syncthreads();
    if (threadIdx.x == 0) {
        unsigned* bar = b.bar;
        __builtin_amdgcn_s_waitcnt(0);
        unsigned nloc = b.st[0], nx = b.st[1];
        if (nloc == 0u) { xcd_barrier_complete(bar, b.x, nloc, nx); b.st[0] = nloc; b.st[1] = nx; }
        const unsigned old = xb_add(&bar[XB_XSUB(b.x)], 1u);
        const unsigned gen = old / nloc;
        if (old + 1u == (gen + 1u) * nloc) {
            __builtin_amdgcn_fence(__ATOMIC_RELEASE, "agent");
            asm volatile("s_waitcnt vmcnt(0)" ::: "memory");
            const unsigned og = xb_add(&bar[XB_TOP], 1u);
            const unsigned tg = og / nx;
            if (og + 1u == (tg + 1u) * nx) xb_add(&bar[XB_TOPGEN], 1u);
            else XB_SPIN(xb_ld(&bar[XB_TOPGEN]) == tg, bar);
            __builtin_amdgcn_fence(__ATOMIC_ACQUIRE, "agent");
            xb_add(&bar[XB_XGEN(b.x)], 1u);
            asm volatile("s_waitcnt vmcnt(0)" ::: "memory");
        } else {
            XB_SPIN(xb_ld(&bar[XB_XGEN(b.x)]) == gen, bar);
            __builtin_amdgcn_fence(__ATOMIC_ACQUIRE, "agent");
            asm volatile("s_waitcnt vmcnt(0)" ::: "memory");
        }
    }
    __syncthreads();
}

namespace pg8 {
constexpr int BM = 256, BK = 64, HALF = 128, HTB = HALF * BK * 2, STAGE_BYTES = 8 * HTB, NXCD = 8, WGM = 8;
__device__ __forceinline__ int lds_byte(int r, int c) { const int st = (r >> 4) * 2 + (c >> 5), rr = r & 15, cc = c & 31, ob = rr * 64 + cc * 2; return st * 1024 + (ob ^ (((ob >> 9) & 1) << 5)); }
__device__ __forceinline__ void stage_rc(int b, int& R, int& C) { const int st = b / 1024, sb = b % 1024, swz = sb ^ (((sb >> 9) & 1) << 5); R = (st >> 1) * 16 + swz / 64; C = (st & 1) * 32 + (swz % 64) / 2; }
__device__ __forceinline__ int perm32(int rho) { const int n = rho >> 4, i = rho & 15; return 8 * (i >> 2) + 4 * n + (i & 3); }

struct Unit { int pm, pn, e; };

__device__ __forceinline__ bool static_tile(long L, int nM, int nN, int& pm, int& pn) {
    const int nwg = nM * nN; if (L >= nwg) return false;
    int wgid = (int)L; { const int q = nwg / NXCD, r = nwg % NXCD, xcd = wgid % NXCD, off = wgid / NXCD; wgid = (xcd < r ? xcd * (q + 1) : r * (q + 1) + (xcd - r) * q) + off; }
    const int nig = WGM * nN, gid = wgid / nig, fm = gid * WGM, gsz = (nM - fm) < WGM ? (nM - fm) : WGM;
    pm = fm + ((wgid % nig) % gsz); pn = (wgid % nig) / gsz; return true;
}
struct DenseOrder {
    int nM, nN, G, c, skipctx; const char* A; const char* Bt; size_t tstep;
    __device__ __forceinline__ bool next(int i, Unit& u) const {
        int pm, pn; if (!static_tile((long)i * G + c, nM, nN, pm, pn)) return false;
        u.pm = skipctx ? (pm >> 4) * 17 + 1 + (pm & 15) : pm; u.pn = pn; u.e = 0; return true; }
    __device__ __forceinline__ const char* a_base(const Unit& u) const { return A + (size_t)u.pm * tstep; }
    __device__ __forceinline__ const char* b_base(const Unit& u) const { return Bt + (size_t)u.pn * tstep; }
};
struct MoeOrder {
    int nMe, nN, G, c; const char* A; size_t a_estride; const char* Bt; size_t b_estride; size_t tstep;
    __device__ __forceinline__ bool next(int i, Unit& u) const {
        const int per_e = nMe * nN, nwg = per_e * NEXP; const long L = (long)i * G + c; if (L >= nwg) return false;
        int wgid = (int)L; { const int q = nwg / NXCD, r = nwg % NXCD, xcd = wgid % NXCD, off = wgid / NXCD; wgid = (xcd < r ? xcd * (q + 1) : r * (q + 1) + (xcd - r) * q) + off; }
        u.e = wgid / per_e; const int loc = wgid % per_e;
        const int nig = WGM * nN, gid = loc / nig, fm = gid * WGM, gsz = (nMe - fm) < WGM ? (nMe - fm) : WGM;
        u.pm = fm + ((loc % nig) % gsz); u.pn = (loc % nig) / gsz; return true; }
    __device__ __forceinline__ const char* a_base(const Unit& u) const { return A + (size_t)u.e * a_estride + (a_estride ? (size_t)u.pm * tstep : 0); }
    __device__ __forceinline__ const char* b_base(const Unit& u) const { return Bt + (size_t)u.e * b_estride + (size_t)u.pn * tstep; }
};

struct EpiP {
    static constexpr bool PERM = true; bf16_t* O; int rope; const float* sa; float sw; unsigned char* k8a; unsigned char* k8b;
    template <class AT> __device__ __forceinline__ void operator()(const AT (&acc)[2][2][4][2], const Unit& u, int wr, int wc, int fr, int fq) const {
        const int row0 = u.pm * BM + wr * 64 + fr, col0 = u.pn * BM + wc * 32 + 8 * fq;
        const int pt = u.pm % 17;
        unsigned char* kq = nullptr;
        if (rope) { if (u.pn == 4) kq = k8a; else if (u.pn >= 10 && u.pn <= 13) kq = k8b + (size_t)(u.pn - 10) * 2 * NROWS * 128; }
        const bool dorope = rope && pt != 0 && (u.pn <= 4 || (u.pn >= 6 && u.pn <= 13));
        const int jf = ((wc & 1) * 4 + fq) * 4;
        float inv[4];
#pragma unroll
        for (int i = 0; i < 4; ++i) inv[i] = exp2f(-(float)(jf + i) * (13.287712379549449f / 32.f));
#pragma unroll
        for (int ai = 0; ai < 2; ++ai)
#pragma unroll
            for (int m = 0; m < 4; ++m) { bf16_t* rowp = O + (size_t)(row0 + ai * HALF + m * 16) * INW + col0; const float rsc = sa[row0 + ai * HALF + m * 16] * sw;
                float cs[4], sn[4];
                if (dorope) { const int pos = (pt - 1) * 256 + wr * 64 + ai * HALF + m * 16 + fr; const float pp = (float)((wc >> 1) == 0 ? (pos >> 6) : (pos & 63));
#pragma unroll
                    for (int i = 0; i < 4; ++i) { const float ang = pp * inv[i]; cs[i] = __cosf(ang); sn[i] = __sinf(ang); } }
#pragma unroll
                for (int bj = 0; bj < 2; ++bj) { f32x4 v0 = tof(acc[ai][bj][m][0]) * rsc, v1 = tof(acc[ai][bj][m][1]) * rsc;
                    if (dorope) {
#pragma unroll
                        for (int i = 0; i < 4; ++i) { const float a = v0[i], b = v1[i]; v0[i] = a * cs[i] - b * sn[i]; v1[i] = b * cs[i] + a * sn[i]; } }
                    u32x4 w; w.x = cvtpk(v0[0], v0[1]); w.y = cvtpk(v0[2], v0[3]); w.z = cvtpk(v1[0], v1[1]); w.w = cvtpk(v1[2], v1[3]);
                    *(u32x4*)(rowp + bj * HALF) = w;
                    if (kq != nullptr) { u32x2 w8; w8.x = pack_f8x4(v0[0], v0[1], v0[2], v0[3], 1.f); w8.y = pack_f8x4(v1[0], v1[1], v1[2], v1[3], 1.f);
                        *(u32x2*)(kq + ((size_t)bj * NROWS + (row0 + ai * HALF + m * 16)) * 128 + wc * 32 + 8 * fq) = w8; } } }
    }
};
struct EpiDelta {
    static constexpr bool PERM = true; bf16_t* D; const float* modl; const float* so; float sw;
    template <class AT> __device__ __forceinline__ void operator()(const AT (&acc)[2][2][4][2], const Unit& u, int wr, int wc, int fr, int fq) const {
        const int b = u.pm / 17, pt = u.pm % 17;
        const float* gt = modl + (size_t)(pt == 0 ? 8 : b) * MODW + 2 * DM;
        const int row0 = u.pm * BM + wr * 64 + fr, col0 = u.pn * BM + wc * 32 + 8 * fq;
        f32x4 g[2][2];
#pragma unroll
        for (int bj = 0; bj < 2; ++bj)
#pragma unroll
            for (int n = 0; n < 2; ++n) g[bj][n] = *(const f32x4*)(gt + col0 + bj * HALF + 4 * n) * sw;
#pragma unroll
        for (int ai = 0; ai < 2; ++ai)
#pragma unroll
            for (int m = 0; m < 4; ++m) { const int row = row0 + ai * HALF + m * 16; const float rs = so ? so[row] : 1.f; bf16_t* rowp = D + (size_t)row * DM + col0;
#pragma unroll
                for (int bj = 0; bj < 2; ++bj) { const f32x4 v0 = tof(acc[ai][bj][m][0]) * g[bj][0] * rs, v1 = tof(acc[ai][bj][m][1]) * g[bj][1] * rs;
                    u32x4 w; w.x = cvtpk(v0[0], v0[1]); w.y = cvtpk(v0[2], v0[3]); w.z = cvtpk(v1[0], v1[1]); w.w = cvtpk(v1[2], v1[3]);
                    *(u32x4*)(rowp + bj * HALF) = w; } }
    }
};
struct EpiSwiglu {
    static constexpr bool PERM = true; unsigned char* H; int mexp; const float* sas; const float* wsc;
    template <class AT> __device__ __forceinline__ void operator()(const AT (&acc)[2][2][4][2], const Unit& u, int wr, int wc, int fr, int fq) const {
        const int row0 = u.e * mexp + u.pm * BM + wr * 64 + fr, col0 = u.pn * 128 + wc * 16 + 4 * fq;
        const float sg = wsc[2 * u.e], su = wsc[2 * u.e + 1];
#pragma unroll
        for (int ai = 0; ai < 2; ++ai)
#pragma unroll
            for (int m = 0; m < 4; ++m) { unsigned char* rowp = H + (size_t)(row0 + ai * HALF + m * 16) * DEXP + col0; const float rs_ = sas[row0 + ai * HALF + m * 16];
#pragma unroll
                for (int bj = 0; bj < 2; ++bj) { const f32x4 g = tof(acc[ai][bj][m][0]) * (rs_ * sg), up = tof(acc[ai][bj][m][1]) * (rs_ * su); f32x4 h;
#pragma unroll
                    for (int q = 0; q < 4; ++q) h[q] = g[q] * __builtin_amdgcn_rcpf(1.f + __expf(-g[q])) * up[q];
                    *(unsigned*)(rowp + bj * 64) = pack_f8x4(h[0], h[1], h[2], h[3], HID_SCALE); } }
    }
};
struct EpiDown {
    static constexpr bool PERM = true; unsigned char* Y; const float* gate; int mexp; const float* wsc;
    template <class AT> __device__ __forceinline__ void operator()(const AT (&acc)[2][2][4][2], const Unit& u, int wr, int wc, int fr, int fq) const {
        const int row0 = u.e * mexp + u.pm * BM + wr * 64 + fr, col0 = u.pn * BM + wc * 32 + 8 * fq;
#pragma unroll
        for (int ai = 0; ai < 2; ++ai)
#pragma unroll
            for (int m = 0; m < 4; ++m) { const int row = row0 + ai * HALF + m * 16; const float gv = gate[row] * (wsc[u.e] * (Y_SCALE / HID_SCALE)); unsigned char* rowp = Y + (size_t)row * DM + col0;
#pragma unroll
                for (int bj = 0; bj < 2; ++bj) { const f32x4 v0 = tof(acc[ai][bj][m][0]) * gv, v1 = tof(acc[ai][bj][m][1]) * gv;
                    u32x2 w; w.x = pack_f8x4(v0[0], v0[1], v0[2], v0[3], 1.f); w.y = pack_f8x4(v1[0], v1[1], v1[2], v1[3], 1.f);
                    *(u32x2*)(rowp + bj * HALF) = w; } }
    }
};

__device__ __forceinline__ void mfma_f8(f32x4& acc, const i32x8 a, const i32x8 b) { asm volatile("v_mfma_f32_16x16x128_f8f6f4 %0, %1, %2, %0" : "+v"(acc) : "v"(a), "v"(b)); }
__device__ __forceinline__ void mfma_f8(i32x4& acc, const i32x8 a, const i32x8 b) { }
template <class Epi, class Sched, bool GATHER, bool I8, bool F8 = false>
__device__ __forceinline__ void gemm_phase(const int tid, LAS unsigned char* lds, const LAS unsigned* rowtab, const int KB, const Sched& S, const Epi& E) {
    const int wid = __builtin_amdgcn_readfirstlane(tid >> 6), lane = tid & 63, wr = wid >> 2, wc = wid & 3, fr = lane & 15, fq = lane >> 4;
    const int nt = KB / (BK * 2);
    const unsigned hstep = (unsigned)HALF * KB;
    const size_t kstep = (size_t)(BK * 2);
    unsigned voffB[2], vAc[2][2];
#pragma unroll
    for (int i = 0; i < 2; ++i) { int R, C; stage_rc(tid * 16 + i * 8192, R, C); const int Rb = Epi::PERM ? ((R & ~31) + perm32(R & 31)) : R;
        voffB[i] = (unsigned)(Rb * KB) + (unsigned)C * 2u; }
    const unsigned ldsw = (unsigned)wid * 1024u;
    const int aoff = lds_byte(wr * 64 + fr, fq * 8), boff = lds_byte(wc * 32 + fr, fq * 8);
#define PG8_SA(b, h) (((b) * 2 + (h)) * HTB)
#define PG8_SB(b, h) ((4 + (b) * 2 + (h)) * HTB)
#define PG8_STAGE(bufoff, gbase, voff) do { _Pragma("unroll") for (int _i = 0; _i < 2; ++_i) \
        __builtin_amdgcn_global_load_lds((const unsigned*)((const char*)(gbase) + (voff)[_i]), (LAS unsigned*)(lds + (bufoff) + ldsw + _i * 8192), 16, 0, 0); } while (0)
#define PG8_LDA(dst, b, h) do { _Pragma("unroll") for (int m = 0; m < 4; ++m) _Pragma("unroll") for (int k = 0; k < 2; ++k) dst[m][k] = *(const LAS bf16x8*)(lds + PG8_SA(b, h) + aoff + m * 2048 + k * 1024); } while (0)
#define PG8_LDB(dst, b, h) do { _Pragma("unroll") for (int n = 0; n < 2; ++n) _Pragma("unroll") for (int k = 0; k < 2; ++k) dst[n][k] = *(const LAS bf16x8*)(lds + PG8_SB(b, h) + boff + n * 2048 + k * 1024); } while (0)
#define PG8_MMA(ai, bj, At, Bt) do { __builtin_amdgcn_s_setprio(1); _Pragma("unroll") for (int m = 0; m < 4; ++m) _Pragma("unroll") for (int n = 0; n < 2; ++n) \
        if constexpr (F8) mfma_f8(acc[ai][bj][m][n], __builtin_shufflevector(__builtin_bit_cast(i32x4, Bt[n][0]), __builtin_bit_cast(i32x4, Bt[n][1]), 0, 1, 2, 3, 4, 5, 6, 7), \
            __builtin_shufflevector(__builtin_bit_cast(i32x4, At[m][0]), __builtin_bit_cast(i32x4, At[m][1]), 0, 1, 2, 3, 4, 5, 6, 7)); \
        else _Pragma("unroll") for (int k = 0; k < 2; ++k) \
        { if constexpr (I8) acc[ai][bj][m][n] = __builtin_amdgcn_mfma_i32_16x16x64_i8(__builtin_bit_cast(i32x4, Bt[n][k]), __builtin_bit_cast(i32x4, At[m][k]), acc[ai][bj][m][n], 0, 0, 0); \
          else acc[ai][bj][m][n] = __builtin_amdgcn_mfma_f32_16x16x32_bf16(Bt[n][k], At[m][k], acc[ai][bj][m][n], 0, 0, 0); } __builtin_amdgcn_s_setprio(0); } while (0)
#define PG8_WAIT_V(n) asm volatile("s_waitcnt vmcnt(" #n ")" ::: "memory")
#define PG8_WAIT_L(n) asm volatile("s_waitcnt lgkmcnt(" #n ")" ::: "memory")
#define PG8_BAR __builtin_amdgcn_s_barrier()
#define PG8_SCHED __builtin_amdgcn_sched_barrier(0)
#define PG8_LOADTAB(dst, ui_) do { _Pragma("unroll") for (int _i = 0; _i < 2; ++_i) { int _R, _C; stage_rc(tid * 16 + _i * 8192, _R, _C); _Pragma("unroll") for (int _h = 0; _h < 2; ++_h) \
        dst[_h][_i] = GATHER ? rowtab[(ui_) * 256 + _h * HALF + _R] + (unsigned)_C * 2u : (unsigned)((_h * HALF + _R) * KB) + (unsigned)_C * 2u; } } while (0)
    Unit cur, nxt; int ui = 0;
    if (!S.next(0, cur)) return;
    typedef typename std::conditional<I8 && !F8, i32x4, f32x4>::type acc_t;
    acc_t acc[2][2][4][2];
#pragma unroll
    for (int a = 0; a < 2; ++a)
#pragma unroll
        for (int b = 0; b < 2; ++b)
#pragma unroll
            for (int m = 0; m < 4; ++m)
#pragma unroll
                for (int n = 0; n < 2; ++n) acc[a][b][m][n] = acc_t{};
    bf16x8 At[4][2], B0[2][2], B1[2][2];
    const char* cA = S.a_base(cur); const char* cB = S.b_base(cur);
    PG8_LOADTAB(vAc, 0);
    PG8_STAGE(PG8_SB(0, 0), cB, voffB); PG8_STAGE(PG8_SB(0, 1), cB + hstep, voffB); PG8_STAGE(PG8_SA(0, 0), cA, vAc[0]); PG8_STAGE(PG8_SA(0, 1), cA, vAc[1]);
    if (wr == 1) PG8_BAR;
    PG8_WAIT_V(2); PG8_BAR;
    PG8_STAGE(PG8_SB(1, 0), cB + kstep, voffB); PG8_STAGE(PG8_SA(1, 0), cA + kstep, vAc[0]); PG8_STAGE(PG8_SB(1, 1), cB + hstep + kstep, voffB);
    PG8_WAIT_V(6); PG8_BAR;
    for (;;) {
        const bool has_next = S.next(ui + 1, nxt);
        const char* nA = has_next ? S.a_base(nxt) : cA; const char* nB = has_next ? S.b_base(nxt) : cB;
        for (int t = 0; t < nt; t += 2) {
            const bool last = (t == nt - 2);
            const char* a1 = cA + (size_t)(t + 1) * kstep;
            const char* a2 = last ? nA : cA + (size_t)(t + 2) * kstep; const char* b2 = last ? nB : cB + (size_t)(t + 2) * kstep;
            const char* a3 = a2 + kstep; const char* b3 = b2 + kstep;
            PG8_LDB(B0, 0, 0); PG8_LDB(B1, 0, 1); PG8_SCHED; PG8_LDA(At, 0, 0); PG8_STAGE(PG8_SA(1, 1), a1, vAc[1]);
            if (GATHER) { if (last && has_next) { PG8_LOADTAB(vAc, ui + 1); } }
            PG8_WAIT_V(8); PG8_WAIT_L(0); PG8_BAR; PG8_MMA(0, 0, At, B0); PG8_MMA(0, 1, At, B1); PG8_BAR; PG8_SCHED;
            PG8_LDA(At, 0, 1); PG8_STAGE(PG8_SB(0, 0), b2, voffB); PG8_STAGE(PG8_SB(0, 1), b2 + hstep, voffB); PG8_STAGE(PG8_SA(0, 0), a2, vAc[0]);
            PG8_WAIT_V(8); PG8_WAIT_L(0); PG8_BAR; PG8_MMA(1, 0, At, B0); PG8_MMA(1, 1, At, B1); PG8_BAR; PG8_SCHED;
            PG8_LDB(B0, 1, 0); PG8_LDB(B1, 1, 1); PG8_SCHED; PG8_LDA(At, 1, 0); PG8_STAGE(PG8_SA(0, 1), a2, vAc[1]);
            PG8_WAIT_V(8); PG8_WAIT_L(0); PG8_BAR; PG8_MMA(0, 0, At, B0); PG8_MMA(0, 1, At, B1); PG8_BAR; PG8_SCHED;
            PG8_LDA(At, 1, 1); PG8_STAGE(PG8_SB(1, 0), b3, voffB); PG8_STAGE(PG8_SB(1, 1), b3 + hstep, voffB); PG8_STAGE(PG8_SA(1, 0), a3, vAc[0]);
            PG8_WAIT_V(8); PG8_WAIT_L(0); PG8_BAR; PG8_MMA(1, 0, At, B0); PG8_MMA(1, 1, At, B1); PG8_BAR; PG8_SCHED;
        }
        if (wr == 0) PG8_BAR;
        E(acc, cur, wr, wc, fr, fq);
        if (!has_next) break;
#pragma unroll
        for (int a = 0; a < 2; ++a)
#pragma unroll
            for (int b = 0; b < 2; ++b)
#pragma unroll
                for (int m = 0; m < 4; ++m)
#pragma unroll
                    for (int n = 0; n < 2; ++n) acc[a][b][m][n] = acc_t{};
        cur = nxt; cA = nA; cB = nB; ++ui;
        if (wr == 1) PG8_BAR;
    }
    PG8_WAIT_V(0);
    PG8_BAR;
#undef PG8_SA
#undef PG8_SB
#undef PG8_STAGE
#undef PG8_LDA
#undef PG8_LDB
#undef PG8_MMA
#undef PG8_WAIT_V
#undef PG8_WAIT_L
#undef PG8_BAR
#undef PG8_SCHED
#undef PG8_LOADTAB
}
}

namespace att {
constexpr int D = 128, NW = 8, QBLK = 32, KVBLK = 64, LDP = INW;
constexpr float SCALE = 0.088388347648318440f;
constexpr float THR = 8.f;
constexpr int NBUF = 3;
constexpr int SHM_V = KVBLK * D * 2, SHM_K = KVBLK * D * 2, SHM_ATTN = NBUF * SHM_V + NBUF * SHM_K + NW * 64 * 4;
constexpr int BIAS_OFF = 100352;
#define KSWZ(row, colB) ((row) * 256 + ((colB) ^ (((row) & 7) << 4)))
#define SBAR() __builtin_amdgcn_sched_barrier(0)
__device__ __forceinline__ int crow(int r, int hi) { return (r & 3) + 8 * (r >> 2) + 4 * hi; }

struct AUnit { int qrow0, qcol, kcol, vcol, kbase, NT, seg2row, mode, pa, pb, head, ocol, outf32, has_sink; float sink; };

template <bool FIXREF = false> __device__ __forceinline__ void partialSM(f32x16& p0, f32x16& p1, float& m_reg, float& mn, float& alpha) {
  constexpr float C = SCALE * 1.4426950408889634f;
  if constexpr (FIXREF) { mn = m_reg; alpha = 1.f;
#pragma unroll
    for (int r = 0; r < 16; ++r) p0[r] = __builtin_amdgcn_exp2f(p0[r]);
    return; }
  float pmax = p0[0];
#pragma unroll
  for (int r = 1; r < 16; ++r) pmax = fmaxf(pmax, p0[r]);
#pragma unroll
  for (int r = 0; r < 16; ++r) pmax = fmaxf(pmax, p1[r]);
  { auto rr = __builtin_amdgcn_permlane32_swap(__float_as_uint(pmax), __float_as_uint(pmax), false, false);
    pmax = fmaxf(__uint_as_float(rr[0]), __uint_as_float(rr[1])); }
  if (__builtin_expect(__all(pmax - m_reg <= THR / SCALE), 1)) { mn = m_reg; alpha = 1.f; }
  else { mn = fmaxf(m_reg, pmax); alpha = __builtin_amdgcn_exp2f((m_reg - mn) * C); m_reg = mn; }
  float mnC = -mn * C;
#pragma unroll
  for (int r = 0; r < 16; ++r) p0[r] = fmaf(p0[r], C, mnC);
#pragma unroll
  for (int r = 0; r < 16; ++r) p1[r] = fmaf(p1[r], C, mnC);
#pragma unroll
  for (int r = 0; r < 16; ++r) p0[r] = __builtin_amdgcn_exp2f(p0[r]);
}
__device__ __forceinline__ void firstSM(f32x16& p0, f32x16& p1, float& m_reg) {
  float pmax = p0[0];
#pragma unroll
  for (int r = 1; r < 16; ++r) pmax = fmaxf(pmax, p0[r]);
#pragma unroll
  for (int r = 0; r < 16; ++r) pmax = fmaxf(pmax, p1[r]);
  { auto rr = __builtin_amdgcn_permlane32_swap(__float_as_uint(pmax), __float_as_uint(pmax), false, false);
    pmax = fmaxf(__uint_as_float(rr[0]), __uint_as_float(rr[1])); }
  m_reg = pmax;
#pragma unroll
  for (int r = 0; r < 16; ++r) p0[r] = __builtin_amdgcn_exp2f(p0[r] - pmax);
#pragma unroll
  for (int r = 0; r < 16; ++r) p1[r] -= pmax;
}
__device__ __forceinline__ void finishSM(f32x16& p0, f32x16& p1, float alpha, float& l_reg, bf16x8& pa0, bf16x8& pa1, bf16x8& pa2, bf16x8& pa3) {
#pragma unroll
  for (int r = 0; r < 16; ++r) p1[r] = __builtin_amdgcn_exp2f(p1[r]);
  float ps = 0;
#pragma unroll
  for (int r = 0; r < 16; ++r) ps += p0[r];
#pragma unroll
  for (int r = 0; r < 16; ++r) ps += p1[r];
  { auto rr = __builtin_amdgcn_permlane32_swap(__float_as_uint(ps), __float_as_uint(ps), false, false);
    ps = __uint_as_float(rr[0]) + __uint_as_float(rr[1]); }
  l_reg = l_reg * alpha + ps;
#define PK4(P, BASE, OUT) do { unsigned a0 = cvtpk(P[BASE + 0], P[BASE + 1]), a1 = cvtpk(P[BASE + 2], P[BASE + 3]);   \
    unsigned b0 = cvtpk(P[BASE + 4], P[BASE + 5]), b1 = cvtpk(P[BASE + 6], P[BASE + 7]);                              \
    auto r0 = __builtin_amdgcn_permlane32_swap(a0, b0, false, false); auto r1 = __builtin_amdgcn_permlane32_swap(a1, b1, false, false); \
    u32x4 w = {r0[0], r1[0], r0[1], r1[1]}; OUT = *reinterpret_cast<bf16x8*>(&w); } while (0)
  PK4(p0, 0, pa0); PK4(p0, 8, pa1); PK4(p1, 0, pa2); PK4(p1, 8, pa3);
#undef PK4
}
__device__ __forceinline__ void qkt(f32x16& p0, f32x16& p1, const LAS char* Ks, const bf16x8* qr, int r32, int hi, const f32x16& init) {
  p0 = init; p1 = init;
#pragma unroll
  for (int d0 = 0; d0 < 8; ++d0) { int cb = (d0 * 16 + hi * 8) * 2;
    bf16x8 b0 = *reinterpret_cast<const LAS bf16x8*>(Ks + KSWZ(r32, cb));
    bf16x8 b1 = *reinterpret_cast<const LAS bf16x8*>(Ks + KSWZ(32 + r32, cb));
    p0 = __builtin_amdgcn_mfma_f32_32x32x16_bf16(b0, qr[d0], p0, 0, 0, 0);
    p1 = __builtin_amdgcn_mfma_f32_32x32x16_bf16(b1, qr[d0], p1, 0, 0, 0); }
}
__device__ __forceinline__ int v_st(int k, int c) { const int kk = (k & ~0xC) | ((k & 4) << 1) | ((k & 8) >> 1); return ((kk >> 3) * 4 + (c >> 5)) * 512 + ((kk & 7) * 32 + (c & 31)) * 2; }
__device__ __forceinline__ int v_rd_base(int lane) { return ((lane & 3) << 3) | (((lane >> 2) & 3) << 6) | (((lane >> 4) & 1) << 5) | (((lane >> 5) & 1) << 8); }
constexpr int v_rd_off(int d0, int ks, int half) { return d0 * 512 + ks * 4096 + half * 2048; }
template <int OFF> __device__ __forceinline__ s16x4 tr_read(int vb) {
  s16x4 r; asm volatile("ds_read_b64_tr_b16 %0, %1 offset:%2" : "=&v"(r) : "v"(vb), "i"(OFF) : "memory"); return r;
}
template <int D0> __device__ __forceinline__ void pv_one(f32x16& od, int vb, bf16x8 pa0, bf16x8 pa1, bf16x8 pa2, bf16x8 pa3) {
  const s16x4 l0 = tr_read<v_rd_off(D0, 0, 0)>(vb), h0 = tr_read<v_rd_off(D0, 0, 1)>(vb), l1 = tr_read<v_rd_off(D0, 1, 0)>(vb), h1 = tr_read<v_rd_off(D0, 1, 1)>(vb);
  const s16x4 l2 = tr_read<v_rd_off(D0, 2, 0)>(vb), h2 = tr_read<v_rd_off(D0, 2, 1)>(vb), l3 = tr_read<v_rd_off(D0, 3, 0)>(vb), h3 = tr_read<v_rd_off(D0, 3, 1)>(vb);
  asm volatile("s_waitcnt lgkmcnt(0)" ::: "memory"); SBAR();
#define PK(L, H) (bf16x8){L[0], L[1], L[2], L[3], H[0], H[1], H[2], H[3]}
  od = __builtin_amdgcn_mfma_f32_32x32x16_bf16(pa0, PK(l0, h0), od, 0, 0, 0);
  od = __builtin_amdgcn_mfma_f32_32x32x16_bf16(pa1, PK(l1, h1), od, 0, 0, 0);
  od = __builtin_amdgcn_mfma_f32_32x32x16_bf16(pa2, PK(l2, h2), od, 0, 0, 0);
  od = __builtin_amdgcn_mfma_f32_32x32x16_bf16(pa3, PK(l3, h3), od, 0, 0, 0);
#undef PK
}
__device__ __forceinline__ void pv_d0(f32x16* o, int vb, bf16x8 pa0, bf16x8 pa1, bf16x8 pa2, bf16x8 pa3) {
  pv_one<0>(o[0], vb, pa0, pa1, pa2, pa3); pv_one<1>(o[1], vb, pa0, pa1, pa2, pa3); pv_one<2>(o[2], vb, pa0, pa1, pa2, pa3); pv_one<3>(o[3], vb, pa0, pa1, pa2, pa3);
}
template <int MODE> __device__ __forceinline__ void mask_tile(f32x16& p0, f32x16& p1, const AUnit& u, int j, int wid, int r32, int hi, const LAS float* btab) {
  if (MODE == 0 || j < 4) return;
  if (MODE == 1) {
    const int qpos = u.pa + wid * 32 + r32, k0 = u.pb + (j - 4) * 64 + 4 * hi;
#pragma unroll
    for (int r = 0; r < 16; ++r) { const int d = qpos - (k0 + (r & 3) + 8 * (r >> 2));
      p0[r] = (d <= 128 && d >= -128) ? p0[r] : -1e30f; const int d1 = d - 32; p1[r] = (d1 <= 128 && d1 >= -128) ? p1[r] : -1e30f; }
  } else {
    const int qr = u.pa + (wid >> 1), qc = (wid & 1) * 32 + r32, kr = u.pb + (j - 4);
    const int rs = min(max(qr - 4, 0), 56), cs = min(max(qc - 8, 0), 48);
    const bool rowok = (kr >= rs) && (kr < rs + 8);
    const LAS float* tb = btab + u.head * 480 + (kr - qr + 7) * 32 + (15 - qc) + 4 * hi;
#pragma unroll
    for (int r = 0; r < 16; ++r) { const int kc = (r & 3) + 8 * (r >> 2), kf = kc + 4 * hi;
      const float b0 = tb[kc], b1 = tb[kc + 32];
      p0[r] = (rowok && kf >= cs && kf < cs + 16) ? p0[r] + b0 : -1e30f;
      p1[r] = (rowok && kf + 32 >= cs && kf + 32 < cs + 16) ? p1[r] + b1 : -1e30f; }
  }
}

__device__ __forceinline__ void store_o8(unsigned char* Ow, const f32x16 (&o)[4], const float (&rli)[16], const int r32, const int hi) {
  const int qi = r32 & 3; const unsigned sel = (unsigned)qi | ((unsigned)(4 + qi) << 8) | 0x0c0c0000u;
  unsigned char* base = Ow + qi * 32 + (r32 & ~3);
#pragma unroll
  for (int r = 0; r < 16; ++r) { const float sc = rli[r] * O8_SCALE;
    int w = 0; w = __builtin_amdgcn_cvt_pk_fp8_f32(clamp_f8(o[0][r] * sc), clamp_f8(o[1][r] * sc), w, false); w = __builtin_amdgcn_cvt_pk_fp8_f32(clamp_f8(o[2][r] * sc), clamp_f8(o[3][r] * sc), w, true);
    const unsigned p0 = (unsigned)__builtin_amdgcn_update_dpp(0, w, 0x00, 0xf, 0xf, false), p1 = (unsigned)__builtin_amdgcn_update_dpp(0, w, 0x55, 0xf, 0xf, false);
    const unsigned p2 = (unsigned)__builtin_amdgcn_update_dpp(0, w, 0xaa, 0xf, 0xf, false), p3 = (unsigned)__builtin_amdgcn_update_dpp(0, w, 0xff, 0xf, 0xf, false);
    const unsigned t01 = __builtin_amdgcn_perm(p1, p0, sel), t23 = __builtin_amdgcn_perm(p3, p2, sel);
    *reinterpret_cast<unsigned*>(base + (size_t)crow(r, hi) * DM) = t01 | (t23 << 16); }
}
template <int MODE, int SDEPTH> __device__ __forceinline__ void attn_unit(const AUnit& u, const bf16_t* __restrict__ P, bf16_t* __restrict__ O, float* __restrict__ OB, LAS char* lds) {
  int tid = threadIdx.x; asm volatile("" : "+v"(tid));
  const int wid = tid >> 6, lane = tid & 63, r32 = lane & 31, hi = lane >> 5;
  LAS char* V_lds = lds; LAS char* K_lds = lds + NBUF * SHM_V;
  LAS float* ws = (LAS float*)(lds + NBUF * SHM_V + NBUF * SHM_K) + wid * 64; LAS float* li_l = ws; LAS float* al_l = ws + 32;
  const LAS float* btab = (const LAS float*)(lds + BIAS_OFF);
  float m_reg = -1e30f, l_reg = 0; f32x16 o[4] = {}; bf16x8 qr[8];
  const bf16_t* Qw = P + (size_t)(u.qrow0 + wid * QBLK + r32) * LDP + u.qcol + hi * 8;
#pragma unroll
  for (int d0 = 0; d0 < 8; ++d0) qr[d0] = *reinterpret_cast<const bf16x8*>(Qw + d0 * 16);
  f32x16 acc0 = {};
  {
    constexpr float C = SCALE * 1.4426950408889634f;
#pragma unroll
    for (int d0 = 0; d0 < 8; ++d0) { const u32x4 w = __builtin_bit_cast(u32x4, qr[d0]); u32x4 o_;
      o_.x = cvtpk(bflo(w.x) * C, bfhi(w.x) * C); o_.y = cvtpk(bflo(w.y) * C, bfhi(w.y) * C); o_.z = cvtpk(bflo(w.z) * C, bfhi(w.z) * C); o_.w = cvtpk(bflo(w.w) * C, bfhi(w.w) * C);
      qr[d0] = __builtin_bit_cast(bf16x8, o_); } }
  const char* Kh = (const char*)(P + (size_t)u.kbase * LDP + u.kcol); const char* Vh = (const char*)(P + (size_t)u.kbase * LDP + u.vcol);
  const int wv = __builtin_amdgcn_readfirstlane(tid >> 6);
  const unsigned koff0 = (unsigned)((tid >> 4) * (LDP * 2)) + (unsigned)(((tid & 15) * 16) ^ (((tid >> 4) & 7) << 4));
  const int vs_ = tid >> 5, vkk = (vs_ >> 2) * 8 + ((tid & 31) >> 2), vk0 = (vkk & ~0xC) | ((vkk & 4) << 1) | ((vkk & 8) >> 1), vc0 = (vs_ & 3) * 32 + (tid & 3) * 8;
  const unsigned voff0 = (unsigned)(vk0 * (LDP * 2)) + (unsigned)(vc0 * 2);
  constexpr unsigned RS32 = 32u * LDP * 2u;
  const int vb0 = (int)(unsigned)(uintptr_t)V_lds + v_rd_base(lane);
#define KROW(j) ((j) < 4 ? (j) * 64 : u.seg2row + ((j) - 4) * 64)
#define GLDS(gp, lp) __builtin_amdgcn_global_load_lds((const unsigned*)(gp), (LAS unsigned*)(lp), 16, 0, 0)
#define DMA(slot, k0) do { const size_t _kb = (size_t)(k0) * (LDP * 2); LAS char* _kd = K_lds + (slot) * SHM_K + wv * 1024; LAS char* _vd = V_lds + (slot) * SHM_V + wv * 1024; \
    GLDS(Kh + _kb + koff0, _kd); GLDS(Kh + _kb + koff0 + RS32, _kd + 8192); GLDS(Vh + _kb + voff0, _vd); GLDS(Vh + _kb + voff0 + RS32, _vd + 8192); } while (0)
#define DWAIT() asm volatile("s_waitcnt vmcnt(0)" ::: "memory")
#define RESC(a) do { if (__any((a) < 1.f)) { if (hi == 0) al_l[r32] = (a); asm volatile("s_waitcnt lgkmcnt(0)" ::: "memory"); \
    _Pragma("unroll") for (int d = 0; d < 4; ++d) _Pragma("unroll") for (int r = 0; r < 16; ++r) o[d][r] *= al_l[crow(r, hi)]; } } while (0)
  f32x16 pA0, pA1, pB0, pB1; float mnA, mnB, alA, alB; bf16x8 pa0, pa1, pa2, pa3; const int NT = u.NT;
  int bp = 0, bc = 1, bn = 2;
  DMA(0, 0); DWAIT(); __syncthreads();
  qkt(pA0, pA1, K_lds, qr, r32, hi, acc0);
  { firstSM(pA0, pA1, m_reg); mnA = m_reg; alA = 1.f;
#pragma unroll
    for (int r = 0; r < 16; ++r) acc0[r] = -m_reg; }
  DMA(1, KROW(1)); DWAIT(); __syncthreads();
#define TILE_OK(j_) (MODE != 2 || (j_) < 4 || (u.pb + (j_) - 4 >= nb_rs && u.pb + (j_) - 4 < nb_rs + 8))
  const int nb_rs = min(max(u.pa + (wv >> 1) - 4, 0), 56);
  bool okA = true, okB = true;
  for (int j = 1; j + 1 < NT; j += 2) {
    DMA(bn, KROW(j + 1));
    okB = TILE_OK(j);
    SBAR(); if (okB) qkt(pB0, pB1, K_lds + bc * SHM_K, qr, r32, hi, acc0);
    if (okA) { finishSM(pA0, pA1, alA, l_reg, pa0, pa1, pa2, pa3); SBAR();
      pv_d0(o, vb0 + bp * (int)SHM_V, pa0, pa1, pa2, pa3); }
    if (okB) { mask_tile<MODE>(pB0, pB1, u, j, wid, r32, hi, btab); partialSM<true>(pB0, pB1, m_reg, mnB, alB); }
    DWAIT(); __syncthreads();
    bp = bc; bc = bn; bn = (bn == NBUF - 1) ? 0 : bn + 1;
    if (j + 2 < NT) DMA(bn, KROW(j + 2));
    okA = TILE_OK(j + 1);
    SBAR(); if (okA) qkt(pA0, pA1, K_lds + bc * SHM_K, qr, r32, hi, acc0);
    if (okB) { finishSM(pB0, pB1, alB, l_reg, pa0, pa1, pa2, pa3); SBAR();
      pv_d0(o, vb0 + bp * (int)SHM_V, pa0, pa1, pa2, pa3); }
    if (okA) { mask_tile<MODE>(pA0, pA1, u, j + 1, wid, r32, hi, btab); partialSM<true>(pA0, pA1, m_reg, mnA, alA); }
    DWAIT(); __syncthreads();
    bp = bc; bc = bn; bn = (bn == NBUF - 1) ? 0 : bn + 1;
  }
  okB = TILE_OK(NT - 1);
  SBAR(); if (okB) qkt(pB0, pB1, K_lds + bc * SHM_K, qr, r32, hi, acc0);
  if (okA) { finishSM(pA0, pA1, alA, l_reg, pa0, pa1, pa2, pa3); SBAR();
    pv_d0(o, vb0 + bp * (int)SHM_V, pa0, pa1, pa2, pa3); }
  if (okB) { mask_tile<MODE>(pB0, pB1, u, NT - 1, wid, r32, hi, btab); partialSM<true>(pB0, pB1, m_reg, mnB, alB);
    finishSM(pB0, pB1, alB, l_reg, pa0, pa1, pa2, pa3); SBAR();
    pv_d0(o, vb0 + bc * (int)SHM_V, pa0, pa1, pa2, pa3); }
#undef TILE_OK
  if (u.has_sink) l_reg += __builtin_amdgcn_exp2f(u.sink * 1.4426950408889634f - m_reg);
  if (hi == 0) li_l[r32] = l_reg; asm volatile("s_waitcnt lgkmcnt(0)" ::: "memory");
  float rli[16];
#pragma unroll
  for (int r = 0; r < 16; ++r) rli[r] = __builtin_amdgcn_rcpf(li_l[crow(r, hi)]);
  if (u.outf32) {
    float* Ow = OB + (size_t)(u.qrow0 + wid * QBLK) * DM + u.ocol;
#pragma unroll
    for (int r = 0; r < 16; ++r) { const int orow = crow(r, hi);
#pragma unroll
      for (int d0 = 0; d0 < 4; ++d0) Ow[(size_t)orow * DM + d0 * 32 + r32] = o[d0][r] * rli[r]; }
  } else {
    if constexpr (MODE == 2) {
      store_o8(reinterpret_cast<unsigned char*>(O) + (size_t)(u.qrow0 + wid * QBLK) * DM + u.ocol, o, rli, r32, hi);
    } else {
    bf16_t* Ow = O + (size_t)(u.qrow0 + wid * QBLK) * DM + u.ocol;
#pragma unroll
    for (int r = 0; r < 16; ++r) { const int orow = crow(r, hi);
#pragma unroll
      for (int d0 = 0; d0 < 4; ++d0) { const float v = o[d0][r] * rli[r]; Ow[(size_t)orow * DM + d0 * 32 + r32] = (bf16_t)(cvtpk(v, v) & 0xffffu); } }
    }
  }
  __syncthreads();
#undef KROW
#undef GLDS
#undef DMA
#undef DWAIT
#undef RESC
}
constexpr int SHM8 = 8192;
__device__ __forceinline__ void mfma8_32(f32x16& acc, const i32x8 a, const i32x8 b) { asm volatile("v_mfma_f32_32x32x64_f8f6f4 %0, %1, %2, %0" : "+v"(acc) : "v"(a), "v"(b)); }
__device__ __forceinline__ i32x8 cat8(const i32x4 a, const i32x4 b) { return __builtin_shufflevector(a, b, 0, 1, 2, 3, 4, 5, 6, 7); }
__device__ __forceinline__ int cvt4_f8(float a, float b, float c, float d) { int w = 0; w = __builtin_amdgcn_cvt_pk_fp8_f32(a, b, w, false); w = __builtin_amdgcn_cvt_pk_fp8_f32(c, d, w, true); return w; }
__device__ __forceinline__ void mfma8_32c(f32x16& d, const i32x8 a, const i32x8 b, const f32x16& c) { asm volatile("v_mfma_f32_32x32x64_f8f6f4 %0, %1, %2, %3" : "=&v"(d) : "v"(a), "v"(b), "v"(c)); }
__device__ __forceinline__ void kfrag8(i32x8 (&kf)[4], const LAS char* Ks, int r32, int hi) {
  const int x0 = r32 & 7; const LAS char* k0 = Ks + r32 * 128; const LAS char* k1 = k0 + 32 * 128;
#define KF8(kp, s) cat8(*reinterpret_cast<const LAS i32x4*>((kp) + (((4 * (s) + 2 * hi) ^ x0) << 4)), *reinterpret_cast<const LAS i32x4*>((kp) + (((4 * (s) + 2 * hi + 1) ^ x0) << 4)))
  kf[0] = KF8(k0, 0); kf[1] = KF8(k1, 0); kf[2] = KF8(k0, 1); kf[3] = KF8(k1, 1);
#undef KF8
}
__device__ __forceinline__ void qkmma8(f32x16& p0, f32x16& p1, const i32x8 (&kf)[4], const i32x8 (&q8)[2], const f32x16& init) {
  mfma8_32c(p0, kf[0], q8[0], init); mfma8_32c(p1, kf[1], q8[0], init); mfma8_32(p0, kf[2], q8[1]); mfma8_32(p1, kf[3], q8[1]);
}
__device__ __forceinline__ void qkt8(f32x16& p0, f32x16& p1, const LAS char* Ks, const i32x8 (&q8)[2], int r32, int hi, const f32x16& init) {
  i32x8 kf[4]; kfrag8(kf, Ks, r32, hi); qkmma8(p0, p1, kf, q8, init);
}
__device__ __forceinline__ void finishSM8(f32x16& p0, f32x16& p1, float& l_reg, i32x8& pf) {
#pragma unroll
  for (int r = 0; r < 16; ++r) p1[r] = __builtin_amdgcn_exp2f(p1[r]);
  float ps = 0;
#pragma unroll
  for (int r = 0; r < 16; ++r) ps += p0[r];
#pragma unroll
  for (int r = 0; r < 16; ++r) ps += p1[r];
  { auto rr = __builtin_amdgcn_permlane32_swap(__float_as_uint(ps), __float_as_uint(ps), false, false);
    ps = __uint_as_float(rr[0]) + __uint_as_float(rr[1]); }
  l_reg += ps;
#pragma unroll
  for (int i = 0; i < 4; ++i) { pf[i] = cvt4_f8(p0[4 * i], p0[4 * i + 1], p0[4 * i + 2], p0[4 * i + 3]); pf[4 + i] = cvt4_f8(p1[4 * i], p1[4 * i + 1], p1[4 * i + 2], p1[4 * i + 3]); }
}
__device__ __forceinline__ void vfrag8(i32x8 (&vf)[4], const LAS char* Vs, int r32, int hi) {
  const int xs = (r32 >> 1) & 3; const LAS char* vp = Vs + r32 * 64;
#pragma unroll
  for (int d0 = 0; d0 < 4; ++d0) vf[d0] = cat8(*reinterpret_cast<const LAS i32x4*>(vp + d0 * 2048 + (((2 * hi) ^ xs) << 4)), *reinterpret_cast<const LAS i32x4*>(vp + d0 * 2048 + (((2 * hi + 1) ^ xs) << 4)));
}
__device__ __forceinline__ void pvmma8(f32x16* o, const i32x8 (&vf)[4], const i32x8 pf) {
#pragma unroll
  for (int d0 = 0; d0 < 4; ++d0) mfma8_32(o[d0], pf, vf[d0]);
}
__device__ __forceinline__ void pv8(f32x16* o, const LAS char* Vs, const i32x8 pf, int r32, int hi) { i32x8 vf[4]; vfrag8(vf, Vs, r32, hi); pvmma8(o, vf, pf); }
template <int MODE> __device__ __forceinline__ void attn_unit_c8(const AUnit& u, const bf16_t* __restrict__ P, const unsigned char* __restrict__ Kh, const unsigned char* __restrict__ Vh, const float* __restrict__ qn, bf16_t* __restrict__ O, LAS char* lds) {
  int tid = threadIdx.x; asm volatile("" : "+v"(tid));
  const int wid = tid >> 6, lane = tid & 63, r32 = lane & 31, hi = lane >> 5;
  const int wv = __builtin_amdgcn_readfirstlane(tid >> 6);
  LAS char* V_lds = lds; LAS char* K_lds = lds + 6 * SHM8;
  LAS float* li_l = (LAS float*)(lds + 12 * SHM8) + wid * 64;
  float m_reg = -1e30f, l_reg = 0; f32x16 o[4] = {}; i32x8 q8[2];
  if constexpr (MODE != 0) {
    const bf16_t* Qw = P + (size_t)(u.qrow0 + wid * QBLK + r32) * LDP + u.qcol + hi * 32; constexpr float C = SCALE * 1.4426950408889634f;
#pragma unroll
    for (int s = 0; s < 2; ++s)
#pragma unroll
      for (int c = 0; c < 4; ++c) { const u32x4 w = *reinterpret_cast<const u32x4*>(Qw + s * 64 + c * 8);
        q8[s][2 * c] = cvt4_f8(bflo(w.x) * C, bfhi(w.x) * C, bflo(w.y) * C, bfhi(w.y) * C); q8[s][2 * c + 1] = cvt4_f8(bflo(w.z) * C, bfhi(w.z) * C, bflo(w.w) * C, bfhi(w.w) * C); }
  } else
  { const bf16_t* Qw = P + (size_t)(u.qrow0 + wid * QBLK + r32) * LDP + u.qcol + hi * 16; constexpr float C = SCALE * 1.4426950408889634f;
    float xa[2][16], xb[2][16]; float ss = 0.f;
#pragma unroll
    for (int s = 0; s < 2; ++s)
#pragma unroll
      for (int c = 0; c < 2; ++c) { const u32x4 wa = *reinterpret_cast<const u32x4*>(Qw + s * 64 + c * 8), wb = *reinterpret_cast<const u32x4*>(Qw + s * 64 + 32 + c * 8);
        xa[s][8 * c + 0] = bflo(wa.x); xa[s][8 * c + 1] = bfhi(wa.x); xa[s][8 * c + 2] = bflo(wa.y); xa[s][8 * c + 3] = bfhi(wa.y); xa[s][8 * c + 4] = bflo(wa.z); xa[s][8 * c + 5] = bfhi(wa.z); xa[s][8 * c + 6] = bflo(wa.w); xa[s][8 * c + 7] = bfhi(wa.w);
        xb[s][8 * c + 0] = bflo(wb.x); xb[s][8 * c + 1] = bfhi(wb.x); xb[s][8 * c + 2] = bflo(wb.y); xb[s][8 * c + 3] = bfhi(wb.y); xb[s][8 * c + 4] = bflo(wb.z); xb[s][8 * c + 5] = bfhi(wb.z); xb[s][8 * c + 6] = bflo(wb.w); xb[s][8 * c + 7] = bfhi(wb.w); }
#pragma unroll
    for (int s = 0; s < 2; ++s)
#pragma unroll
      for (int j = 0; j < 16; ++j) ss += xa[s][j] * xa[s][j] + xb[s][j] * xb[s][j];
    { auto rr = __builtin_amdgcn_permlane32_swap(__float_as_uint(ss), __float_as_uint(ss), false, false); ss = __uint_as_float(rr[0]) + __uint_as_float(rr[1]); }
    const float rq = rsqrtf(ss * (1.f / 128.f) + EPS) * C;
    const int pos = u.pa + wid * QBLK + r32;
#pragma unroll
    for (int s = 0; s < 2; ++s) { const float pp = (float)(s == 0 ? (pos >> 6) : (pos & 63));
#pragma unroll
      for (int j = 0; j < 16; ++j) { const float ga = qn[64 * s + 16 * hi + j], gb = qn[64 * s + 32 + 16 * hi + j];
        const float ang = pp * exp2f(-(float)(16 * hi + j) * (13.287712379549449f / 32.f)); const float cs_ = __cosf(ang), sn_ = __sinf(ang);
        const float a = xa[s][j] * rq * ga, b = xb[s][j] * rq * gb; xa[s][j] = a * cs_ - b * sn_; xb[s][j] = b * cs_ + a * sn_; }
#pragma unroll
      for (int i = 0; i < 4; ++i) { q8[s][i] = cvt4_f8(xa[s][4 * i], xa[s][4 * i + 1], xa[s][4 * i + 2], xa[s][4 * i + 3]); q8[s][4 + i] = cvt4_f8(xb[s][4 * i], xb[s][4 * i + 1], xb[s][4 * i + 2], xb[s][4 * i + 3]); } } }
  const unsigned koff = (unsigned)((tid >> 3) * 128 + (((tid & 7) ^ ((tid >> 3) & 7)) << 4));
  const unsigned voff = (unsigned)((tid >> 2) * 64 + (((tid & 3) ^ ((tid >> 3) & 3)) << 4));
#define GLDS(gp, lp) __builtin_amdgcn_global_load_lds((const unsigned*)(gp), (LAS unsigned*)(lp), 16, 0, 0)
  const int tb = MODE == 1 ? (u.seg2row >> 6) - 4 : 0;
#define DMA8(ss_, j_) do { _Pragma("unroll") for (int _h = 0; _h < 2; ++_h) { const int _j = (j_) + _h, _t = _j < 4 ? _j : _j + tb; \
    GLDS(Kh + (size_t)_t * 8192 + koff, K_lds + ((ss_) * 2 + _h) * SHM8 + wv * 1024); GLDS(Vh + (size_t)_t * 8192 + voff, V_lds + ((ss_) * 2 + _h) * SHM8 + wv * 1024); } } while (0)
#define MASK8(p0_, p1_, j_) do { if constexpr (MODE == 1) mask_tile<1>(p0_, p1_, u, (j_), wid, r32, hi, (const LAS float*)nullptr); } while (0)
#define DWAIT() asm volatile("s_waitcnt vmcnt(0)" ::: "memory")
#define EXP16(p_) do { _Pragma("unroll") for (int r = 0; r < 16; ++r) p_[r] = __builtin_amdgcn_exp2f(p_[r]); } while (0)
  f32x16 pA0, pA1, pB0, pB1, acc0 = {}; i32x8 pf; const int NT = u.NT;
  DMA8(0, 0); DMA8(1, 2); DWAIT(); __syncthreads();
  qkt8(pA0, pA1, K_lds, q8, r32, hi, acc0);
  asm volatile("s_nop 7\n\ts_nop 7\n\ts_nop 7\n\ts_nop 7\n\ts_nop 7\n\ts_nop 7" : "+v"(pA0), "+v"(pA1));
  firstSM(pA0, pA1, m_reg);
#pragma unroll
  for (int r = 0; r < 16; ++r) acc0[r] = -m_reg;
  int s0 = 0, s1 = 1, s2 = 2;
  for (int j = 1; j + 1 < NT; j += 2) {
    if (j + 3 < NT) DMA8(s2, j + 3);
    { i32x8 vf[4]; SBAR(); { i32x8 kf[4]; kfrag8(kf, K_lds + (s0 * 2 + 1) * SHM8, r32, hi); qkmma8(pB0, pB1, kf, q8, acc0); }
      vfrag8(vf, V_lds + (s0 * 2) * SHM8, r32, hi);
      finishSM8(pA0, pA1, l_reg, pf); SBAR();
      pvmma8(o, vf, pf); }
    MASK8(pB0, pB1, j); EXP16(pB0);
    { i32x8 vf[4]; SBAR(); { i32x8 kf[4]; kfrag8(kf, K_lds + (s1 * 2) * SHM8, r32, hi); qkmma8(pA0, pA1, kf, q8, acc0); }
      vfrag8(vf, V_lds + (s0 * 2 + 1) * SHM8, r32, hi);
      finishSM8(pB0, pB1, l_reg, pf); SBAR();
      pvmma8(o, vf, pf); }
    MASK8(pA0, pA1, j + 1); EXP16(pA0);
    DWAIT(); __syncthreads();
    { const int t_ = s0; s0 = s1; s1 = s2; s2 = t_; }
  }
  SBAR(); qkt8(pB0, pB1, K_lds + (s0 * 2 + 1) * SHM8, q8, r32, hi, acc0);
  finishSM8(pA0, pA1, l_reg, pf); SBAR();
  pv8(o, V_lds + (s0 * 2) * SHM8, pf, r32, hi);
  MASK8(pB0, pB1, NT - 1); EXP16(pB0);
  finishSM8(pB0, pB1, l_reg, pf); SBAR();
  pv8(o, V_lds + (s0 * 2 + 1) * SHM8, pf, r32, hi);
  asm volatile("s_nop 7\n\ts_nop 7\n\ts_nop 7\n\ts_nop 7\n\ts_nop 7\n\ts_nop 7" : "+v"(o[0]), "+v"(o[1]), "+v"(o[2]), "+v"(o[3]));
  if (MODE == 1 && u.has_sink) l_reg += __builtin_amdgcn_exp2f(u.sink * 1.4426950408889634f - m_reg);
  if (hi == 0) li_l[r32] = l_reg; asm volatile("s_waitcnt lgkmcnt(0)" ::: "memory");
  float rli[16];
#pragma unroll
  for (int r = 0; r < 16; ++r) rli[r] = __builtin_amdgcn_rcpf(li_l[crow(r, hi)]);
  if constexpr (MODE == 3) { float* Ow = reinterpret_cast<float*>(O) + (size_t)(u.qrow0 + wid * QBLK) * DM + u.ocol;
#pragma unroll
    for (int r = 0; r < 16; ++r) { const int orow = crow(r, hi);
#pragma unroll
      for (int d0 = 0; d0 < 4; ++d0) Ow[(size_t)orow * DM + d0 * 32 + r32] = o[d0][r] * rli[r]; }
  } else
  if constexpr (MODE == 1) { bf16_t* Ow = O + (size_t)(u.qrow0 + wid * QBLK) * DM + u.ocol;
#pragma unroll
    for (int r = 0; r < 16; ++r) { const int orow = crow(r, hi);
#pragma unroll
      for (int d0 = 0; d0 < 4; ++d0) { const float v = o[d0][r] * rli[r]; Ow[(size_t)orow * DM + d0 * 32 + r32] = (bf16_t)(cvtpk(v, v) & 0xffffu); } }
  } else
  store_o8(reinterpret_cast<unsigned char*>(O) + (size_t)(u.qrow0 + wid * QBLK) * DM + u.ocol, o, rli, r32, hi);
  __syncthreads();
#undef GLDS
#undef DMA8
#undef MASK8
#undef DWAIT
#undef EXP16
}
__device__ __forceinline__ void attn_unit_b(const AUnit& u, const bf16_t* __restrict__ P, float* __restrict__ OB, LAS char* lds) {
  int tid = threadIdx.x; asm volatile("" : "+v"(tid));
  const int lane = tid & 63, r32 = lane & 31, hi = lane >> 5;
  const int wv = __builtin_amdgcn_readfirstlane(tid >> 6), rg = wv & 3, kh = wv >> 2;
  LAS char* K_lds = lds; LAS char* V_lds = lds + 2 * SHM_K;
  LAS char* Pex = lds + 2 * SHM_K + 4 * SHM_V;
  LAS float* st = (LAS float*)(lds + 2 * SHM_K + 4 * SHM_V + 2 * 8 * 2048);
  f32x16 o[4] = {}; bf16x8 qr[8];
  { const bf16_t* Qw = P + (size_t)(u.qrow0 + rg * QBLK + r32) * LDP + u.qcol + hi * 8; constexpr float C = SCALE * 1.4426950408889634f;
#pragma unroll
    for (int d0 = 0; d0 < 8; ++d0) { const u32x4 w = __builtin_bit_cast(u32x4, *reinterpret_cast<const bf16x8*>(Qw + d0 * 16)); u32x4 o_;
      o_.x = cvtpk(bflo(w.x) * C, bfhi(w.x) * C); o_.y = cvtpk(bflo(w.y) * C, bfhi(w.y) * C); o_.z = cvtpk(bflo(w.z) * C, bfhi(w.z) * C); o_.w = cvtpk(bflo(w.w) * C, bfhi(w.w) * C);
      qr[d0] = __builtin_bit_cast(bf16x8, o_); } }
  const char* Kh = (const char*)(P + (size_t)u.kbase * LDP + u.kcol); const char* Vh = (const char*)(P + (size_t)u.kbase * LDP + u.vcol);
  const unsigned koff0 = (unsigned)((tid >> 4) * (LDP * 2)) + (unsigned)(((tid & 15) * 16) ^ (((tid >> 4) & 7) << 4));
  const int vs_ = tid >> 5, vkk = (vs_ >> 2) * 8 + ((tid & 31) >> 2), vk0 = (vkk & ~0xC) | ((vkk & 4) << 1) | ((vkk & 8) >> 1), vc0 = (vs_ & 3) * 32 + (tid & 3) * 8;
  const unsigned voff0 = (unsigned)(vk0 * (LDP * 2)) + (unsigned)(vc0 * 2);
  constexpr unsigned RS32 = 32u * LDP * 2u;
  const int vrd = (int)(unsigned)(uintptr_t)V_lds + kh * (int)SHM_V + v_rd_base(lane);
#define GLDS(gp, lp) __builtin_amdgcn_global_load_lds((const unsigned*)(gp), (LAS unsigned*)(lp), 16, 0, 0)
#define DMAK(slot, k0) do { const size_t _kb = (size_t)(k0) * (LDP * 2); LAS char* _kd = K_lds + (slot) * SHM_K + wv * 1024; GLDS(Kh + _kb + koff0, _kd); GLDS(Kh + _kb + koff0 + RS32, _kd + 8192); } while (0)
#define DMAV(slot, k0) do { const size_t _kb = (size_t)(k0) * (LDP * 2); LAS char* _vd = V_lds + (slot) * (2 * SHM_V) + wv * 1024; \
    GLDS(Vh + _kb + voff0, _vd); GLDS(Vh + _kb + voff0 + RS32, _vd + 8192); GLDS(Vh + _kb + voff0 + 256, _vd + SHM_V); GLDS(Vh + _kb + voff0 + RS32 + 256, _vd + SHM_V + 8192); } while (0)
#define DWAIT() asm volatile("s_waitcnt vmcnt(0)" ::: "memory")
#define LWAIT() asm volatile("s_waitcnt lgkmcnt(0)" ::: "memory")
#define QKH(s_, ks, init_) do { f32x16 _s1 = {}; s_ = init_; const LAS char* _K = K_lds + (ks) * SHM_K; bf16x8 _kf[8]; \
    _Pragma("unroll") for (int d0 = 0; d0 < 8; ++d0) _kf[d0] = *reinterpret_cast<const LAS bf16x8*>(_K + KSWZ(kh * 32 + r32, (d0 * 16 + hi * 8) * 2)); \
    _Pragma("unroll") for (int d0 = 0; d0 < 8; d0 += 2) { s_ = __builtin_amdgcn_mfma_f32_32x32x16_bf16(_kf[d0], qr[d0], s_, 0, 0, 0); _s1 = __builtin_amdgcn_mfma_f32_32x32x16_bf16(_kf[d0 + 1], qr[d0 + 1], _s1, 0, 0, 0); } \
    _Pragma("unroll") for (int r = 0; r < 16; ++r) s_[r] += _s1[r]; } while (0)
#define PK4(Pv, BASE, OUT) do { unsigned a0 = cvtpk(Pv[BASE + 0], Pv[BASE + 1]), a1 = cvtpk(Pv[BASE + 2], Pv[BASE + 3]);   \
    unsigned b0 = cvtpk(Pv[BASE + 4], Pv[BASE + 5]), b1 = cvtpk(Pv[BASE + 6], Pv[BASE + 7]);                              \
    auto r0 = __builtin_amdgcn_permlane32_swap(a0, b0, false, false); auto r1 = __builtin_amdgcn_permlane32_swap(a1, b1, false, false); \
    u32x4 w = {r0[0], r1[0], r0[1], r1[1]}; OUT = *reinterpret_cast<bf16x8*>(&w); } while (0)
#define SOFT_PUB(s_, f0_, f1_, par) do { _Pragma("unroll") for (int r = 0; r < 16; ++r) { s_[r] = __builtin_amdgcn_exp2f(s_[r]); lsum += s_[r]; } \
    PK4(s_, 0, f0_); PK4(s_, 8, f1_); LAS char* _px = Pex + (par) * 16384 + wv * 2048 + lane * 16; *(LAS bf16x8*)_px = f0_; *(LAS bf16x8*)(_px + 1024) = f1_; } while (0)
  const int NT = u.NT; float lsum = 0.f; bf16x8 own0, own1; f32x16 sc, acc0 = {};
  DMAK(0, 0); DMAV(0, 0); DMAK(1, 64); DWAIT(); __syncthreads();
  QKH(sc, 0, acc0);
  { float pmax = sc[0];
#pragma unroll
    for (int r = 1; r < 16; ++r) pmax = fmaxf(pmax, sc[r]);
    { auto rr = __builtin_amdgcn_permlane32_swap(__float_as_uint(pmax), __float_as_uint(pmax), false, false); pmax = fmaxf(__uint_as_float(rr[0]), __uint_as_float(rr[1])); }
    if (hi == 0) st[wv * 64 + r32] = pmax; LWAIT(); __syncthreads();
    const float mref = fmaxf(pmax, st[(wv ^ 4) * 64 + r32]); LWAIT();
#pragma unroll
    for (int r = 0; r < 16; ++r) { acc0[r] = -mref; sc[r] -= mref; } }
  SOFT_PUB(sc, own0, own1, 0);
  LWAIT(); __syncthreads();
  for (int j = 0; j < NT; ++j) {
    if (j + 2 < NT) DMAK(j & 1, (j + 2) * 64);
    if (j + 1 < NT) DMAV((j + 1) & 1, (j + 1) * 64);
    const LAS char* _pq = Pex + (j & 1) * 16384 + (wv ^ 4) * 2048 + lane * 16;
    const bf16x8 q0 = *(const LAS bf16x8*)_pq, q1 = *(const LAS bf16x8*)(_pq + 1024);
    const bf16x8 pa0 = kh ? q0 : own0, pa1 = kh ? q1 : own1, pa2 = kh ? own0 : q0, pa3 = kh ? own1 : q1;
    pv_d0(o, vrd + (j & 1) * (2 * (int)SHM_V), pa0, pa1, pa2, pa3);
    if (j + 1 < NT) { QKH(sc, (j + 1) & 1, acc0); SOFT_PUB(sc, own0, own1, (j + 1) & 1); }
    LWAIT(); DWAIT(); __syncthreads();
  }
  { auto rr = __builtin_amdgcn_permlane32_swap(__float_as_uint(lsum), __float_as_uint(lsum), false, false); lsum = __uint_as_float(rr[0]) + __uint_as_float(rr[1]); }
  if (hi == 0) st[wv * 64 + r32] = lsum; LWAIT(); __syncthreads();
  float rli[16];
#pragma unroll
  for (int r = 0; r < 16; ++r) rli[r] = __builtin_amdgcn_rcpf(st[wv * 64 + crow(r, hi)] + st[(wv ^ 4) * 64 + crow(r, hi)]);
  float* Ow = OB + (size_t)(u.qrow0 + rg * QBLK) * DM + u.ocol + kh * 128;
#pragma unroll
  for (int r = 0; r < 16; ++r) { const int orow = crow(r, hi);
#pragma unroll
    for (int d0 = 0; d0 < 4; ++d0) Ow[(size_t)orow * DM + d0 * 32 + r32] = o[d0][r] * rli[r]; }
  LWAIT(); __syncthreads();
#undef GLDS
#undef DMAK
#undef DMAV
#undef DWAIT
#undef LWAIT
#undef QKH
#undef PK4
#undef SOFT_PUB
}
}

struct Ctx {
    LAS unsigned char* lds; int tid, lane, wave, G, bid, gw, NGW;
    float* mod; float* affl; float* affc; int* rows; float* gate; int* slot; float* xc; float* sax; float* sah; float* sas; float* wsc; float* shd; signed char* hid8; float* so; signed char* o8; bf16_t* dlt;
    bf16_t *win, *wout, *wgu, *wdn, *r1, *r2, *hid, *y; float* ob; unsigned char* y8; unsigned char* k8; unsigned char* v8; unsigned char* k8d; unsigned char* v8d;
};

__device__ __forceinline__ Ctx make_ctx(const Params& p, LAS unsigned char* lds) {
    Ctx F; int tid = threadIdx.x; asm volatile("" : "+v"(tid));
    unsigned long long wsb = (unsigned long long)p.ws; asm volatile("" : "+s"(wsb)); __attribute__((address_space(1))) unsigned char* ws = (__attribute__((address_space(1))) unsigned char*)wsb;
    int bid = blockIdx.x; asm volatile("" : "+s"(bid));
    F.lds = lds; F.tid = tid; F.lane = tid & 63; F.wave = __builtin_amdgcn_readfirstlane(tid >> 6);
    F.G = gridDim.x; F.bid = bid; F.gw = bid * NWAVES + F.wave; F.NGW = F.G * NWAVES;
    F.mod = (float*)(ws + WS_MOD); F.affl = (float*)(ws + WS_AFFL); F.affc = (float*)(ws + WS_AFFC); F.rows = (int*)(ws + WS_ROWS); F.gate = (float*)(ws + WS_GATE);
    F.slot = (int*)(ws + WS_SLOT); F.xc = (float*)(ws + WS_XC); F.sax = (float*)(ws + WS_SAX); F.sah = (float*)(ws + WS_SAH); F.sas = (float*)(ws + WS_SAS); F.wsc = (float*)(ws + WS_WSC); F.shd = (float*)(ws + WS_SHD); F.hid8 = (signed char*)(ws + WS_R2 + 204 * MiB); F.so = (float*)(ws + WS_SO); F.o8 = (signed char*)(ws + WS_R3); F.dlt = (bf16_t*)(ws + WS_DLT);
    F.win = (bf16_t*)(ws + WS_WIN); F.wout = (bf16_t*)(ws + WS_WOUT); F.wgu = (bf16_t*)(ws + WS_WGU); F.wdn = (bf16_t*)(ws + WS_WDN);
    F.r1 = (bf16_t*)(ws + WS_R1); F.r2 = (bf16_t*)(ws + WS_R2); F.hid = (bf16_t*)(ws + WS_R2); F.y = (bf16_t*)(ws + WS_R3); F.y8 = (unsigned char*)(ws + WS_R3); F.k8 = (unsigned char*)(ws + WS_K8); F.v8 = (unsigned char*)(ws + WS_V8); F.k8d = (unsigned char*)(ws + WS_K8D); F.v8d = (unsigned char*)(ws + WS_V8D); F.ob = (float*)(ws + WS_R3);
    return F;
}
__device__ __forceinline__ void transpose_item_i8(const float* __restrict__ src, int K, int N, signed char* __restrict__ dst, int rs, int roff, LAS float* scr, int idx, int lane, const float inv, const bool f8 = false) {
    const int nblk = N >> 6, kb = idx / nblk, nb = idx - kb * nblk, k0 = kb * 64, n0 = nb * 64;
    const int kr = lane >> 4, nc = (lane & 15) * 4;
    const float* s = src + (size_t)(k0 + kr) * N + n0 + nc;
    f32x4 v[16];
#pragma unroll
    for (int i = 0; i < 16; ++i) v[i] = __builtin_nontemporal_load((const f32x4*)(s + (size_t)(4 * i) * N));
#pragma unroll
    for (int i = 0; i < 16; ++i) { LAS float* q = scr + (kr + 4 * i) * 65 + nc; q[0] = v[i].x; q[1] = v[i].y; q[2] = v[i].z; q[3] = v[i].w; }
    LDS_WAIT();
    const int c = lane & 3;
#pragma unroll
    for (int j = 0; j < 4; ++j) { const int n = (lane >> 2) + 16 * j; const LAS float* q = scr + (16 * c) * 65 + n;
        u32x4 o; o.x = pack_q4(q[0], q[65], q[130], q[195], inv, f8); o.y = pack_q4(q[260], q[325], q[390], q[455], inv, f8);
        o.z = pack_q4(q[520], q[585], q[650], q[715], inv, f8); o.w = pack_q4(q[780], q[845], q[910], q[975], inv, f8);
        const int ng = n0 + n; int row;
        if (rs > 0) row = (ng >> 2) * rs + roff + (ng & 3);
        else { const bool roped = ng < 1280 || (ng >= 1536 && ng < 3584); const int d = ng & 127;
            row = roped ? (ng & ~127) + (d & 64) + ((d & 31) >> 2) * 8 + ((d >> 5) & 1) * 4 + (d & 3) : ng; }
        *(u32x4*)(dst + (size_t)row * K + k0 + 16 * c) = o; }
    LDS_WAIT();
}
#ifndef CV_INTERLEAVE
#define CV_INTERLEAVE 1
#endif
constexpr int CV_IN = 32 * 72, CV_OUT = 32 * 32, CV_E = 768, CV_PER_L = CV_IN + CV_OUT + 3 * NEXP * CV_E, CV_TOTAL = 2 * CV_PER_L, CV_FIRST = CV_INTERLEAVE ? CV_IN : CV_TOTAL;
__device__ __forceinline__ void conv_item(const Params& p, const Ctx& F, LAS float* scr, const int it, const int lane) {
    const int l = it / CV_PER_L; int r = it - l * CV_PER_L;
    if (r < CV_IN) { transpose_item_i8(p.w_in + (size_t)l * DM * INW, DM, INW, (signed char*)F.win + (size_t)l * INW * DM, l == 0 ? -1 : 4, 0, scr, r, lane, 1.f / F.wsc[l]); return; } r -= CV_IN;
    if (r < CV_OUT) { transpose_item_i8(p.w_out + (size_t)l * DM * DM, DM, DM, (signed char*)F.wout + (size_t)l * DM * DM, 4, 0, scr, r, lane, 1.f / F.wsc[98 + l], l == 1); return; } r -= CV_OUT;
    const int ty = r / (NEXP * CV_E), e = (r % (NEXP * CV_E)) / CV_E, idx = r % CV_E; const size_t le = (size_t)l * NEXP + e;
    if (ty == 0) transpose_item_i8(p.w_gate + le * DM * DEXP, DM, DEXP, (signed char*)F.wgu + le * 3072 * DM, 8, 0, scr, idx, lane, 1.f / F.wsc[2 + 2 * le]);
    else if (ty == 1) transpose_item_i8(p.w_up + le * DM * DEXP, DM, DEXP, (signed char*)F.wgu + le * 3072 * DM, 8, 4, scr, idx, lane, 1.f / F.wsc[3 + 2 * le]);
    else transpose_item_i8(p.w_down + le * DEXP * DM, DEXP, DM, (signed char*)F.wdn + le * DM * DEXP, 4, 0, scr, idx, lane, 1.f / F.wsc[66 + le], true);
}

__device__ __forceinline__ void conv_some(const Params& p, const Ctx& F, int& cv_it, const int k) {
    int t2 = threadIdx.x; asm volatile("" : "+v"(t2));
    const int lane = t2 & 63, wave = __builtin_amdgcn_readfirstlane(t2 >> 6);
    LAS float* scr = (LAS float*)(F.lds + wave * 16640);
    for (int q = 0; q < k && cv_it < CV_TOTAL; ++q, cv_it += F.NGW) conv_item(p, F, scr, cv_it, lane);
}

__device__ __forceinline__ void phase_prologue(const Params& p, const Ctx& F) {
    for (int item = F.bid; item < 192; item += F.G) {
        LAS float* sl = (LAS float*)F.lds; LAS float* red = (LAS float*)(F.lds + 73728);
        for (int i = F.tid; i < 9 * DM; i += NTHR) { const int r = i >> 11, d = i & 2047; const float v = r < 8 ? p.c[r * DM + d] : p.c_ctx[d]; sl[i] = silu_f(v); }
        __syncthreads();
        const int l = item / 96, cb = item % 96;
        const float* W = p.w_ada + ((size_t)l * DM + F.wave * 256) * MODW + cb * 128 + 2 * F.lane;
        float a0[9], a1[9];
#pragma unroll
        for (int r = 0; r < 9; ++r) { a0[r] = 0.f; a1[r] = 0.f; }
#pragma unroll 8
        for (int d = 0; d < 256; ++d) { const f32x2 w = *(const f32x2*)(W + (size_t)d * MODW);
#pragma unroll
            for (int r = 0; r < 9; ++r) { const float s = sl[r * DM + F.wave * 256 + d]; a0[r] += s * w.x; a1[r] += s * w.y; } }
#pragma unroll
        for (int r = 0; r < 9; ++r) { red[(F.wave * 9 + r) * 128 + 2 * F.lane] = a0[r]; red[(F.wave * 9 + r) * 128 + 2 * F.lane + 1] = a1[r]; }
        __syncthreads();
        for (int i = F.tid; i < 9 * 128; i += NTHR) { const int r = i >> 7, cc = i & 127; float s = p.b_ada[l * MODW + cb * 128 + cc];
#pragma unroll
            for (int w = 0; w < 8; ++w) s += red[(w * 9 + r) * 128 + cc];
            F.mod[(size_t)(l * 9 + r) * MODW + cb * 128 + cc] = s; }
        __syncthreads();
    }
    for (int m = F.bid; m < 100; m += F.G) {
        LAS float* red = (LAS float*)F.lds;
        const float* W; int N;
        if (m < 2) { W = p.w_in + (size_t)m * DM * INW; N = INW; }
        else if (m >= 98) { W = p.w_out + (size_t)(m - 98) * DM * DM; N = DM; }
        else if (m >= 66) { W = p.w_down + (size_t)(m - 66) * DEXP * DM; N = DM; }
        else { const int le = (m - 2) >> 1; W = ((m & 1) ? p.w_up : p.w_gate) + (size_t)le * DM * DEXP; N = DEXP; }
        float ss = 0.f;
        for (int i = F.tid; i < 8 * N; i += NTHR) { const float v = W[i]; ss += v * v; }
        ss = wave_sum(ss);
        if (F.lane == 0) red[F.wave] = ss;
        __syncthreads();
        if (F.tid == 0) { float t = 0.f;
#pragma unroll
            for (int w = 0; w < 8; ++w) t += red[w];
            F.wsc[m] = fmaxf(6.0f * sqrtf(t / (float)(8 * N)) * (1.f / 127.f), 1e-30f); }
        __syncthreads();
    }
}

__device__ __forceinline__ void row_ptrs(const Params& p, const Ctx& F, const int l, const int b, const int t, const float*& xs, float*& xd) {
    const unsigned long long blat = (l <= 1) ? (unsigned long long)p.x : (unsigned long long)p.out, bctx = (l <= 1) ? (unsigned long long)p.ctx : (unsigned long long)F.xc;
    const bool isctx = t < CTXL;
    const size_t roff = isctx ? ((size_t)b * CTXL + t) * DM : ((size_t)b * SEQ + (t - CTXL)) * DM;
    xs = (const float*)(isctx ? bctx : blat) + roff;
    xd = (isctx ? F.xc : p.out) + roff;
}
__device__ __forceinline__ void gather_y1(const Ctx& F, const int s, f32x4 (&acc)[8]) {
#pragma unroll
    for (int j = 0; j < 8; ++j) acc[j] = (f32x4){0.f, 0.f, 0.f, 0.f};
#pragma unroll 2
    for (int e = 0; e < 16; ++e) { const int se = __builtin_amdgcn_readlane(s, e);
        if (se >= 0) { const unsigned char* yr = F.y8 + (size_t)se * DM + 4 * F.lane;
#pragma unroll
            for (int j = 0; j < 8; ++j) { const unsigned w = __builtin_nontemporal_load((const unsigned*)(yr + 256 * j)); acc[j] += unpack_f8x4(w); } } }
}
__device__ __forceinline__ void gather_y(const Ctx& F, const int s, f32x4 (&acc)[8]) {
#pragma unroll
    for (int j = 0; j < 8; ++j) acc[j] = (f32x4){0.f, 0.f, 0.f, 0.f};
    unsigned m = (unsigned)__ballot(s >= 0) & 0xffffu;
    while (m) {
        const int e0 = __builtin_ctz(m); m &= m - 1;
        const bool two = m != 0; const int e1 = two ? __builtin_ctz(m) : e0; if (two) m &= m - 1;
        const int s0 = __builtin_amdgcn_readlane(s, e0), s1 = __builtin_amdgcn_readlane(s, e1);
        const unsigned char* y0 = F.y8 + (size_t)s0 * DM + 4 * F.lane; const unsigned char* y1 = F.y8 + (size_t)s1 * DM + 4 * F.lane;
        unsigned w0[8], w1[8];
#pragma unroll
        for (int j = 0; j < 8; ++j) w0[j] = __builtin_nontemporal_load((const unsigned*)(y0 + 256 * j));
#pragma unroll
        for (int j = 0; j < 8; ++j) w1[j] = __builtin_nontemporal_load((const unsigned*)(y1 + 256 * j));
        const float k1 = two ? 1.f : 0.f;
#pragma unroll
        for (int j = 0; j < 8; ++j) { acc[j] += unpack_f8x4(w0[j]); acc[j] += unpack_f8x4(w1[j]) * k1; }
    }
}
__device__ __forceinline__ void phase_norm1(const Params& p, const Ctx& F, const int l) {
    const bool fin = (l == 2), comb = (l > 0);
    if (l == 0) { LAS float* scr = (LAS float*)(F.lds + F.wave * 16640); for (int it = F.gw; it < CV_FIRST; it += F.NGW) conv_item(p, F, scr, it, F.lane); }
    const int b = F.gw & 7, tstride = F.NGW >> 3;
    int cur_m = -1; f32x4 A[8], Bv[8];
    int t = F.gw >> 3; if (fin) { while (t < CTXL) t += tstride; }
    f32x4 vn[8], accn[8]; u32x2 dn[8]; int sn = -1;
#pragma unroll
    for (int j = 0; j < 8; ++j) dn[j] = (u32x2){0u, 0u};
#pragma unroll
    for (int j = 0; j < 8; ++j) accn[j] = (f32x4){0.f, 0.f, 0.f, 0.f};
    if (t < TPB) { const float* xs; float* xd; row_ptrs(p, F, l, b, t, xs, xd);
#pragma unroll
        for (int j = 0; j < 8; ++j) vn[j] = __builtin_nontemporal_load((const f32x4*)xs + F.lane + 64 * j);
        if (comb) {
#pragma unroll
            for (int j = 0; j < 8; ++j) dn[j] = __builtin_nontemporal_load((const u32x2*)(F.dlt + ((size_t)b * TPB + t) * DM + 4 * F.lane + 256 * j)); }
        if (comb) { int s0 = -1; if (F.lane < 16) s0 = F.slot[(unsigned)((b * 16 + F.lane) * TPB + t)]; { if (fin) gather_y1(F, s0, accn); else gather_y(F, s0, accn); }
            if (t + tstride < TPB && F.lane < 16) sn = F.slot[(unsigned)((b * 16 + F.lane) * TPB + t + tstride)]; } }
    for (; t < TPB; t += tstride) {
        const bool isctx = t < CTXL;
        const int mrow = isctx ? 8 : b;
        const float* xs; float* xd; row_ptrs(p, F, l, b, t, xs, xd);
        f32x4 v[8];
#pragma unroll
        for (int j = 0; j < 8; ++j) v[j] = vn[j] + (f32x4){bflo(dn[j].x), bfhi(dn[j].x), bflo(dn[j].y), bfhi(dn[j].y)};
        if (comb) {
            const float* gt = F.mod + (size_t)((l - 1) * 9 + mrow) * MODW + 5 * DM;
#pragma unroll
            for (int j = 0; j < 8; ++j) { v[j] += *((const f32x4*)gt + F.lane + 64 * j) * accn[j] * (1.f / Y_SCALE); if (!fin) *((f32x4*)xd + F.lane + 64 * j) = v[j]; }
        }
        { const int t2 = t + tstride;
          if (t2 < TPB) { const float* xs2; float* xd2; row_ptrs(p, F, l, b, t2, xs2, xd2);
#pragma unroll
            for (int j = 0; j < 8; ++j) vn[j] = __builtin_nontemporal_load((const f32x4*)xs2 + F.lane + 64 * j);
            if (comb) {
#pragma unroll
                for (int j = 0; j < 8; ++j) dn[j] = __builtin_nontemporal_load((const u32x2*)(F.dlt + ((size_t)b * TPB + t2) * DM + 4 * F.lane + 256 * j)); }
            if (comb) { { if (fin) gather_y1(F, sn, accn); else gather_y(F, sn, accn); } const int t3 = t2 + tstride; sn = -1; if (t3 < TPB && F.lane < 16) sn = F.slot[(unsigned)((b * 16 + F.lane) * TPB + t3)]; } } }
        if (mrow != cur_m) { cur_m = mrow;
            if (!fin) {
                const float* mr = F.mod + (size_t)(l * 9 + mrow) * MODW;
#pragma unroll
                for (int j = 0; j < 8; ++j) { const f32x4 g = *((const f32x4*)(p.g_mix + l * DM) + F.lane + 64 * j), sc = *((const f32x4*)(mr + DM) + F.lane + 64 * j);
                    A[j] = g * (sc + 1.f); Bv[j] = *((const f32x4*)mr + F.lane + 64 * j); }
            }
        }
        float ss = 0.f;
#pragma unroll
        for (int j = 0; j < 8; ++j) ss += (v[j].x * v[j].x + v[j].y * v[j].y) + (v[j].z * v[j].z + v[j].w * v[j].w);
        const float rstd = rsqrtf(wave_sum(ss) * (1.f / DM) + EPS);
        if (fin) {
#pragma unroll
            for (int j = 0; j < 8; ++j) __builtin_nontemporal_store(v[j] * rstd * *((const f32x4*)p.g_final + F.lane + 64 * j), (f32x4*)xd + F.lane + 64 * j);
        } else {
            float am = 0.f;
#pragma unroll
            for (int j = 0; j < 8; ++j) { v[j] = v[j] * rstd * A[j] + Bv[j]; am = fmaxf(am, amax4(v[j])); }
            am = fmaxf(wave_max(am), 1e-20f); const float inv = 127.f / am;
            unsigned* xn = (unsigned*)((signed char*)F.r1 + ((size_t)b * TPB + t) * DM) + F.lane;
#pragma unroll
            for (int j = 0; j < 8; ++j) __builtin_nontemporal_store(pack_i8x4(v[j].x, v[j].y, v[j].z, v[j].w, inv), xn + 64 * j);
            if (F.lane == 0) F.sax[b * TPB + t] = am * (1.f / 127.f);
        }
    }
}

__device__ __forceinline__ void v8_tiles_n(const Ctx& F, const int col0, const int nh, unsigned char* dstb) {
        for (int it = F.gw; it < NB * nh * 68; it += F.NGW) {
            const int tile = it % 68, bk = it / 68, kvh = bk % nh, b = bk / nh;
            const bf16_t* srcv = F.r2 + (size_t)(b * TPB + tile * 64) * INW + col0 + kvh * 128 + 2 * F.lane;
            unsigned w[64];
#pragma unroll
            for (int kk = 0; kk < 64; ++kk) w[kk] = *(const unsigned*)(srcv + (size_t)kk * INW);
            unsigned char* dst = dstb + (size_t)it * 8192 + F.lane * 128;
#pragma unroll
            for (int half = 0; half < 2; ++half)
#pragma unroll
                for (int q = 0; q < 4; ++q) { u32x4 o;
#pragma unroll
                    for (int a = 0; a < 4; ++a) { const int s0 = 16 * q + 4 * a, hi_ = s0 >> 5, j = s0 & 31, key = 32 * (j >> 4) + 8 * ((j >> 2) & 3) + 4 * hi_;
                        float f[4];
#pragma unroll
                        for (int i = 0; i < 4; ++i) f[i] = half ? bfhi(w[key + i]) : bflo(w[key + i]);
                        o[a] = pack_f8x4(f[0], f[1], f[2], f[3], 1.f); }
                    *(u32x4*)(dst + half * 64 + q * 16) = o; }
        }
}
__device__ __forceinline__ void v8_tiles(const Ctx& F) { v8_tiles_n(F, 1280, 2, F.v8); }
__device__ __forceinline__ void phase_qkfix(const Params& p, const Ctx& F, const int l) {
    LAS f32x2* cs = (LAS f32x2*)F.lds;
    for (int i = F.tid; i < 2048; i += NTHR) { const int pp = i >> 5, fi = i & 31; const float inv = exp2f(-(float)fi * (13.287712379549449f / 32.f)); const float ang = (float)pp * inv;
        cs[i] = (f32x2){__cosf(ang), __sinf(ang)}; }
    __syncthreads();
    const int NV = l == 0 ? 26 : 2, nrows = l == 0 ? NB * SEQ : NROWS;
    const long total = (long)nrows * NV;
    const int sub = F.lane >> 4, jl = F.lane & 15, ax = jl >> 3, f0 = (jl & 7) * 4;
    for (long V0 = (long)F.gw * 4; V0 < total; V0 += (long)F.NGW * 4) {
        const long V = V0 + sub; const bool valid = V < total; const long Vc = valid ? V : 0;
        const int rr = (int)(Vc / NV), v = (int)(Vc % NV);
        int R, pos; bool lat;
        if (l == 0) { const int b = rr >> 12, s = rr & 4095; R = b * TPB + CTXL + s; pos = s; lat = true; }
        else { R = rr; const int t = rr % TPB; lat = t >= CTXL; pos = t - CTXL; }
        const int col = l == 0 ? v * 128 + (v >= 10 ? 256 : 0) : (8 + v) * 128;
        bf16_t* ptr = F.r2 + (size_t)R * INW + col + ax * 64 + f0;
        const u32x2 wl = *(const u32x2*)ptr, wh = *(const u32x2*)(ptr + 32);
        float xl[4] = {bflo(wl.x), bfhi(wl.x), bflo(wl.y), bfhi(wl.y)}, xh[4] = {bflo(wh.x), bfhi(wh.x), bflo(wh.y), bfhi(wh.y)};
        if (l == 1) {
            float ss = 0.f;
#pragma unroll
            for (int q = 0; q < 4; ++q) ss += xl[q] * xl[q] + xh[q] * xh[q];
            ss += __shfl_xor(ss, 1); ss += __shfl_xor(ss, 2); ss += __shfl_xor(ss, 4); ss += __shfl_xor(ss, 8);
            const float rstd = rsqrtf(ss * (1.f / 128.f) + EPS);
            const float* g = p.kn + ax * 64 + f0;
#pragma unroll
            for (int q = 0; q < 4; ++q) { xl[q] = xl[q] * rstd * g[q]; xh[q] = xh[q] * rstd * g[32 + q]; }
        }
        if (lat) {
            const int pp = ax == 0 ? (pos >> 6) : (pos & 63);
#pragma unroll
            for (int q = 0; q < 4; ++q) { const f32x2 c = cs[pp * 32 + f0 + q]; const float a = xl[q], bq = xh[q]; xl[q] = a * c.x - bq * c.y; xh[q] = bq * c.x + a * c.y; }
        }
        if (valid) {
            if (l == 0) { u32x2 o; o.x = cvtpk(xl[0], xl[1]); o.y = cvtpk(xl[2], xl[3]); *(u32x2*)ptr = o; o.x = cvtpk(xh[0], xh[1]); o.y = cvtpk(xh[2], xh[3]); *(u32x2*)(ptr + 32) = o; }
            else { unsigned char* k8 = F.k8 + ((size_t)v * NROWS + R) * 128 + ax * 64 + (f0 >> 4) * 32 + (f0 & 15);
                *(unsigned*)k8 = pack_f8x4(xl[0], xl[1], xl[2], xl[3], 1.f); *(unsigned*)(k8 + 16) = pack_f8x4(xh[0], xh[1], xh[2], xh[3], 1.f); } }
    }
    if (l == 1) v8_tiles(F);
}

__device__ __forceinline__ void bfinal_tile(const Params& p, const Ctx& F, const int qrow0, const int h) {
    int t2 = threadIdx.x; asm volatile("" : "+v"(t2));
    const int lane = t2 & 63, wave = __builtin_amdgcn_readfirstlane(t2 >> 6);
    const float lam_init = 0.2f;
    float s1 = p.lq1[lane] * p.lk1[lane] + p.lq1[lane + 64] * p.lk1[lane + 64], s2 = p.lq2[lane] * p.lk2[lane] + p.lq2[lane + 64] * p.lk2[lane + 64];
    s1 = wave_sum(s1); s2 = wave_sum(s2);
    const float lam = expf(s1) - expf(s2) + lam_init;
    const int sub = lane >> 4, jl = lane & 15;
    f32x4 g[4];
#pragma unroll
    for (int q = 0; q < 4; ++q) g[q] = *(const f32x4*)(p.subln + jl * 4 + 64 * q) * (1.f - lam_init);
    for (int it = 0; it < 8; ++it) {
        const int R = qrow0 + wave * 32 + it * 4 + sub;
        const float* o1 = F.ob + (size_t)R * DM + h * 512 + jl * 4; const float* o2 = o1 + 256;
        f32x4 v[4]; float ss = 0.f;
#pragma unroll
        for (int q = 0; q < 4; ++q) { v[q] = *(const f32x4*)(o1 + 64 * q) - lam * *(const f32x4*)(o2 + 64 * q); ss += (v[q].x * v[q].x + v[q].y * v[q].y) + (v[q].z * v[q].z + v[q].w * v[q].w); }
        ss += __shfl_xor(ss, 1); ss += __shfl_xor(ss, 2); ss += __shfl_xor(ss, 4); ss += __shfl_xor(ss, 8);
        const float rstd = rsqrtf(ss * (1.f / 256.f) + EPS);
        bf16_t* o = F.r1 + (size_t)R * DM + 1024 + h * 256 + jl * 4;
#pragma unroll
        for (int q = 0; q < 4; ++q) { const f32x4 y = v[q] * rstd * g[q]; u32x2 w; w.x = cvtpk(y.x, y.y); w.y = cvtpk(y.z, y.w); *(u32x2*)(o + 64 * q) = w; }
    }
}

__device__ __forceinline__ void phase_attn(const Params& p, const Ctx& F, const int l) {
    LAS char* lds = (LAS char*)F.lds;
    if (l == 1) { LAS float* bt = (LAS float*)(lds + att::BIAS_OFF);
        for (int i = F.tid; i < 8 * 480; i += NTHR) { const int h = i / 480, rem = i % 480, ro = rem >> 5, cc = rem & 31; bt[i] = cc < 31 ? p.rpb[(h * 15 + ro) * 31 + cc] * 1.4426950408889634f : 0.f; }
        __syncthreads(); }
    const int vcu = (F.G % 8 == 0) ? (F.bid % 8) * (F.G / 8) + F.bid / 8 : F.bid;
    constexpr int CV_PER_UNIT = 3;
    int cv_it = CV_FIRST + F.gw, cv_slot = 0;
    unsigned* a8cnt = (unsigned*)(p.ws + WS_CTL) + 8192;
    if (l == 0) {
        v8_tiles(F);
        v8_tiles_n(F, 3584, 8, F.v8d);
        asm volatile("s_waitcnt vmcnt(0)" ::: "memory"); __syncthreads();
        if (F.tid == 0) { __builtin_amdgcn_fence(__ATOMIC_RELEASE, "agent"); __hip_atomic_fetch_add(a8cnt, 1u, __ATOMIC_RELAXED, __HIP_MEMORY_SCOPE_AGENT); }
    }
    {
    if (l == 0) {
        for (int su = vcu; su < 544; su += F.G) {
            const bool lat = su < 512; int b, h, qt;
            if (lat) { qt = su & 15; h = (su >> 4) & 3; b = su >> 6; } else { const int uu = su - 512; qt = 0; h = uu & 3; b = uu >> 2; }
            const int qrow0 = b * TPB + (lat ? CTXL + qt * 256 : 0);
            for (int sp = 0; sp < 4; ++sp) {
                att::AUnit u; u.mode = 0; u.pa = 0; u.pb = 0; u.head = 0; u.has_sink = 0; u.sink = 0.f; u.seg2row = CTXL; u.kbase = b * TPB; u.outf32 = 1;
                if (false) {
                    const int mp = 0, rh = sp & 1;
                    u.qrow0 = qrow0 + rh * 128; u.qcol = 1536 + h * 256 + mp * 128; u.kcol = 2560 + h * 256 + mp * 128; u.vcol = 3584 + h * 256; u.NT = 68; u.ocol = h * 512 + mp * 256;
                    att::attn_unit_b(u, F.r2, F.ob, lds);
                } else if (lat) {
                    const int vh = sp & 1, mp = sp >> 1;
                    if (sp == 0) { if (F.tid == 0) { unsigned spn = 0; while (__hip_atomic_load(a8cnt, __ATOMIC_RELAXED, __HIP_MEMORY_SCOPE_AGENT) < (unsigned)F.G) { __builtin_amdgcn_s_sleep(2); if (++spn > (1u << 24)) break; }
                            __builtin_amdgcn_fence(__ATOMIC_ACQUIRE, "agent"); }
                        __syncthreads(); }
                    u.qrow0 = qrow0; u.qcol = 1536 + h * 256 + mp * 128; u.NT = 68; u.ocol = h * 512 + mp * 256 + vh * 128;
                    att::attn_unit_c8<3>(u, F.r2, F.k8d + ((size_t)(h * 2 + mp) * NROWS + u.kbase) * 128, F.v8d + (size_t)(b * 8 + h * 2 + vh) * (68 * 8192), nullptr, (bf16_t*)F.ob, lds);
                } else {
                    const int mp = sp >> 1, vh = sp & 1;
                    u.qrow0 = qrow0; u.qcol = 1536 + h * 256 + mp * 128; u.NT = 4; u.ocol = h * 512 + mp * 256 + vh * 128;
                    att::attn_unit_c8<3>(u, F.r2, F.k8d + ((size_t)(h * 2 + mp) * NROWS + u.kbase) * 128, F.v8d + (size_t)(b * 8 + h * 2 + vh) * (68 * 8192), nullptr, (bf16_t*)F.ob, lds);
                }
                if (((cv_slot++ ^ vcu) & 1) == 0) { conv_some(p, F, cv_it, 2 * CV_PER_UNIT); __syncthreads(); }
            }
            VM_WAIT(); __syncthreads();
            bfinal_tile(p, F, qrow0, h);
        }
        for (int ui = vcu; ui < 64; ui += F.G) {
            att::AUnit u; u.mode = 0; u.pa = 0; u.pb = 0; u.head = 0; u.outf32 = 0; u.seg2row = CTXL;
            const int h = ui & 7, b = ui >> 3;
            u.qrow0 = b * TPB; u.kbase = b * TPB;
            u.qcol = h * 128; u.kcol = 1024 + (h >> 2) * 128; u.vcol = 1280 + (h >> 2) * 128; u.ocol = h * 128;
            u.has_sink = 1; u.sink = p.a_sink[h]; u.NT = 4;
            att::attn_unit<0, 1>(u, F.r2, F.r1, F.ob, lds);
        }
    } else {
        for (int ui = vcu; ui < 1024; ui += F.G) {
            att::AUnit u; u.mode = 0; u.pa = 0; u.pb = 0; u.head = 0; u.has_sink = 0; u.sink = 0.f; u.outf32 = 0; u.seg2row = CTXL; u.NT = 68;
            const int qt = ui & 15, h = (ui >> 4) & 7, b = ui >> 7;
            u.qrow0 = b * TPB + CTXL + qt * 256; u.kbase = b * TPB;
            u.qcol = h * 128; u.kcol = 1024 + (h >> 2) * 128; u.vcol = 1280 + (h >> 2) * 128; u.ocol = h * 128;
            u.pa = qt * 256;
            att::attn_unit_c8<0>(u, F.r2, F.k8 + ((size_t)(h >> 2) * NROWS + u.kbase) * 128, F.v8 + (size_t)(b * 2 + (h >> 2)) * (68 * 8192), p.qn, (bf16_t*)F.o8, lds);
        }
    } }
    if (l == 0) {
    if (F.tid == 0) { unsigned sp = 0; while (__hip_atomic_load(a8cnt, __ATOMIC_RELAXED, __HIP_MEMORY_SCOPE_AGENT) < (unsigned)F.G) { __builtin_amdgcn_s_sleep(2); if (++sp > (1u << 24)) break; }
        __builtin_amdgcn_fence(__ATOMIC_ACQUIRE, "agent"); }
    __syncthreads();
    for (int ui = vcu; ui < 1024; ui += F.G) {
        att::AUnit u; u.mode = 1; u.head = 0; u.outf32 = 0;
        const int qt = ui & 15, h = (ui >> 4) & 7, b = ui >> 7;
        u.qrow0 = b * TPB + CTXL + qt * 256; u.kbase = b * TPB;
        u.qcol = h * 128; u.kcol = 1024 + (h >> 2) * 128; u.vcol = 1280 + (h >> 2) * 128; u.ocol = h * 128;
        u.has_sink = 1; u.sink = p.a_sink[h];
        const int s0 = qt * 256, lo = max(0, s0 - 128), hi2 = min(SEQ, s0 + 384); u.NT = 4 + (hi2 - lo) / 64; u.seg2row = CTXL + lo; u.pa = s0; u.pb = lo;
        att::attn_unit_c8<1>(u, F.r2, F.k8 + ((size_t)(h >> 2) * NROWS + u.kbase) * 128, F.v8 + (size_t)(b * 2 + (h >> 2)) * (68 * 8192), nullptr, F.r1, lds);
        if (((cv_slot++ ^ vcu) & 1) == 0) { conv_some(p, F, cv_it, 2 * CV_PER_UNIT); __syncthreads(); }
    }
    conv_some(p, F, cv_it, 1 << 20);
    __syncthreads(); }
    else {
    for (int ui = vcu; ui < 1024; ui += F.G) {
        att::AUnit u; u.mode = 2; u.has_sink = 0; u.sink = 0.f; u.outf32 = 0;
        const int qt = ui & 15, h = (ui >> 4) & 7, b = ui >> 7;
        u.qrow0 = b * TPB + CTXL + qt * 256; u.kbase = b * TPB;
        u.qcol = 1536 + h * 128; u.kcol = 2560 + h * 128; u.vcol = 3584 + h * 128; u.ocol = 1024 + h * 128; u.head = h;
        const int r0 = qt * 4; int lo = min(max(r0 - 4, 0), 56), hi2 = min(max(r0 - 1, 0), 56) + 7; if (((hi2 - lo + 1) & 1) != 0) { if (hi2 < 63) ++hi2; else --lo; }
        u.NT = 4 + (hi2 - lo + 1); u.seg2row = CTXL + lo * 64; u.pa = r0; u.pb = lo;
        att::attn_unit<2, 1>(u, F.r2, (bf16_t*)F.o8, F.ob, lds);
    } }
}

__device__ __forceinline__ void router_tail(const Ctx& F, const float (&lg)[16], const int b, const int t, const bool valid) {
    const bool b5 = (F.lane & 32) != 0, b4 = (F.lane & 16) != 0, b3 = (F.lane & 8) != 0, b2 = (F.lane & 4) != 0;
    float r8[8], r4[4], r2[2];
#pragma unroll
    for (int e = 0; e < 8; ++e) { const float keep = b5 ? lg[e + 8] : lg[e], send = b5 ? lg[e] : lg[e + 8]; r8[e] = keep + __shfl_xor(send, 32); }
#pragma unroll
    for (int e = 0; e < 4; ++e) { const float keep = b4 ? r8[e + 4] : r8[e], send = b4 ? r8[e] : r8[e + 4]; r4[e] = keep + __shfl_xor(send, 16); }
#pragma unroll
    for (int e = 0; e < 2; ++e) { const float keep = b3 ? r4[e + 2] : r4[e], send = b3 ? r4[e] : r4[e + 2]; r2[e] = keep + __shfl_xor(send, 8); }
    float lgt; { const float keep = b2 ? r2[1] : r2[0], send = b2 ? r2[0] : r2[1]; lgt = keep + __shfl_xor(send, 4); }
    lgt += __shfl_xor(lgt, 2); lgt += __shfl_xor(lgt, 1);
    float mx = lgt;
    mx = fmaxf(mx, __shfl_xor(mx, 4)); mx = fmaxf(mx, __shfl_xor(mx, 8)); mx = fmaxf(mx, __shfl_xor(mx, 16)); mx = fmaxf(mx, __shfl_xor(mx, 32));
    const float ex = expf(lgt - mx); float sum = ex;
    sum += __shfl_xor(sum, 4); sum += __shfl_xor(sum, 8); sum += __shfl_xor(sum, 16); sum += __shfl_xor(sum, 32);
    if (valid && (F.lane & 3) == 0) { const float af = ex / sum; const int e = F.lane >> 2;
        if (t < CTXL) F.affc[((size_t)(b * 16 + e)) * CTXL + t] = af; else F.affl[((size_t)(b * 16 + e)) * SEQ + (t - CTXL)] = af; }
}
__device__ __forceinline__ void phase_norm2(const Params& p, const Ctx& F, const int l) {
    LAS float* wr = (LAS float*)F.lds;
    for (int i = F.tid; i < DM * NEXP; i += NTHR) { const int d = i >> 4, e = i & 15; wr[e * DM + d] = p.w_router[(size_t)l * DM * NEXP + i]; }
    __syncthreads();
    const int b = F.gw & 7, tstride = F.NGW >> 3;
    int cur_m = -1; f32x4 A[8], Bv[8];
    int t = F.gw >> 3; if (l == 1) { while (t < CTXL) t += tstride; }
    while (t < TPB) {
        const bool isctx = t < CTXL;
        const int mrow = isctx ? 8 : b;
        const int tB = t + tstride;
        const bool two = !isctx && tB < TPB;
        f32x2 vv[8][4];
        { const float* xlat = l == 0 ? p.x : p.out; const float* xctx = l == 0 ? p.ctx : F.xc;
          const float* xs0 = isctx ? xctx + ((size_t)b * CTXL + t) * DM : xlat + ((size_t)b * SEQ + (t - CTXL)) * DM;
          const float* xs1 = two ? xlat + ((size_t)b * SEQ + (tB - CTXL)) * DM : xs0;
          const bf16_t* d0p = F.dlt + ((size_t)b * TPB + t) * DM + 4 * F.lane; const bf16_t* d1p = F.dlt + ((size_t)b * TPB + (two ? tB : t)) * DM + 4 * F.lane;
#pragma unroll
          for (int j = 0; j < 8; ++j) { f32x4 x0 = __builtin_nontemporal_load((const f32x4*)xs0 + F.lane + 64 * j), x1 = __builtin_nontemporal_load((const f32x4*)xs1 + F.lane + 64 * j);
              const u32x2 e0 = __builtin_nontemporal_load((const u32x2*)(d0p + 256 * j)), e1 = __builtin_nontemporal_load((const u32x2*)(d1p + 256 * j));
              x0 += (f32x4){bflo(e0.x), bfhi(e0.x), bflo(e0.y), bfhi(e0.y)}; x1 += (f32x4){bflo(e1.x), bfhi(e1.x), bflo(e1.y), bfhi(e1.y)};
#pragma unroll
              for (int c = 0; c < 4; ++c) vv[j][c] = (f32x2){x0[c], x1[c]}; } }
        if (mrow != cur_m) { cur_m = mrow; const float* mr = F.mod + (size_t)(l * 9 + mrow) * MODW;
#pragma unroll
            for (int j = 0; j < 8; ++j) { const f32x4 g = *((const f32x4*)(p.g_ffn + l * DM) + F.lane + 64 * j), sc = *((const f32x4*)(mr + 4 * DM) + F.lane + 64 * j);
                A[j] = g * (sc + 1.f); Bv[j] = *((const f32x4*)(mr + 3 * DM) + F.lane + 64 * j); } }
        f32x2 ss = {0.f, 0.f};
#pragma unroll
        for (int j = 0; j < 8; ++j)
#pragma unroll
            for (int c = 0; c < 4; ++c) ss += vv[j][c] * vv[j][c];
        const f32x2 rstd = {rsqrtf(wave_sum(ss.x) * (1.f / DM) + EPS), rsqrtf(wave_sum(ss.y) * (1.f / DM) + EPS)};
        f32x2 am = {0.f, 0.f};
#pragma unroll
        for (int j = 0; j < 8; ++j)
#pragma unroll
            for (int c = 0; c < 4; ++c) { vv[j][c] = vv[j][c] * rstd * A[j][c] + Bv[j][c]; am = __builtin_elementwise_max(am, __builtin_elementwise_abs(vv[j][c])); }
        const float am0 = fmaxf(wave_max(am.x), 1e-20f), am1 = fmaxf(wave_max(am.y), 1e-20f), inv0 = 127.f / am0, inv1 = 127.f / am1;
        unsigned* hn0 = (unsigned*)((signed char*)F.r1 + ((size_t)b * TPB + t) * DM) + F.lane;
        unsigned* hn1 = (unsigned*)((signed char*)F.r1 + ((size_t)b * TPB + (two ? tB : t)) * DM) + F.lane;
#pragma unroll
        for (int j = 0; j < 8; ++j) { __builtin_nontemporal_store(pack_i8x4(vv[j][0].x, vv[j][1].x, vv[j][2].x, vv[j][3].x, inv0), hn0 + 64 * j);
            if (two) __builtin_nontemporal_store(pack_i8x4(vv[j][0].y, vv[j][1].y, vv[j][2].y, vv[j][3].y, inv1), hn1 + 64 * j); }
        if (F.lane == 0) { F.sah[b * TPB + t] = am0 * (1.f / 127.f); if (two) F.sah[b * TPB + tB] = am1 * (1.f / 127.f); }
        f32x2 lg[16];
        unsigned wro = (unsigned)(uintptr_t)wr; asm volatile("" : "+v"(wro));
        const LAS float* wr2 = (const LAS float*)(uintptr_t)wro;
#pragma unroll
        for (int e = 0; e < 16; ++e) { f32x2 a = {0.f, 0.f};
#pragma unroll
            for (int j = 0; j < 8; ++j) { const f32x4 w = *((const LAS f32x4*)(wr2 + e * DM) + F.lane + 64 * j);
#pragma unroll
                for (int c = 0; c < 4; ++c) a += vv[j][c] * w[c]; }
            lg[e] = a; }
        float lg0[16], lg1[16];
#pragma unroll
        for (int e = 0; e < 16; ++e) { lg0[e] = lg[e].x; lg1[e] = lg[e].y; }
        router_tail(F, lg0, b, t, true);
        router_tail(F, lg1, b, tB, two);
        t += two ? 2 * tstride : tstride;
    }
}

__device__ __forceinline__ void phase_oq(const Params& p, const Ctx& F, const int l) {
    for (int R = F.gw; R < NROWS; R += F.NGW) {
        if (l == 1 && (R % TPB) < CTXL) continue;
        const bf16_t* src = F.r1 + (size_t)R * DM + 8 * F.lane;
        u32x4 w[4];
#pragma unroll
        for (int j = 0; j < 4; ++j) w[j] = __builtin_nontemporal_load((const u32x4*)(src + 512 * j));
        float v[4][8], am = 0.f;
#pragma unroll
        for (int j = 0; j < 4; ++j) { v[j][0] = bflo(w[j].x); v[j][1] = bfhi(w[j].x); v[j][2] = bflo(w[j].y); v[j][3] = bfhi(w[j].y); v[j][4] = bflo(w[j].z); v[j][5] = bfhi(w[j].z); v[j][6] = bflo(w[j].w); v[j][7] = bfhi(w[j].w);
#pragma unroll
            for (int q = 0; q < 8; ++q) am = fmaxf(am, fabsf(v[j][q])); }
        am = fmaxf(wave_max(am), 1e-20f); const float inv = 127.f / am;
        signed char* dst = F.o8 + (size_t)R * DM + 8 * F.lane;
#pragma unroll
        for (int j = 0; j < 4; ++j) { u32x2 o; o.x = pack_i8x4(v[j][0], v[j][1], v[j][2], v[j][3], inv); o.y = pack_i8x4(v[j][4], v[j][5], v[j][6], v[j][7], inv); *(u32x2*)(dst + 512 * j) = o; }
        if (F.lane == 0) F.so[R] = am * (1.f / 127.f);
    }
}

__device__ __forceinline__ void phase_hidq(const Params& p, const Ctx& F, const int l) {
    const int nrows = 16 * (l == 0 ? 4352 : 4096);
    for (int R = F.gw; R < nrows; R += F.NGW) {
        const bf16_t* src = F.hid + (size_t)R * DEXP + 8 * F.lane;
        u32x4 w[3]; float v[3][8]; float am = 0.f;
#pragma unroll
        for (int j = 0; j < 3; ++j) w[j] = __builtin_nontemporal_load((const u32x4*)(src + 512 * j));
#pragma unroll
        for (int j = 0; j < 3; ++j) { v[j][0] = bflo(w[j].x); v[j][1] = bfhi(w[j].x); v[j][2] = bflo(w[j].y); v[j][3] = bfhi(w[j].y); v[j][4] = bflo(w[j].z); v[j][5] = bfhi(w[j].z); v[j][6] = bflo(w[j].w); v[j][7] = bfhi(w[j].w);
#pragma unroll
            for (int q = 0; q < 8; ++q) am = fmaxf(am, fabsf(v[j][q])); }
        am = fmaxf(wave_max(am), 1e-20f); const float inv = 127.f / am;
        signed char* dst = F.hid8 + (size_t)R * DEXP + 8 * F.lane;
#pragma unroll
        for (int j = 0; j < 3; ++j) { u32x2 o; o.x = pack_i8x4(v[j][0], v[j][1], v[j][2], v[j][3], inv); o.y = pack_i8x4(v[j][4], v[j][5], v[j][6], v[j][7], inv); *(u32x2*)(dst + 512 * j) = o; }
        if (F.lane == 0) F.shd[R] = am * (1.f / 127.f);
    }
}

__device__ __forceinline__ void phase_topk(const Params& p, const Ctx& F, const int l) {
    LAS unsigned* cnt = (LAS unsigned*)F.lds;
    const int nunits = l == 0 ? 256 : 128, mexp = l == 0 ? 4352 : 4096;
    for (int ui = F.bid; ui < nunits; ui += F.G) {
        const bool lat = ui < 128; const int uu = ui & 127, b = uu >> 4, e = uu & 15;
        const int ntok = lat ? SEQ : CTXL, cap = lat ? 512 : 32;
        const float* aff = lat ? F.affl + (size_t)(b * 16 + e) * SEQ : F.affc + (size_t)(b * 16 + e) * CTXL;
        const int rowbase = l == 0 ? (lat ? 256 + b * 512 : b * 32) : b * 512;
        if (F.tid < 64) cnt[F.tid] = 0u;
        unsigned key[8];
#pragma unroll
        for (int i = 0; i < 8; ++i) { const int n = i * NTHR + F.tid; key[i] = n < ntok ? __float_as_uint(aff[n]) : 0u; }
        __syncthreads();
        unsigned prefix = 0u;
        for (int bit = 30; bit >= 0; --bit) {
            const unsigned cand = prefix | (1u << bit); unsigned c = 0u;
#pragma unroll
            for (int i = 0; i < 8; ++i) c += (unsigned)__popcll(__ballot(key[i] >= cand));
            if (F.lane == 0) __hip_atomic_fetch_add(&cnt[bit], c, __ATOMIC_RELAXED, __HIP_MEMORY_SCOPE_WORKGROUP);
            __syncthreads();
            if (cnt[bit] >= (unsigned)cap) prefix = cand;
        }
#pragma unroll
        for (int i = 0; i < 8; ++i) { const int n = i * NTHR + F.tid;
            if (n < ntok) { int slot = -1;
                if (key[i] > prefix) slot = (int)__hip_atomic_fetch_add(&cnt[32], 1u, __ATOMIC_RELAXED, __HIP_MEMORY_SCOPE_WORKGROUP);
                key[i] = (key[i] > prefix) ? (0x80000000u | (unsigned)slot) : (key[i] == prefix ? 0x40000000u : 0u); } else key[i] = 0u; }
        __syncthreads();
        const unsigned cgt = cnt[32];
#pragma unroll
        for (int i = 0; i < 8; ++i) { const int n = i * NTHR + F.tid;
            if (n < ntok) { int slot = -1;
                if (key[i] & 0x80000000u) slot = (int)(key[i] & 0xffffu);
                else if (key[i] & 0x40000000u) { const unsigned s2 = cgt + __hip_atomic_fetch_add(&cnt[33], 1u, __ATOMIC_RELAXED, __HIP_MEMORY_SCOPE_WORKGROUP); if (s2 < (unsigned)cap) slot = (int)s2; }
                const int t = lat ? CTXL + n : n;
                int yrow = -1;
                if (slot >= 0) { const int rr = rowbase + slot; yrow = e * mexp + rr; F.rows[e * MEXP_MAX + rr] = b * TPB + t; F.gate[e * mexp + rr] = aff[n]; F.sas[e * mexp + rr] = F.sah[b * TPB + t]; }
                F.slot[((size_t)(b * 16 + e)) * TPB + t] = yrow; } }
        __syncthreads();
    }
}

__global__ void __launch_bounds__(NTHR, 2) fwd_kernel(Params p) {
    extern __shared__ __attribute__((aligned(16))) unsigned char lds_raw[];
    unsigned char* ws = p.ws;
    LAS unsigned char* const lds0 = (LAS unsigned char*)lds_raw;
    volatile LAS unsigned* lctl = (volatile LAS unsigned*)(lds0 + LCTL_OFF);
    if (threadIdx.x < 128) lctl[threadIdx.x] = 0u;
    __syncthreads();
#if MK_MULTI
#define GRID_BAR() do { } while (0)
#else
    XcdBarrier bar = xcd_barrier_post((unsigned*)(ws + WS_CTL) + 4096, lctl + 8);
#define GRID_BAR() xcd_barrier(bar)
#endif
    const int lo = p.ph_lo, hi = p.ph_hi;
#define IN(k) (lo <= (k) && (k) < hi)
#define SEAM(k) do { if (IN((k) + 1)) GRID_BAR(); } while (0)
#ifndef PHMASK
#define PHMASK 0xfff
#endif
#define EN(s) (((PHMASK) >> (s)) & 1)
#ifndef REP_PRO
#define REP_PRO 1
#endif
#ifndef REP_HEAVY
#define REP_HEAVY 1
#endif
#ifndef REP_THIN
#define REP_THIN 1
#endif
#ifndef REP_ATT
#define REP_ATT 1
#endif

    if (EN(0) && IN(0)) { for (int rep = 0; rep < REP_PRO; ++rep) { const Ctx F = make_ctx(p, lds0); phase_prologue(p, F); __syncthreads(); } SEAM(0); }

    for (int l = 0; l < 2; ++l) {
        const int pb = 1 + l * 11;
        const int mexp = l == 0 ? 4352 : 4096;
        if (EN(1) && IN(pb + 0)) { for (int rep = 0; rep < (l == 0 ? REP_THIN : 1); ++rep) { const Ctx F = make_ctx(p, lds0); phase_norm1(p, F, l); } SEAM(pb + 0); }
        if (EN(2) && IN(pb + 1)) {
            const Ctx F = make_ctx(p, lds0);
            pg8::DenseOrder S{NROWS / 256, INW / 256, F.G, F.bid, 0, (const char*)F.r1, (const char*)F.win + (size_t)l * INW * DM, (size_t)256 * DM};
            pg8::EpiP E{F.r2, l == 0 ? 1 : 0, F.sax, F.wsc[l], F.k8, F.k8d};
            for (int rep = 0; rep < REP_HEAVY; ++rep) pg8::gemm_phase<pg8::EpiP, pg8::DenseOrder, false, true>(F.tid, F.lds, nullptr, DM, S, E);
            SEAM(pb + 1);
        }
        if (EN(3) && IN(pb + 2) && l == 1) { const Ctx F = make_ctx(p, lds0); phase_qkfix(p, F, l); SEAM(pb + 2); }
        if (EN(4) && IN(pb + 3)) { for (int rep = 0; rep < REP_ATT; ++rep) { const Ctx F = make_ctx(p, lds0); phase_attn(p, F, l); } SEAM(pb + 3); }
        if (EN(6) && IN(pb + 4) && l == 0) { const Ctx F = make_ctx(p, lds0); phase_oq(p, F, l); SEAM(pb + 4); }
        if (EN(6) && IN(pb + 5)) {
            const Ctx F = make_ctx(p, lds0);
            pg8::DenseOrder S{l == 0 ? NROWS / 256 : NB * 16, DM / 256, F.G, F.bid, l, (const char*)F.o8, (const char*)F.wout + (size_t)l * DM * DM, (size_t)256 * DM};
            if (l == 0) { pg8::EpiDelta E{F.dlt, F.mod + (size_t)l * 9 * MODW, F.so, F.wsc[98 + l]};
                pg8::gemm_phase<pg8::EpiDelta, pg8::DenseOrder, false, true>(F.tid, F.lds, nullptr, DM, S, E); }
            else { pg8::EpiDelta E{F.dlt, F.mod + (size_t)l * 9 * MODW, nullptr, F.wsc[98 + l] * (1.f / O8_SCALE)};
                pg8::gemm_phase<pg8::EpiDelta, pg8::DenseOrder, false, true, true>(F.tid, F.lds, nullptr, DM, S, E); }
            SEAM(pb + 5);
        }
        if (EN(7) && IN(pb + 6)) { for (int rep = 0; rep < REP_THIN; ++rep) { const Ctx F = make_ctx(p, lds0); phase_norm2(p, F, l); __syncthreads(); } SEAM(pb + 6); }
        if (EN(8) && IN(pb + 7)) { for (int rep = 0; rep < REP_THIN; ++rep) { const Ctx F = make_ctx(p, lds0); phase_topk(p, F, l); } SEAM(pb + 7); }
        if (EN(9) && IN(pb + 8)) {
            const Ctx F = make_ctx(p, lds0);
            pg8::MoeOrder S{mexp / 256, 3072 / 256, F.G, F.bid, (const char*)F.r1, 0, (const char*)F.wgu + (size_t)l * NEXP * 3072 * DM, (size_t)3072 * DM, (size_t)256 * DM};
            LAS unsigned* tab = (LAS unsigned*)(F.lds + TAB_OFF);
            { unsigned rv[14];
#pragma unroll
              for (int i = 0; i < 14; ++i) { pg8::Unit u; rv[i] = 0u; if (S.next(i, u) && F.tid < 256) rv[i] = (unsigned)F.rows[u.e * MEXP_MAX + u.pm * 256 + F.tid]; }
#pragma unroll
              for (int i = 0; i < 14; ++i) if (F.tid < 256) tab[i * 256 + F.tid] = rv[i] * (unsigned)DM; }
            __syncthreads();
            pg8::EpiSwiglu E{(unsigned char*)F.hid8, mexp, F.sas, F.wsc + 2 + 32 * l};
            for (int rep = 0; rep < REP_HEAVY; ++rep) pg8::gemm_phase<pg8::EpiSwiglu, pg8::MoeOrder, true, true>(F.tid, F.lds, tab, DM, S, E);
            SEAM(pb + 8);
        }
        if (EN(10) && IN(pb + 10)) {
            const Ctx F = make_ctx(p, lds0);
            pg8::MoeOrder S{mexp / 256, DM / 256, F.G, F.bid, (const char*)F.hid8, (size_t)mexp * DEXP, (const char*)F.wdn + (size_t)l * NEXP * DM * DEXP, (size_t)DM * DEXP, (size_t)256 * DEXP};
            pg8::EpiDown E{F.y8, F.gate, mexp, F.wsc + 66 + 16 * l};
            pg8::gemm_phase<pg8::EpiDown, pg8::MoeOrder, false, true, true>(F.tid, F.lds, nullptr, DEXP, S, E);
            SEAM(pb + 10);
        }
    }
    if (EN(11) && IN(23)) { const Ctx F = make_ctx(p, lds0); phase_norm1(p, F, 2); }
#undef IN
#undef SEAM
}

extern "C" void kernel_launch(void* const* d_in, const int* in_sizes, int n_in, void* d_out, int out_size, void* d_ws, size_t ws_size, hipStream_t stream) {
    static int grid = 0;
    if (grid == 0) {
        if (n_in != 24 || out_size != NB * SEQ * DM || ws_size < WS_END) { fprintf(stderr, "kernel_launch: unexpected shapes: n_in %d out %d ws %zu (need %zu)\n", n_in, out_size, ws_size, (size_t)WS_END); grid = -1; return; }
        int dev = 0, cus = 0, per_cu = 0;
        if (hipGetDevice(&dev) != hipSuccess || hipDeviceGetAttribute(&cus, hipDeviceAttributeMultiprocessorCount, dev) != hipSuccess) { fprintf(stderr, "kernel_launch: device query failed\n"); grid = -1; return; }
        if (hipFuncSetAttribute((const void*)fwd_kernel, hipFuncAttributeMaxDynamicSharedMemorySize, LDS_BYTES) != hipSuccess) { fprintf(stderr, "kernel_launch: hipFuncSetAttribute failed\n"); grid = -1; return; }
        if (hipOccupancyMaxActiveBlocksPerMultiprocessor(&per_cu, (const void*)fwd_kernel, NTHR, LDS_BYTES) != hipSuccess || per_cu < 1) fprintf(stderr, "kernel_launch: note: occupancy query reports %d\n", per_cu);
        (void)hipGetLastError();
        grid = cus;
    }
    if (grid < 0) return;
    if (hipMemsetAsync((char*)d_ws + WS_CTL, 0, CTL_ZERO_BYTES, stream) != hipSuccess) { fprintf(stderr, "kernel_launch: memset failed\n"); return; }
    Params p{};
    const float** pp = (const float**)&p;
    for (int i = 0; i < 24; ++i) pp[i] = (const float*)d_in[i];
    p.out = (float*)d_out; p.ws = (unsigned char*)d_ws;
#if MK_MULTI
    for (int ph = 0; ph < 24; ++ph) { p.ph_lo = ph; p.ph_hi = ph + 1;
        hipLaunchKernelGGL(fwd_kernel, dim3(grid), dim3(NTHR), LDS_BYTES, stream, p); }
#elif defined(PROBE_K)
    p.ph_lo = 0; p.ph_hi = PROBE_K + 1;
    hipLaunchKernelGGL(fwd_kernel, dim3(grid), dim3(NTHR), LDS_BYTES, stream, p);
    (void)hipMemsetAsync((char*)d_ws + WS_CTL, 0, CTL_ZERO_BYTES, stream);
    p.ph_lo = PROBE_K2; p.ph_hi = 24;
    hipLaunchKernelGGL(fwd_kernel, dim3(grid), dim3(NTHR), LDS_BYTES, stream, p);
#else
    p.ph_lo = 0; p.ph_hi = 24;
    hipLaunchKernelGGL(fwd_kernel, dim3(grid), dim3(NTHR), LDS_BYTES, stream, p);
#endif
    const hipError_t le = hipPeekAtLastError();
    if (le != hipSuccess) fprintf(stderr, "kernel_launch: launch failed: %s\n", hipGetErrorName(le));
}
```

```cpp
#include <hip/hip_runtime.h>
#include <cstdio>
#include <cstdint>
#include <type_traits>

#ifndef MK_MULTI
#define MK_MULTI 0
#endif

#define LAS __attribute__((address_space(3)))
typedef unsigned short bf16_t;
typedef short bf16x8 __attribute__((ext_vector_type(8)));
typedef short s16x4 __attribute__((ext_vector_type(4)));
typedef float f32x4 __attribute__((ext_vector_type(4)));
typedef float f32x2 __attribute__((ext_vector_type(2)));
typedef float f32x16 __attribute__((ext_vector_type(16)));
typedef unsigned u32x4 __attribute__((ext_vector_type(4)));
typedef unsigned u32x2 __attribute__((ext_vector_type(2)));
typedef int i32x4 __attribute__((ext_vector_type(4)));
typedef int i32x8 __attribute__((ext_vector_type(8)));

constexpr int DM = 2048, NB = 8, SEQ = 4096, CTXL = 256, TPB = SEQ + CTXL, NROWS = NB * TPB;
constexpr int INW = 4608, NEXP = 16, DEXP = 1536, MODW = 6 * DM;
constexpr int MEXP_MAX = 4352;
constexpr float EPS = 1e-6f;
constexpr int NWAVES = 8, NTHR = 512;

constexpr size_t MiB = 1u << 20;
constexpr size_t WS_CTL = 0, CTL_ZERO_BYTES = 1 * MiB;
constexpr size_t WS_MOD = 1 * MiB;
constexpr size_t WS_AFFL = 2 * MiB;
constexpr size_t WS_AFFC = 4 * MiB;
constexpr size_t WS_SHD = 4 * MiB + 256 * 1024;
constexpr size_t WS_SO = 4 * MiB + 640 * 1024;
constexpr size_t WS_ROWS = 5 * MiB;
constexpr size_t WS_GATE = 5 * MiB + 512 * 1024;
constexpr size_t WS_SLOT = 6 * MiB;
constexpr size_t WS_SAX = 9 * MiB;
constexpr size_t WS_SAH = 9 * MiB + 256 * 1024;
constexpr size_t WS_SAS = 9 * MiB + 512 * 1024;
constexpr size_t WS_WSC = 9 * MiB + 896 * 1024;
constexpr size_t WS_XC = 10 * MiB;
constexpr size_t WS_WIN = 26 * MiB;
constexpr size_t WS_WOUT = 62 * MiB;
constexpr size_t WS_WGU = 78 * MiB;
constexpr size_t WS_K8 = 272 * MiB;
constexpr size_t WS_V8 = 288 * MiB;
constexpr size_t WS_K8D = 306 * MiB;
constexpr size_t WS_V8D = 342 * MiB;
constexpr size_t WS_WDN = 462 * MiB;
constexpr size_t WS_R1 = 654 * MiB;
constexpr size_t WS_R2 = 790 * MiB;
constexpr size_t WS_R3 = 1096 * MiB;
constexpr size_t WS_DLT = 1368 * MiB;
constexpr size_t WS_END = 1504 * MiB;

constexpr int RING_BYTES = 131072;
constexpr int TAB_OFF = 131072;
constexpr int LCTL_OFF = 146944;
constexpr int LDS_BYTES = 147456;

__device__ __forceinline__ unsigned cvtpk(float lo, float hi) { unsigned r; asm volatile("v_cvt_pk_bf16_f32 %0, %1, %2" : "=v"(r) : "v"(lo), "v"(hi)); return r; }
__device__ __forceinline__ float bflo(unsigned w) { return __uint_as_float(w << 16); }
__device__ __forceinline__ float bfhi(unsigned w) { return __uint_as_float(w & 0xffff0000u); }
__device__ __forceinline__ float wave_sum(float v) {
#pragma unroll
    for (int o = 1; o < 64; o <<= 1) v += __shfl_xor(v, o);
    return v;
}
__device__ __forceinline__ float wave_max(float v) {
#pragma unroll
    for (int o = 1; o < 64; o <<= 1) v = fmaxf(v, __shfl_xor(v, o));
    return v;
}
__device__ __forceinline__ f32x4 tof(const f32x4& a) { return a; }
__device__ __forceinline__ f32x4 tof(const i32x4& a) { return (f32x4){(float)a.x, (float)a.y, (float)a.z, (float)a.w}; }
__device__ __forceinline__ unsigned q8u(float x, float inv) { int q = __float2int_rn(x * inv); q = min(max(q, -127), 127); return (unsigned)q & 0xffu; }
__device__ __forceinline__ unsigned pack_i8x4(float a, float b, float c, float d, float inv) { return q8u(a, inv) | (q8u(b, inv) << 8) | (q8u(c, inv) << 16) | (q8u(d, inv) << 24); }
__device__ __forceinline__ float clamp_f8(float x) { return __builtin_amdgcn_fmed3f(x, -448.f, 448.f); }
__device__ __forceinline__ unsigned pack_f8x4(float a, float b, float c, float d, float inv) {
    int w = 0; w = __builtin_amdgcn_cvt_pk_fp8_f32(clamp_f8(a * inv), clamp_f8(b * inv), w, false); w = __builtin_amdgcn_cvt_pk_fp8_f32(clamp_f8(c * inv), clamp_f8(d * inv), w, true); return (unsigned)w; }
__device__ __forceinline__ unsigned pack_q4(float a, float b, float c, float d, float inv, bool f8) { const unsigned i = pack_i8x4(a, b, c, d, inv), f = pack_f8x4(a, b, c, d, inv); return f8 ? f : i; }
constexpr float HID_SCALE = 8.f;
constexpr float O8_SCALE = 64.f;
constexpr float Y_SCALE = 32.f;
__device__ __forceinline__ f32x4 unpack_f8x4(unsigned w) { const auto lo = __builtin_amdgcn_cvt_pk_f32_fp8((int)w, false), hi = __builtin_amdgcn_cvt_pk_f32_fp8((int)w, true); return (f32x4){lo[0], lo[1], hi[0], hi[1]}; }
__device__ __forceinline__ float amax4(const f32x4& v) { return fmaxf(fmaxf(fabsf(v.x), fabsf(v.y)), fmaxf(fabsf(v.z), fabsf(v.w))); }
__device__ __forceinline__ float silu_f(float x) { return x / (1.f + __expf(-x)); }
#define LDS_WAIT() asm volatile("s_waitcnt lgkmcnt(0)" ::: "memory")
#define VM_WAIT() asm volatile("s_waitcnt vmcnt(0)" ::: "memory")

struct Params {
    const float *x, *c, *ctx, *c_ctx, *w_ada, *b_ada, *g_mix, *g_ffn, *w_in, *w_out, *a_sink, *lq1, *lk1, *lq2, *lk2, *subln, *qn, *kn, *rpb, *w_router, *w_gate, *w_up, *w_down, *g_final;
    float* out; unsigned char* ws; int ph_lo, ph_hi;
};

#define XB_TMO      128
#define XB_XCNT(j)  (256  + 64 * (j))
#define XB_XSUB(j)  (1280 + 64 * (j))
#define XB_XGEN(j)  (2304 + 64 * (j))
#define XB_TOP      3328
#define XB_TOPGEN   3392
#define XCD_BAR_WORDS 3456
#define XB_SPIN_CAP (1u << 18)

__device__ __forceinline__ unsigned xb_ld(unsigned* p)              { return __hip_atomic_load(p, __ATOMIC_RELAXED, __HIP_MEMORY_SCOPE_AGENT); }
__device__ __forceinline__ unsigned xb_add(unsigned* p, unsigned v) { return __hip_atomic_fetch_add(p, v, __ATOMIC_RELAXED, __HIP_MEMORY_SCOPE_AGENT); }
__device__ __forceinline__ unsigned xb_xcc_id() { return (unsigned)__builtin_amdgcn_s_getreg((3 << 11) | 20) & 0xFu; }
#define XB_SPIN(cond, bar) do { unsigned _sp = 0; while (cond) { __builtin_amdgcn_s_sleep(1); \
    if ((++_sp & 255u) == 0u) { if (xb_ld(&(bar)[XB_TMO])) break; if (_sp > XB_SPIN_CAP) { atomicAdd(&(bar)[XB_TMO], 1u); break; } } } } while (0)

struct XcdBarrier { unsigned* bar; unsigned x; volatile LAS unsigned* st; };

__device__ __forceinline__ XcdBarrier xcd_barrier_post(unsigned* bar, volatile LAS unsigned* st) {
    XcdBarrier b; b.bar = bar; b.x = xb_xcc_id(); b.st = st;
    if (threadIdx.x == 0) (void)xb_add(&bar[XB_XCNT(b.x)], 1u);
    return b;
}
__device__ __forceinline__ void xcd_barrier_complete(unsigned* bar, unsigned x, unsigned& nloc, unsigned& nx) {
    const unsigned G = gridDim.x * gridDim.y * gridDim.z;
    unsigned sum, cnt, mine, sp = 0u;
    for (;;) {
        sum = 0u; cnt = 0u; mine = 0u;
#pragma unroll
        for (unsigned j = 0; j < 16; ++j) { const unsigned c = xb_ld(&bar[XB_XCNT(j)]); sum += c; cnt += (c > 0u) ? 1u : 0u; mine = (j == x) ? c : mine; }
        if (sum == G) break;
        __builtin_amdgcn_s_sleep(1);
        if ((++sp & 255u) == 0u) { if (xb_ld(&bar[XB_TMO])) break; if (sp > XB_SPIN_CAP) { atomicAdd(&bar[XB_TMO], 1u); break; } }
    }
    nloc = mine > 0u ? mine : 1u; nx = cnt > 0u ? cnt : 1u;
}
__device__ __forceinline__ void xcd_barrier(const XcdBarrier& b) {
    asm volatile("s_waitcnt vmcnt(0)" ::: "memory");
    __syncthreads();
    if (threadIdx.x == 0) {
        unsigned* bar = b.bar;
        __builtin_amdgcn_s_waitcnt(0);
        unsigned nloc = b.st[0], nx = b.st[1];
        if (nloc == 0u) { xcd_barrier_complete(bar, b.x, nloc, nx); b.st[0] = nloc; b.st[1] = nx; }
        const unsigned old = xb_add(&bar[XB_XSUB(b.x)], 1u);
        const unsigned gen = old / nloc;
        if (old + 1u == (gen + 1u) * nloc) {
            __builtin_amdgcn_fence(__ATOMIC_RELEASE, "agent");
            asm volatile("s_waitcnt vmcnt(0)" ::: "memory");
            const unsigned og = xb_add(&bar[XB_TOP], 1u);
            const unsigned tg = og / nx;
            if (og + 1u == (tg + 1u) * nx) xb_add(&bar[XB_TOPGEN], 1u);
            else XB_SPIN(xb_ld(&bar[XB_TOPGEN]) == tg, bar);
            __builtin_amdgcn_fence(__ATOMIC_ACQUIRE, "agent");
            xb_add(&bar[XB_XGEN(b.x)], 1u);
            asm volatile("s_waitcnt vmcnt(0)" ::: "memory");
        } else {
            XB_SPIN(xb_ld(&bar[XB_XGEN(b.x)]) == gen, bar);
            __builtin_amdgcn_fence(__ATOMIC_ACQUIRE, "agent");
            asm volatile("s_waitcnt vmcnt(0)" ::: "memory");
        }
    }
    __syncthreads();
}

namespace pg8 {
constexpr int BM = 256, BK = 64, HALF = 128, HTB = HALF * BK * 2, STAGE_BYTES = 8 * HTB, NXCD = 8, WGM = 8;
__device__ __forceinline__ int lds_byte(int r, int c) { const int st = (r >> 4) * 2 + (c >> 5), rr = r & 15, cc = c & 31, ob = rr * 64 + cc * 2; return st * 1024 + (ob ^ (((ob >> 9) & 1) << 5)); }
__device__ __forceinline__ void stage_rc(int b, int& R, int& C) { const int st = b / 1024, sb = b % 1024, swz = sb ^ (((sb >> 9) & 1) << 5); R = (st >> 1) * 16 + swz / 64; C = (st & 1) * 32 + (swz % 64) / 2; }
__device__ __forceinline__ int perm32(int rho) { const int n = rho >> 4, i = rho & 15; return 8 * (i >> 2) + 4 * n + (i & 3); }

struct Unit { int pm, pn, e; };

__device__ __forceinline__ bool static_tile(long L, int nM, int nN, int& pm, int& pn) {
    const int nwg = nM * nN; if (L >= nwg) return false;
    int wgid = (int)L; { const int q = nwg / NXCD, r = nwg % NXCD, xcd = wgid % NXCD, off = wgid / NXCD; wgid = (xcd < r ? xcd * (q + 1) : r * (q + 1) + (xcd - r) * q) + off; }
    const int nig = WGM * nN, gid = wgid / nig, fm = gid * WGM, gsz = (nM - fm) < WGM ? (nM - fm) : WGM;
    pm = fm + ((wgid % nig) % gsz); pn = (wgid % nig) / gsz; return true;
}
struct DenseOrder {
    int nM, nN, G, c, skipctx; const char* A; const char* Bt; size_t tstep;
    __device__ __forceinline__ bool next(int i, Unit& u) const {
        int pm, pn; if (!static_tile((long)i * G + c, nM, nN, pm, pn)) return false;
        u.pm = skipctx ? (pm >> 4) * 17 + 1 + (pm & 15) : pm; u.pn = pn; u.e = 0; return true; }
    __device__ __forceinline__ const char* a_base(const Unit& u) const { return A + (size_t)u.pm * tstep; }
    __device__ __forceinline__ const char* b_base(const Unit& u) const { return Bt + (size_t)u.pn * tstep; }
};
struct MoeOrder {
    int nMe, nN, G, c; const char* A; size_t a_estride; const char* Bt; size_t b_estride; size_t tstep;
    __device__ __forceinline__ bool next(int i, Unit& u) const {
        const int per_e = nMe * nN, nwg = per_e * NEXP; const long L = (long)i * G + c; if (L >= nwg) return false;
        int wgid = (int)L; { const int q = nwg / NXCD, r = nwg % NXCD, xcd = wgid % NXCD, off = wgid / NXCD; wgid = (xcd < r ? xcd * (q + 1) : r * (q + 1) + (xcd - r) * q) + off; }
        u.e = wgid / per_e; const int loc = wgid % per_e;
        const int nig = WGM * nN, gid = loc / nig, fm = gid * WGM, gsz = (nMe - fm) < WGM ? (nMe - fm) : WGM;
        u.pm = fm + ((loc % nig) % gsz); u.pn = (loc % nig) / gsz; return true; }
    __device__ __forceinline__ const char* a_base(const Unit& u) const { return A + (size_t)u.e * a_estride + (a_estride ? (size_t)u.pm * tstep : 0); }
    __device__ __forceinline__ const char* b_base(const Unit& u) const { return Bt + (size_t)u.e * b_estride + (size_t)u.pn * tstep; }
};

struct EpiP {
    static constexpr bool PERM = true; unsigned char* wsb; int rope; float sw;
    template <class AT> __device__ __forceinline__ void operator()(const AT (&acc)[2][2][4][2], const Unit& u, int wr, int wc, int fr, int fq) const {
        const int row0 = u.pm * BM + wr * 64 + fr, col0 = u.pn * BM + wc * 32 + 8 * fq;
        const int pt = u.pm % 17;
        bf16_t* const O = (bf16_t*)(wsb + WS_R2); const float* const sa = (const float*)(wsb + WS_SAX);
        unsigned char* const k8a = wsb + WS_K8; unsigned char* const k8b = wsb + WS_K8D; unsigned char* const v8a = wsb + WS_V8; unsigned char* const v8b = wsb + WS_V8D;
        int frl = fr, fql = fq; asm volatile("" : "+v"(frl), "+v"(fql));
        unsigned char* kq = nullptr;
        if (rope) { if (u.pn == 4) kq = k8a; else if (u.pn >= 10 && u.pn <= 13) kq = k8b + (size_t)(u.pn - 10) * 2 * NROWS * 128; }
        if (rope && (u.pn == 5 || u.pn >= 14)) {
            const int b = u.pm / 17, qi = frl & 3, a4 = frl >> 2, nhv = u.pn == 5 ? 2 : 8, hv0 = u.pn == 5 ? 0 : (u.pn - 14) * 2; unsigned char* vq = u.pn == 5 ? v8a : v8b;
            const unsigned sel = (unsigned)qi | ((unsigned)(4 + qi) << 8) | 0x0c0c0000u;
#pragma unroll
            for (int ai = 0; ai < 2; ++ai)
#pragma unroll
                for (int m = 0; m < 4; ++m) { const float rsc = sa[row0 + ai * HALF + m * 16] * sw;
                    const int tile = (u.pm % 17) * 4 + wr + 2 * ai, pos0 = 32 * (a4 & 1) + 16 * (m >> 1) + 4 * ((2 * m + (a4 >> 1)) & 3);
#pragma unroll
                    for (int bj = 0; bj < 2; ++bj) { const f32x4 v0 = tof(acc[ai][bj][m][0]) * rsc, v1 = tof(acc[ai][bj][m][1]) * rsc;
                        unsigned char* tb_ = vq + ((size_t)((b * nhv + hv0 + bj) * 68 + tile)) * 8192 + (size_t)(wc * 32 + 8 * fql) * 64 + pos0;
#pragma unroll
                        for (int hh = 0; hh < 2; ++hh) { const f32x4 vv = hh ? v1 : v0; const int w = (int)pack_f8x4(vv[0], vv[1], vv[2], vv[3], 1.f);
                            const unsigned p0 = (unsigned)__builtin_amdgcn_update_dpp(0, w, 0x00, 0xf, 0xf, false), p1 = (unsigned)__builtin_amdgcn_update_dpp(0, w, 0x55, 0xf, 0xf, false);
                            const unsigned p2 = (unsigned)__builtin_amdgcn_update_dpp(0, w, 0xaa, 0xf, 0xf, false), p3 = (unsigned)__builtin_amdgcn_update_dpp(0, w, 0xff, 0xf, 0xf, false);
                            const unsigned t01 = __builtin_amdgcn_perm(p1, p0, sel), t23 = __builtin_amdgcn_perm(p3, p2, sel);
                            *(unsigned*)(tb_ + (hh * 4 + qi) * 64) = t01 | (t23 << 16); } } }
        }
        const bool dorope = rope && pt != 0 && (u.pn <= 4 || (u.pn >= 6 && u.pn <= 13));
        const int jf = ((wc & 1) * 4 + fq) * 4;
        float inv[4];
#pragma unroll
        for (int i = 0; i < 4; ++i) inv[i] = exp2f(-(float)(jf + i) * (13.287712379549449f / 32.f));
#pragma unroll
        for (int ai = 0; ai < 2; ++ai)
#pragma unroll
            for (int m = 0; m < 4; ++m) { bf16_t* rowp = O + (size_t)(row0 + ai * HALF + m * 16) * INW + col0; const float rsc = sa[row0 + ai * HALF + m * 16] * sw;
                float cs[4], sn[4];
                if (dorope) { const int pos = (pt - 1) * 256 + wr * 64 + ai * HALF + m * 16 + fr; const float pp = (float)((wc >> 1) == 0 ? (pos >> 6) : (pos & 63));
#pragma unroll
                    for (int i = 0; i < 4; ++i) { const float ang = pp * inv[i]; cs[i] = __cosf(ang); sn[i] = __sinf(ang); } }
#pragma unroll
                for (int bj = 0; bj < 2; ++bj) { f32x4 v0 = tof(acc[ai][bj][m][0]) * rsc, v1 = tof(acc[ai][bj][m][1]) * rsc;
                    if (dorope) {
#pragma unroll
                        for (int i = 0; i < 4; ++i) { const float a = v0[i], b = v1[i]; v0[i] = a * cs[i] - b * sn[i]; v1[i] = b * cs[i] + a * sn[i]; } }
                    u32x4 w; w.x = cvtpk(v0[0], v0[1]); w.y = cvtpk(v0[2], v0[3]); w.z = cvtpk(v1[0], v1[1]); w.w = cvtpk(v1[2], v1[3]);
                    *(u32x4*)(rowp + bj * HALF) = w;
                    if (kq != nullptr) { u32x2 w8; w8.x = pack_f8x4(v0[0], v0[1], v0[2], v0[3], 1.f); w8.y = pack_f8x4(v1[0], v1[1], v1[2], v1[3], 1.f);
                        *(u32x2*)(kq + ((size_t)bj * NROWS + (u.pm * BM + wr * 64 + frl + ai * HALF + m * 16)) * 128 + wc * 32 + 8 * fql) = w8; } } }
    }
};
struct EpiDelta {
    static constexpr bool PERM = true; bf16_t* D; const float* modl; const float* so; float sw;
    template <class AT> __device__ __forceinline__ void operator()(const AT (&acc)[2][2][4][2], const Unit& u, int wr, int wc, int fr, int fq) const {
        const int b = u.pm / 17, pt = u.pm % 17;
        const float* gt = modl + (size_t)(pt == 0 ? 8 : b) * MODW + 2 * DM;
        const int row0 = u.pm * BM + wr * 64 + fr, col0 = u.pn * BM + wc * 32 + 8 * fq;
        f32x4 g[2][2];
#pragma unroll
        for (int bj = 0; bj < 2; ++bj)
#pragma unroll
            for (int n = 0; n < 2; ++n) g[bj][n] = *(const f32x4*)(gt + col0 + bj * HALF + 4 * n) * sw;
#pragma unroll
        for (int ai = 0; ai < 2; ++ai)
#pragma unroll
            for (int m = 0; m < 4; ++m) { const int row = row0 + ai * HALF + m * 16; const float rs = so ? so[row] : 1.f; bf16_t* rowp = D + (size_t)row * DM + col0;
#pragma unroll
                for (int bj = 0; bj < 2; ++bj) { const f32x4 v0 = tof(acc[ai][bj][m][0]) * g[bj][0] * rs, v1 = tof(acc[ai][bj][m][1]) * g[bj][1] * rs;
                    u32x4 w; w.x = cvtpk(v0[0], v0[1]); w.y = cvtpk(v0[2], v0[3]); w.z = cvtpk(v1[0], v1[1]); w.w = cvtpk(v1[2], v1[3]);
                    *(u32x4*)(rowp + bj * HALF) = w; } }
    }
};
struct EpiSwiglu {
    static constexpr bool PERM = true; unsigned char* H; int mexp; const float* sas; const float* wsc;
    template <class AT> __device__ __forceinline__ void operator()(const AT (&acc)[2][2][4][2], const Unit& u, int wr, int wc, int fr, int fq) const {
        const int row0 = u.e * mexp + u.pm * BM + wr * 64 + fr, col0 = u.pn * 128 + wc * 16 + 4 * fq;
        const float sg = wsc[2 * u.e], su = wsc[2 * u.e + 1];
#pragma unroll
        for (int ai = 0; ai < 2; ++ai)
#pragma unroll
            for (int m = 0; m < 4; ++m) { unsigned char* rowp = H + (size_t)(row0 + ai * HALF + m * 16) * DEXP + col0; const float rs_ = sas[row0 + ai * HALF + m * 16];
#pragma unroll
                for (int bj = 0; bj < 2; ++bj) { const f32x4 g = tof(acc[ai][bj][m][0]) * (rs_ * sg), up = tof(acc[ai][bj][m][1]) * (rs_ * su); f32x4 h;
#pragma unroll
                    for (int q = 0; q < 4; ++q) h[q] = g[q] * __builtin_amdgcn_rcpf(1.f + __expf(-g[q])) * up[q];
                    *(unsigned*)(rowp + bj * 64) = pack_f8x4(h[0], h[1], h[2], h[3], HID_SCALE); } }
    }
};
struct EpiDown {
    static constexpr bool PERM = true; unsigned char* Y; const float* gate; int mexp; const float* wsc;
    template <class AT> __device__ __forceinline__ void operator()(const AT (&acc)[2][2][4][2], const Unit& u, int wr, int wc, int fr, int fq) const {
        const int row0 = u.e * mexp + u.pm * BM + wr * 64 + fr, col0 = u.pn * BM + wc * 32 + 8 * fq;
#pragma unroll
        for (int ai = 0; ai < 2; ++ai)
#pragma unroll
            for (int m = 0; m < 4; ++m) { const int row = row0 + ai * HALF + m * 16; const float gv = gate[row] * (wsc[u.e] * (Y_SCALE / HID_SCALE)); unsigned char* rowp = Y + (size_t)row * DM + col0;
#pragma unroll
                for (int bj = 0; bj < 2; ++bj) { const f32x4 v0 = tof(acc[ai][bj][m][0]) * gv, v1 = tof(acc[ai][bj][m][1]) * gv;
                    u32x2 w; w.x = pack_f8x4(v0[0], v0[1], v0[2], v0[3], 1.f); w.y = pack_f8x4(v1[0], v1[1], v1[2], v1[3], 1.f);
                    *(u32x2*)(rowp + bj * HALF) = w; } }
    }
};

__device__ __forceinline__ void mfma_f8(f32x4& acc, const i32x8 a, const i32x8 b) { asm volatile("v_mfma_f32_16x16x128_f8f6f4 %0, %1, %2, %0" : "+v"(acc) : "v"(a), "v"(b)); }
__device__ __forceinline__ void mfma_f8(i32x4& acc, const i32x8 a, const i32x8 b) { }
template <class Epi, class Sched, bool GATHER, bool I8, bool F8 = false>
__device__ __forceinline__ void gemm_phase(const int tid, LAS unsigned char* lds, const LAS unsigned* rowtab, const int KB, const Sched& S, const Epi& E) {
    const int wid = __builtin_amdgcn_readfirstlane(tid >> 6), lane = tid & 63, wr = wid >> 2, wc = wid & 3, fr = lane & 15, fq = lane >> 4;
    const int nt = KB / (BK * 2);
    const unsigned hstep = (unsigned)HALF * KB;
    const size_t kstep = (size_t)(BK * 2);
    unsigned voffB[2], vAc[2][2];
#pragma unroll
    for (int i = 0; i < 2; ++i) { int R, C; stage_rc(tid * 16 + i * 8192, R, C); const int Rb = Epi::PERM ? ((R & ~31) + perm32(R & 31)) : R;
        voffB[i] = (unsigned)(Rb * KB) + (unsigned)C * 2u; }
    const unsigned ldsw = (unsigned)wid * 1024u;
    const int aoff = lds_byte(wr * 64 + fr, fq * 8), boff = lds_byte(wc * 32 + fr, fq * 8);
#define PG8_SA(b, h) (((b) * 2 + (h)) * HTB)
#define PG8_SB(b, h) ((4 + (b) * 2 + (h)) * HTB)
#define PG8_STAGE(bufoff, gbase, voff) do { _Pragma("unroll") for (int _i = 0; _i < 2; ++_i) \
        __builtin_amdgcn_global_load_lds((const unsigned*)((const char*)(gbase) + (voff)[_i]), (LAS unsigned*)(lds + (bufoff) + ldsw + _i * 8192), 16, 0, 0); } while (0)
#define PG8_LDA(dst, b, h) do { _Pragma("unroll") for (int m = 0; m < 4; ++m) _Pragma("unroll") for (int k = 0; k < 2; ++k) dst[m][k] = *(const LAS bf16x8*)(lds + PG8_SA(b, h) + aoff + m * 2048 + k * 1024); } while (0)
#define PG8_LDB(dst, b, h) do { _Pragma("unroll") for (int n = 0; n < 2; ++n) _Pragma("unroll") for (int k = 0; k < 2; ++k) dst[n][k] = *(const LAS bf16x8*)(lds + PG8_SB(b, h) + boff + n * 2048 + k * 1024); } while (0)
#define PG8_MMA(ai, bj, At, Bt) do { __builtin_amdgcn_s_setprio(1); _Pragma("unroll") for (int m = 0; m < 4; ++m) _Pragma("unroll") for (int n = 0; n < 2; ++n) \
        if constexpr (F8) mfma_f8(acc[ai][bj][m][n], __builtin_shufflevector(__builtin_bit_cast(i32x4, Bt[n][0]), __builtin_bit_cast(i32x4, Bt[n][1]), 0, 1, 2, 3, 4, 5, 6, 7), \
            __builtin_shufflevector(__builtin_bit_cast(i32x4, At[m][0]), __builtin_bit_cast(i32x4, At[m][1]), 0, 1, 2, 3, 4, 5, 6, 7)); \
        else _Pragma("unroll") for (int k = 0; k < 2; ++k) \
        { if constexpr (I8) acc[ai][bj][m][n] = __builtin_amdgcn_mfma_i32_16x16x64_i8(__builtin_bit_cast(i32x4, Bt[n][k]), __builtin_bit_cast(i32x4, At[m][k]), acc[ai][bj][m][n], 0, 0, 0); \
          else acc[ai][bj][m][n] = __builtin_amdgcn_mfma_f32_16x16x32_bf16(Bt[n][k], At[m][k], acc[ai][bj][m][n], 0, 0, 0); } __builtin_amdgcn_s_setprio(0); } while (0)
#define PG8_WAIT_V(n) asm volatile("s_waitcnt vmcnt(" #n ")" ::: "memory")
#define PG8_WAIT_L(n) asm volatile("s_waitcnt lgkmcnt(" #n ")" ::: "memory")
#define PG8_BAR __builtin_amdgcn_s_barrier()
#define PG8_SCHED __builtin_amdgcn_sched_barrier(0)
#define PG8_LOADTAB(dst, ui_) do { _Pragma("unroll") for (int _i = 0; _i < 2; ++_i) { int _R, _C; stage_rc(tid * 16 + _i * 8192, _R, _C); _Pragma("unroll") for (int _h = 0; _h < 2; ++_h) \
        dst[_h][_i] = GATHER ? rowtab[(ui_) * 256 + _h * HALF + _R] + (unsigned)_C * 2u : (unsigned)((_h * HALF + _R) * KB) + (unsigned)_C * 2u; } } while (0)
    Unit cur, nxt; int ui = 0;
    if (!S.next(0, cur)) return;
    typedef typename std::conditional<I8 && !F8, i32x4, f32x4>::type acc_t;
    acc_t acc[2][2][4][2];
#pragma unroll
    for (int a = 0; a < 2; ++a)
#pragma unroll
        for (int b = 0; b < 2; ++b)
#pragma unroll
            for (int m = 0; m < 4; ++m)
#pragma unroll
                for (int n = 0; n < 2; ++n) acc[a][b][m][n] = acc_t{};
    bf16x8 At[4][2], B0[2][2], B1[2][2];
    const char* cA = S.a_base(cur); const char* cB = S.b_base(cur);
    PG8_LOADTAB(vAc, 0);
    PG8_STAGE(PG8_SB(0, 0), cB, voffB); PG8_STAGE(PG8_SB(0, 1), cB + hstep, voffB); PG8_STAGE(PG8_SA(0, 0), cA, vAc[0]); PG8_STAGE(PG8_SA(0, 1), cA, vAc[1]);
    if (wr == 1) PG8_BAR;
    PG8_WAIT_V(2); PG8_BAR;
    PG8_STAGE(PG8_SB(1, 0), cB + kstep, voffB); PG8_STAGE(PG8_SA(1, 0), cA + kstep, vAc[0]); PG8_STAGE(PG8_SB(1, 1), cB + hstep + kstep, voffB);
    PG8_WAIT_V(6); PG8_BAR;
    for (;;) {
        const bool has_next = S.next(ui + 1, nxt);
        const char* nA = has_next ? S.a_base(nxt) : cA; const char* nB = has_next ? S.b_base(nxt) : cB;
        for (int t = 0; t < nt; t += 2) {
            const bool last = (t == nt - 2);
            const char* a1 = cA + (size_t)(t + 1) * kstep;
            const char* a2 = last ? nA : cA + (size_t)(t + 2) * kstep; const char* b2 = last ? nB : cB + (size_t)(t + 2) * kstep;
            const char* a3 = a2 + kstep; const char* b3 = b2 + kstep;
            PG8_LDB(B0, 0, 0); PG8_LDB(B1, 0, 1); PG8_SCHED; PG8_LDA(At, 0, 0); PG8_STAGE(PG8_SA(1, 1), a1, vAc[1]);
            if (GATHER) { if (last && has_next) { PG8_LOADTAB(vAc, ui + 1); } }
            PG8_WAIT_V(8); PG8_WAIT_L(0); PG8_BAR; PG8_MMA(0, 0, At, B0); PG8_MMA(0, 1, At, B1); PG8_BAR; PG8_SCHED;
            PG8_LDA(At, 0, 1); PG8_STAGE(PG8_SB(0, 0), b2, voffB); PG8_STAGE(PG8_SB(0, 1), b2 + hstep, voffB); PG8_STAGE(PG8_SA(0, 0), a2, vAc[0]);
            PG8_WAIT_V(8); PG8_WAIT_L(0); PG8_BAR; PG8_MMA(1, 0, At, B0); PG8_MMA(1, 1, At, B1); PG8_BAR; PG8_SCHED;
            PG8_LDB(B0, 1, 0); PG8_LDB(B1, 1, 1); PG8_SCHED; PG8_LDA(At, 1, 0); PG8_STAGE(PG8_SA(0, 1), a2, vAc[1]);
            PG8_WAIT_V(8); PG8_WAIT_L(0); PG8_BAR; PG8_MMA(0, 0, At, B0); PG8_MMA(0, 1, At, B1); PG8_BAR; PG8_SCHED;
            PG8_LDA(At, 1, 1); PG8_STAGE(PG8_SB(1, 0), b3, voffB); PG8_STAGE(PG8_SB(1, 1), b3 + hstep, voffB); PG8_STAGE(PG8_SA(1, 0), a3, vAc[0]);
            PG8_WAIT_V(8); PG8_WAIT_L(0); PG8_BAR; PG8_MMA(1, 0, At, B0); PG8_MMA(1, 1, At, B1); PG8_BAR; PG8_SCHED;
        }
        if (wr == 0) PG8_BAR;
        E(acc, cur, wr, wc, fr, fq);
        if (!has_next) break;
#pragma unroll
        for (int a = 0; a < 2; ++a)
#pragma unroll
            for (int b = 0; b < 2; ++b)
#pragma unroll
                for (int m = 0; m < 4; ++m)
#pragma unroll
                    for (int n = 0; n < 2; ++n) acc[a][b][m][n] = acc_t{};
        cur = nxt; cA = nA; cB = nB; ++ui;
        if (wr == 1) PG8_BAR;
    }
    PG8_WAIT_V(0);
    PG8_BAR;
#undef PG8_SA
#undef PG8_SB
#undef PG8_STAGE
#undef PG8_LDA
#undef PG8_LDB
#undef PG8_MMA
#undef PG8_WAIT_V
#undef PG8_WAIT_L
#undef PG8_BAR
#undef PG8_SCHED
#undef PG8_LOADTAB
}
}

namespace att {
constexpr int D = 128, NW = 8, QBLK = 32, KVBLK = 64, LDP = INW;
constexpr float SCALE = 0.088388347648318440f;
constexpr float THR = 8.f;
constexpr int NBUF = 3;
constexpr int SHM_V = KVBLK * D * 2, SHM_K = KVBLK * D * 2, SHM_ATTN = NBUF * SHM_V + NBUF * SHM_K + NW * 64 * 4;
constexpr int BIAS_OFF = 100352;
#define KSWZ(row, colB) ((row) * 256 + ((colB) ^ (((row) & 7) << 4)))
#define SBAR() __builtin_amdgcn_sched_barrier(0)
__device__ __forceinline__ int crow(int r, int hi) { return (r & 3) + 8 * (r >> 2) + 4 * hi; }

struct AUnit { int qrow0, qcol, kcol, vcol, kbase, NT, seg2row, mode, pa, pb, head, ocol, outf32, has_sink; float sink; };

template <bool FIXREF = false> __device__ __forceinline__ void partialSM(f32x16& p0, f32x16& p1, float& m_reg, float& mn, float& alpha) {
  constexpr float C = SCALE * 1.4426950408889634f;
  if constexpr (FIXREF) { mn = m_reg; alpha = 1.f;
#pragma unroll
    for (int r = 0; r < 16; ++r) p0[r] = __builtin_amdgcn_exp2f(p0[r]);
    return; }
  float pmax = p0[0];
#pragma unroll
  for (int r = 1; r < 16; ++r) pmax = fmaxf(pmax, p0[r]);
#pragma unroll
  for (int r = 0; r < 16; ++r) pmax = fmaxf(pmax, p1[r]);
  { auto rr = __builtin_amdgcn_permlane32_swap(__float_as_uint(pmax), __float_as_uint(pmax), false, false);
    pmax = fmaxf(__uint_as_float(rr[0]), __uint_as_float(rr[1])); }
  if (__builtin_expect(__all(pmax - m_reg <= THR / SCALE), 1)) { mn = m_reg; alpha = 1.f; }
  else { mn = fmaxf(m_reg, pmax); alpha = __builtin_amdgcn_exp2f((m_reg - mn) * C); m_reg = mn; }
  float mnC = -mn * C;
#pragma unroll
  for (int r = 0; r < 16; ++r) p0[r] = fmaf(p0[r], C, mnC);
#pragma unroll
  for (int r = 0; r < 16; ++r) p1[r] = fmaf(p1[r], C, mnC);
#pragma unroll
  for (int r = 0; r < 16; ++r) p0[r] = __builtin_amdgcn_exp2f(p0[r]);
}
__device__ __forceinline__ void firstSM(f32x16& p0, f32x16& p1, float& m_reg) {
  float pmax = p0[0];
#pragma unroll
  for (int r = 1; r < 16; ++r) pmax = fmaxf(pmax, p0[r]);
#pragma unroll
  for (int r = 0; r < 16; ++r) pmax = fmaxf(pmax, p1[r]);
  { auto rr = __builtin_amdgcn_permlane32_swap(__float_as_uint(pmax), __float_as_uint(pmax), false, false);
    pmax = fmaxf(__uint_as_float(rr[0]), __uint_as_float(rr[1])); }
  m_reg = pmax;
#pragma unroll
  for (int r = 0; r < 16; ++r) p0[r] = __builtin_amdgcn_exp2f(p0[r] - pmax);
#pragma unroll
  for (int r = 0; r < 16; ++r) p1[r] -= pmax;
}
__device__ __forceinline__ void finishSM(f32x16& p0, f32x16& p1, float alpha, float& l_reg, bf16x8& pa0, bf16x8& pa1, bf16x8& pa2, bf16x8& pa3) {
#pragma unroll
  for (int r = 0; r < 16; ++r) p1[r] = __builtin_amdgcn_exp2f(p1[r]);
  float ps = 0;
#pragma unroll
  for (int r = 0; r < 16; ++r) ps += p0[r];
#pragma unroll
  for (int r = 0; r < 16; ++r) ps += p1[r];
  { auto rr = __builtin_amdgcn_permlane32_swap(__float_as_uint(ps), __float_as_uint(ps), false, false);
    ps = __uint_as_float(rr[0]) + __uint_as_float(rr[1]); }
  l_reg = l_reg * alpha + ps;
#define PK4(P, BASE, OUT) do { unsigned a0 = cvtpk(P[BASE + 0], P[BASE + 1]), a1 = cvtpk(P[BASE + 2], P[BASE + 3]);   \
    unsigned b0 = cvtpk(P[BASE + 4], P[BASE + 5]), b1 = cvtpk(P[BASE + 6], P[BASE + 7]);                              \
    auto r0 = __builtin_amdgcn_permlane32_swap(a0, b0, false, false); auto r1 = __builtin_amdgcn_permlane32_swap(a1, b1, false, false); \
    u32x4 w = {r0[0], r1[0], r0[1], r1[1]}; OUT = *reinterpret_cast<bf16x8*>(&w); } while (0)
  PK4(p0, 0, pa0); PK4(p0, 8, pa1); PK4(p1, 0, pa2); PK4(p1, 8, pa3);
#undef PK4
}
__device__ __forceinline__ void qkt(f32x16& p0, f32x16& p1, const LAS char* Ks, const bf16x8* qr, int r32, int hi, const f32x16& init) {
  p0 = init; p1 = init;
#pragma unroll
  for (int d0 = 0; d0 < 8; ++d0) { int cb = (d0 * 16 + hi * 8) * 2;
    bf16x8 b0 = *reinterpret_cast<const LAS bf16x8*>(Ks + KSWZ(r32, cb));
    bf16x8 b1 = *reinterpret_cast<const LAS bf16x8*>(Ks + KSWZ(32 + r32, cb));
    p0 = __builtin_amdgcn_mfma_f32_32x32x16_bf16(b0, qr[d0], p0, 0, 0, 0);
    p1 = __builtin_amdgcn_mfma_f32_32x32x16_bf16(b1, qr[d0], p1, 0, 0, 0); }
}
__device__ __forceinline__ int v_st(int k, int c) { const int kk = (k & ~0xC) | ((k & 4) << 1) | ((k & 8) >> 1); return ((kk >> 3) * 4 + (c >> 5)) * 512 + ((kk & 7) * 32 + (c & 31)) * 2; }
__device__ __forceinline__ int v_rd_base(int lane) { return ((lane & 3) << 3) | (((lane >> 2) & 3) << 6) | (((lane >> 4) & 1) << 5) | (((lane >> 5) & 1) << 8); }
constexpr int v_rd_off(int d0, int ks, int half) { return d0 * 512 + ks * 4096 + half * 2048; }
template <int OFF> __device__ __forceinline__ s16x4 tr_read(int vb) {
  s16x4 r; asm volatile("ds_read_b64_tr_b16 %0, %1 offset:%2" : "=&v"(r) : "v"(vb), "i"(OFF) : "memory"); return r;
}
template <int D0> __device__ __forceinline__ void pv_one(f32x16& od, int vb, bf16x8 pa0, bf16x8 pa1, bf16x8 pa2, bf16x8 pa3) {
  const s16x4 l0 = tr_read<v_rd_off(D0, 0, 0)>(vb), h0 = tr_read<v_rd_off(D0, 0, 1)>(vb), l1 = tr_read<v_rd_off(D0, 1, 0)>(vb), h1 = tr_read<v_rd_off(D0, 1, 1)>(vb);
  const s16x4 l2 = tr_read<v_rd_off(D0, 2, 0)>(vb), h2 = tr_read<v_rd_off(D0, 2, 1)>(vb), l3 = tr_read<v_rd_off(D0, 3, 0)>(vb), h3 = tr_read<v_rd_off(D0, 3, 1)>(vb);
  asm volatile("s_waitcnt lgkmcnt(0)" ::: "memory"); SBAR();
#define PK(L, H) (bf16x8){L[0], L[1], L[2], L[3], H[0], H[1], H[2], H[3]}
  od = __builtin_amdgcn_mfma_f32_32x32x16_bf16(pa0, PK(l0, h0), od, 0, 0, 0);
  od = __builtin_amdgcn_mfma_f32_32x32x16_bf16(pa1, PK(l1, h1), od, 0, 0, 0);
  od = __builtin_amdgcn_mfma_f32_32x32x16_bf16(pa2, PK(l2, h2), od, 0, 0, 0);
  od = __builtin_amdgcn_mfma_f32_32x32x16_bf16(pa3, PK(l3, h3), od, 0, 0, 0);
#undef PK
}
__device__ __forceinline__ void pv_d0(f32x16* o, int vb, bf16x8 pa0, bf16x8 pa1, bf16x8 pa2, bf16x8 pa3) {
  pv_one<0>(o[0], vb, pa0, pa1, pa2, pa3); pv_one<1>(o[1], vb, pa0, pa1, pa2, pa3); pv_one<2>(o[2], vb, pa0, pa1, pa2, pa3); pv_one<3>(o[3], vb, pa0, pa1, pa2, pa3);
}
template <int MODE> __device__ __forceinline__ void mask_tile(f32x16& p0, f32x16& p1, const AUnit& u, int j, int wid, int r32, int hi, const LAS float* btab) {
  if (MODE == 0 || j < 4) return;
  if (MODE == 1) {
    const int qpos = u.pa + wid * 32 + r32, k0 = u.pb + (j - 4) * 64 + 4 * hi;
#pragma unroll
    for (int r = 0; r < 16; ++r) { const int d = qpos - (k0 + (r & 3) + 8 * (r >> 2));
      p0[r] = (d <= 128 && d >= -128) ? p0[r] : -1e30f; const int d1 = d - 32; p1[r] = (d1 <= 128 && d1 >= -128) ? p1[r] : -1e30f; }
  } else {
    const int qr = u.pa + (wid >> 1), qc = (wid & 1) * 32 + r32, kr = u.pb + (j - 4);
    const int rs = min(max(qr - 4, 0), 56), cs = min(max(qc - 8, 0), 48);
    const bool rowok = (kr >= rs) && (kr < rs + 8);
    const LAS float* tb = btab + u.head * 480 + (kr - qr + 7) * 32 + (15 - qc) + 4 * hi;
#pragma unroll
    for (int r = 0; r < 16; ++r) { const int kc = (r & 3) + 8 * (r >> 2), kf = kc + 4 * hi;
      const float b0 = tb[kc], b1 = tb[kc + 32];
      p0[r] = (rowok && kf >= cs && kf < cs + 16) ? p0[r] + b0 : -1e30f;
      p1[r] = (rowok && kf + 32 >= cs && kf + 32 < cs + 16) ? p1[r] + b1 : -1e30f; }
  }
}

__device__ __forceinline__ void store_o8(unsigned char* Ow, const f32x16 (&o)[4], const float (&rli)[16], const int r32, const int hi) {
  const int qi = r32 & 3; const unsigned sel = (unsigned)qi | ((unsigned)(4 + qi) << 8) | 0x0c0c0000u;
  unsigned char* base = Ow + qi * 32 + (r32 & ~3);
#pragma unroll
  for (int r = 0; r < 16; ++r) { const float sc = rli[r] * O8_SCALE;
    int w = 0; w = __builtin_amdgcn_cvt_pk_fp8_f32(clamp_f8(o[0][r] * sc), clamp_f8(o[1][r] * sc), w, false); w = __builtin_amdgcn_cvt_pk_fp8_f32(clamp_f8(o[2][r] * sc), clamp_f8(o[3][r] * sc), w, true);
    const unsigned p0 = (unsigned)__builtin_amdgcn_update_dpp(0, w, 0x00, 0xf, 0xf, false), p1 = (unsigned)__builtin_amdgcn_update_dpp(0, w, 0x55, 0xf, 0xf, false);
    const unsigned p2 = (unsigned)__builtin_amdgcn_update_dpp(0, w, 0xaa, 0xf, 0xf, false), p3 = (unsigned)__builtin_amdgcn_update_dpp(0, w, 0xff, 0xf, 0xf, false);
    const unsigned t01 = __builtin_amdgcn_perm(p1, p0, sel), t23 = __builtin_amdgcn_perm(p3, p2, sel);
    *reinterpret_cast<unsigned*>(base + (size_t)crow(r, hi) * DM) = t01 | (t23 << 16); }
}
template <int MODE, int SDEPTH> __device__ __forceinline__ void attn_unit(const AUnit& u, const bf16_t* __restrict__ P, bf16_t* __restrict__ O, float* __restrict__ OB, LAS char* lds) {
  int tid = threadIdx.x; asm volatile("" : "+v"(tid));
  const int wid = tid >> 6, lane = tid & 63, r32 = lane & 31, hi = lane >> 5;
  LAS char* V_lds = lds; LAS char* K_lds = lds + NBUF * SHM_V;
  LAS float* ws = (LAS float*)(lds + NBUF * SHM_V + NBUF * SHM_K) + wid * 64; LAS float* li_l = ws; LAS float* al_l = ws + 32;
  const LAS float* btab = (const LAS float*)(lds + BIAS_OFF);
  float m_reg = -1e30f, l_reg = 0; f32x16 o[4] = {}; bf16x8 qr[8];
  const bf16_t* Qw = P + (size_t)(u.qrow0 + wid * QBLK + r32) * LDP + u.qcol + hi * 8;
#pragma unroll
  for (int d0 = 0; d0 < 8; ++d0) qr[d0] = *reinterpret_cast<const bf16x8*>(Qw + d0 * 16);
  f32x16 acc0 = {};
  {
    constexpr float C = SCALE * 1.4426950408889634f;
#pragma unroll
    for (int d0 = 0; d0 < 8; ++d0) { const u32x4 w = __builtin_bit_cast(u32x4, qr[d0]); u32x4 o_;
      o_.x = cvtpk(bflo(w.x) * C, bfhi(w.x) * C); o_.y = cvtpk(bflo(w.y) * C, bfhi(w.y) * C); o_.z = cvtpk(bflo(w.z) * C, bfhi(w.z) * C); o_.w = cvtpk(bflo(w.w) * C, bfhi(w.w) * C);
      qr[d0] = __builtin_bit_cast(bf16x8, o_); } }
  const char* Kh = (const char*)(P + (size_t)u.kbase * LDP + u.kcol); const char* Vh = (const char*)(P + (size_t)u.kbase * LDP + u.vcol);
  const int wv = __builtin_amdgcn_readfirstlane(tid >> 6);
  const unsigned koff0 = (unsigned)((tid >> 4) * (LDP * 2)) + (unsigned)(((tid & 15) * 16) ^ (((tid >> 4) & 7) << 4));
  const int vs_ = tid >> 5, vkk = (vs_ >> 2) * 8 + ((tid & 31) >> 2), vk0 = (vkk & ~0xC) | ((vkk & 4) << 1) | ((vkk & 8) >> 1), vc0 = (vs_ & 3) * 32 + (tid & 3) * 8;
  const unsigned voff0 = (unsigned)(vk0 * (LDP * 2)) + (unsigned)(vc0 * 2);
  constexpr unsigned RS32 = 32u * LDP * 2u;
  const int vb0 = (int)(unsigned)(uintptr_t)V_lds + v_rd_base(lane);
#define KROW(j) ((j) < 4 ? (j) * 64 : u.seg2row + ((j) - 4) * 64)
#define GLDS(gp, lp) __builtin_amdgcn_global_load_lds((const unsigned*)(gp), (LAS unsigned*)(lp), 16, 0, 0)
#define DMA(slot, k0) do { const size_t _kb = (size_t)(k0) * (LDP * 2); LAS char* _kd = K_lds + (slot) * SHM_K + wv * 1024; LAS char* _vd = V_lds + (slot) * SHM_V + wv * 1024; \
    GLDS(Kh + _kb + koff0, _kd); GLDS(Kh + _kb + koff0 + RS32, _kd + 8192); GLDS(Vh + _kb + voff0, _vd); GLDS(Vh + _kb + voff0 + RS32, _vd + 8192); } while (0)
#define DWAIT() asm volatile("s_waitcnt vmcnt(0)" ::: "memory")
#define RESC(a) do { if (__any((a) < 1.f)) { if (hi == 0) al_l[r32] = (a); asm volatile("s_waitcnt lgkmcnt(0)" ::: "memory"); \
    _Pragma("unroll") for (int d = 0; d < 4; ++d) _Pragma("unroll") for (int r = 0; r < 16; ++r) o[d][r] *= al_l[crow(r, hi)]; } } while (0)
  f32x16 pA0, pA1, pB0, pB1; float mnA, mnB, alA, alB; bf16x8 pa0, pa1, pa2, pa3; const int NT = u.NT;
  int bp = 0, bc = 1, bn = 2;
  DMA(0, 0); DWAIT(); __syncthreads();
  qkt(pA0, pA1, K_lds, qr, r32, hi, acc0);
  { firstSM(pA0, pA1, m_reg); mnA = m_reg; alA = 1.f;
#pragma unroll
    for (int r = 0; r < 16; ++r) acc0[r] = -m_reg; }
  DMA(1, KROW(1)); DWAIT(); __syncthreads();
#define TILE_OK(j_) (MODE != 2 || (j_) < 4 || (u.pb + (j_) - 4 >= nb_rs && u.pb + (j_) - 4 < nb_rs + 8))
  const int nb_rs = min(max(u.pa + (wv >> 1) - 4, 0), 56);
  bool okA = true, okB = true;
  for (int j = 1; j + 1 < NT; j += 2) {
    DMA(bn, KROW(j + 1));
    okB = TILE_OK(j);
    SBAR(); if (okB) qkt(pB0, pB1, K_lds + bc * SHM_K, qr, r32, hi, acc0);
    if (okA) { finishSM(pA0, pA1, alA, l_reg, pa0, pa1, pa2, pa3); SBAR();
      pv_d0(o, vb0 + bp * (int)SHM_V, pa0, pa1, pa2, pa3); }
    if (okB) { mask_tile<MODE>(pB0, pB1, u, j, wid, r32, hi, btab); partialSM<true>(pB0, pB1, m_reg, mnB, alB); }
    DWAIT(); __syncthreads();
    bp = bc; bc = bn; bn = (bn == NBUF - 1) ? 0 : bn + 1;
    if (j + 2 < NT) DMA(bn, KROW(j + 2));
    okA = TILE_OK(j + 1);
    SBAR(); if (okA) qkt(pA0, pA1, K_lds + bc * SHM_K, qr, r32, hi, acc0);
    if (okB) { finishSM(pB0, pB1, alB, l_reg, pa0, pa1, pa2, pa3); SBAR();
      pv_d0(o, vb0 + bp * (int)SHM_V, pa0, pa1, pa2, pa3); }
    if (okA) { mask_tile<MODE>(pA0, pA1, u, j + 1, wid, r32, hi, btab); partialSM<true>(pA0, pA1, m_reg, mnA, alA); }
    DWAIT(); __syncthreads();
    bp = bc; bc = bn; bn = (bn == NBUF - 1) ? 0 : bn + 1;
  }
  okB = TILE_OK(NT - 1);
  SBAR(); if (okB) qkt(pB0, pB1, K_lds + bc * SHM_K, qr, r32, hi, acc0);
  if (okA) { finishSM(pA0, pA1, alA, l_reg, pa0, pa1, pa2, pa3); SBAR();
    pv_d0(o, vb0 + bp * (int)SHM_V, pa0, pa1, pa2, pa3); }
  if (okB) { mask_tile<MODE>(pB0, pB1, u, NT - 1, wid, r32, hi, btab); partialSM<true>(pB0, pB1, m_reg, mnB, alB);
    finishSM(pB0, pB1, alB, l_reg, pa0, pa1, pa2, pa3); SBAR();
    pv_d0(o, vb0 + bc * (int)SHM_V, pa0, pa1, pa2, pa3); }
#undef TILE_OK
  if (u.has_sink) l_reg += __builtin_amdgcn_exp2f(u.sink * 1.4426950408889634f - m_reg);
  if (hi == 0) li_l[r32] = l_reg; asm volatile("s_waitcnt lgkmcnt(0)" ::: "memory");
  float rli[16];
#pragma unroll
  for (int r = 0; r < 16; ++r) rli[r] = __builtin_amdgcn_rcpf(li_l[crow(r, hi)]);
  if (u.outf32) {
    float* Ow = OB + (size_t)(u.qrow0 + wid * QBLK) * DM + u.ocol;
#pragma unroll
    for (int r = 0; r < 16; ++r) { const int orow = crow(r, hi);
#pragma unroll
      for (int d0 = 0; d0 < 4; ++d0) Ow[(size_t)orow * DM + d0 * 32 + r32] = o[d0][r] * rli[r]; }
  } else {
    if constexpr (MODE == 2) {
      store_o8(reinterpret_cast<unsigned char*>(O) + (size_t)(u.qrow0 + wid * QBLK) * DM + u.ocol, o, rli, r32, hi);
    } else {
    bf16_t* Ow = O + (size_t)(u.qrow0 + wid * QBLK) * DM + u.ocol;
#pragma unroll
    for (int r = 0; r < 16; ++r) { const int orow = crow(r, hi);
#pragma unroll
      for (int d0 = 0; d0 < 4; ++d0) { const float v = o[d0][r] * rli[r]; Ow[(size_t)orow * DM + d0 * 32 + r32] = (bf16_t)(cvtpk(v, v) & 0xffffu); } }
    }
  }
  __syncthreads();
#undef KROW
#undef GLDS
#undef DMA
#undef DWAIT
#undef RESC
}
constexpr int SHM8 = 8192;
__device__ __forceinline__ void mfma8_32(f32x16& acc, const i32x8 a, const i32x8 b) { asm volatile("v_mfma_f32_32x32x64_f8f6f4 %0, %1, %2, %0" : "+v"(acc) : "v"(a), "v"(b)); }
__device__ __forceinline__ i32x8 cat8(const i32x4 a, const i32x4 b) { return __builtin_shufflevector(a, b, 0, 1, 2, 3, 4, 5, 6, 7); }
__device__ __forceinline__ int cvt4_f8(float a, float b, float c, float d) { int w = 0; w = __builtin_amdgcn_cvt_pk_fp8_f32(a, b, w, false); w = __builtin_amdgcn_cvt_pk_fp8_f32(c, d, w, true); return w; }
__device__ __forceinline__ void mfma8_32c(f32x16& d, const i32x8 a, const i32x8 b, const f32x16& c) { asm volatile("v_mfma_f32_32x32x64_f8f6f4 %0, %1, %2, %3" : "=&v"(d) : "v"(a), "v"(b), "v"(c)); }
__device__ __forceinline__ void kfrag8(i32x8 (&kf)[4], const LAS char* Ks, int r32, int hi) {
  const int x0 = r32 & 7; const LAS char* k0 = Ks + r32 * 128; const LAS char* k1 = k0 + 32 * 128;
#define KF8(kp, s) cat8(*reinterpret_cast<const LAS i32x4*>((kp) + (((4 * (s) + 2 * hi) ^ x0) << 4)), *reinterpret_cast<const LAS i32x4*>((kp) + (((4 * (s) + 2 * hi + 1) ^ x0) << 4)))
  kf[0] = KF8(k0, 0); kf[1] = KF8(k1, 0); kf[2] = KF8(k0, 1); kf[3] = KF8(k1, 1);
#undef KF8
}
__device__ __forceinline__ void qkmma8(f32x16& p0, f32x16& p1, const i32x8 (&kf)[4], const i32x8 (&q8)[2], const f32x16& init) {
  mfma8_32c(p0, kf[0], q8[0], init); mfma8_32c(p1, kf[1], q8[0], init); mfma8_32(p0, kf[2], q8[1]); mfma8_32(p1, kf[3], q8[1]);
}
__device__ __forceinline__ void qkt8(f32x16& p0, f32x16& p1, const LAS char* Ks, const i32x8 (&q8)[2], int r32, int hi, const f32x16& init) {
  i32x8 kf[4]; kfrag8(kf, Ks, r32, hi); qkmma8(p0, p1, kf, q8, init);
}
__device__ __forceinline__ void finishSM8(f32x16& p0, f32x16& p1, float& l_reg, i32x8& pf) {
#pragma unroll
  for (int r = 0; r < 16; ++r) p1[r] = __builtin_amdgcn_exp2f(p1[r]);
  float ps = 0;
#pragma unroll
  for (int r = 0; r < 16; ++r) ps += p0[r];
#pragma unroll
  for (int r = 0; r < 16; ++r) ps += p1[r];
  { auto rr = __builtin_amdgcn_permlane32_swap(__float_as_uint(ps), __float_as_uint(ps), false, false);
    ps = __uint_as_float(rr[0]) + __uint_as_float(rr[1]); }
  l_reg += ps;
#pragma unroll
  for (int i = 0; i < 4; ++i) { pf[i] = cvt4_f8(p0[4 * i], p0[4 * i + 1], p0[4 * i + 2], p0[4 * i + 3]); pf[4 + i] = cvt4_f8(p1[4 * i], p1[4 * i + 1], p1[4 * i + 2], p1[4 * i + 3]); }
}
__device__ __forceinline__ void vfrag8(i32x8 (&vf)[4], const LAS char* Vs, int r32, int hi) {
  const int xs = (r32 >> 1) & 3; const LAS char* vp = Vs + r32 * 64;
#pragma unroll
  for (int d0 = 0; d0 < 4; ++d0) vf[d0] = cat8(*reinterpret_cast<const LAS i32x4*>(vp + d0 * 2048 + (((2 * hi) ^ xs) << 4)), *reinterpret_cast<const LAS i32x4*>(vp + d0 * 2048 + (((2 * hi + 1) ^ xs) << 4)));
}
__device__ __forceinline__ void pvmma8(f32x16* o, const i32x8 (&vf)[4], const i32x8 pf) {
#pragma unroll
  for (int d0 = 0; d0 < 4; ++d0) mfma8_32(o[d0], pf, vf[d0]);
}
__device__ __forceinline__ void pv8(f32x16* o, const LAS char* Vs, const i32x8 pf, int r32, int hi) { i32x8 vf[4]; vfrag8(vf, Vs, r32, hi); pvmma8(o, vf, pf); }
template <int MODE> __device__ __forceinline__ void attn_unit_c8(const AUnit& u, const bf16_t* __restrict__ P, const unsigned char* __restrict__ Kh, const unsigned char* __restrict__ Vh, const float* __restrict__ qn, bf16_t* __restrict__ O, LAS char* lds) {
  int tid = threadIdx.x; asm volatile("" : "+v"(tid));
  const int wid = tid >> 6, lane = tid & 63, r32 = lane & 31, hi = lane >> 5;
  const int wv = __builtin_amdgcn_readfirstlane(tid >> 6);
  LAS char* V_lds = lds; LAS char* K_lds = lds + 6 * SHM8;
  LAS float* li_l = (LAS float*)(lds + 12 * SHM8) + wid * 64;
  float m_reg = -1e30f, l_reg = 0; f32x16 o[4] = {}; i32x8 q8[2];
  if constexpr (MODE != 0) {
    const bf16_t* Qw = P + (size_t)(u.qrow0 + wid * QBLK + r32) * LDP + u.qcol + hi * 32; constexpr float C = SCALE * 1.4426950408889634f;
#pragma unroll
    for (int s = 0; s < 2; ++s)
#pragma unroll
      for (int c = 0; c < 4; ++c) { const u32x4 w = *reinterpret_cast<const u32x4*>(Qw + s * 64 + c * 8);
        q8[s][2 * c] = cvt4_f8(bflo(w.x) * C, bfhi(w.x) * C, bflo(w.y) * C, bfhi(w.y) * C); q8[s][2 * c + 1] = cvt4_f8(bflo(w.z) * C, bfhi(w.z) * C, bflo(w.w) * C, bfhi(w.w) * C); }
  } else
  { const bf16_t* Qw = P + (size_t)(u.qrow0 + wid * QBLK + r32) * LDP + u.qcol + hi * 16; constexpr float C = SCALE * 1.4426950408889634f;
    float xa[2][16], xb[2][16]; float ss = 0.f;
#pragma unroll
    for (int s = 0; s < 2; ++s)
#pragma unroll
      for (int c = 0; c < 2; ++c) { const u32x4 wa = *reinterpret_cast<const u32x4*>(Qw + s * 64 + c * 8), wb = *reinterpret_cast<const u32x4*>(Qw + s * 64 + 32 + c * 8);
        xa[s][8 * c + 0] = bflo(wa.x); xa[s][8 * c + 1] = bfhi(wa.x); xa[s][8 * c + 2] = bflo(wa.y); xa[s][8 * c + 3] = bfhi(wa.y); xa[s][8 * c + 4] = bflo(wa.z); xa[s][8 * c + 5] = bfhi(wa.z); xa[s][8 * c + 6] = bflo(wa.w); xa[s][8 * c + 7] = bfhi(wa.w);
        xb[s][8 * c + 0] = bflo(wb.x); xb[s][8 * c + 1] = bfhi(wb.x); xb[s][8 * c + 2] = bflo(wb.y); xb[s][8 * c + 3] = bfhi(wb.y); xb[s][8 * c + 4] = bflo(wb.z); xb[s][8 * c + 5] = bfhi(wb.z); xb[s][8 * c + 6] = bflo(wb.w); xb[s][8 * c + 7] = bfhi(wb.w); }
#pragma unroll
    for (int s = 0; s < 2; ++s)
#pragma unroll
      for (int j = 0; j < 16; ++j) ss += xa[s][j] * xa[s][j] + xb[s][j] * xb[s][j];
    { auto rr = __builtin_amdgcn_permlane32_swap(__float_as_uint(ss), __float_as_uint(ss), false, false); ss = __uint_as_float(rr[0]) + __uint_as_float(rr[1]); }
    const float rq = rsqrtf(ss * (1.f / 128.f) + EPS) * C;
    const int pos = u.pa + wid * QBLK + r32;
#pragma unroll
    for (int s = 0; s < 2; ++s) { const float pp = (float)(s == 0 ? (pos >> 6) : (pos & 63));
#pragma unroll
      for (int j = 0; j < 16; ++j) { const float ga = qn[64 * s + 16 * hi + j], gb = qn[64 * s + 32 + 16 * hi + j];
        const float ang = pp * exp2f(-(float)(16 * hi + j) * (13.287712379549449f / 32.f)); const float cs_ = __cosf(ang), sn_ = __sinf(ang);
        const float a = xa[s][j] * rq * ga, b = xb[s][j] * rq * gb; xa[s][j] = a * cs_ - b * sn_; xb[s][j] = b * cs_ + a * sn_; }
#pragma unroll
      for (int i = 0; i < 4; ++i) { q8[s][i] = cvt4_f8(xa[s][4 * i], xa[s][4 * i + 1], xa[s][4 * i + 2], xa[s][4 * i + 3]); q8[s][4 + i] = cvt4_f8(xb[s][4 * i], xb[s][4 * i + 1], xb[s][4 * i + 2], xb[s][4 * i + 3]); } } }
  const unsigned koff = (unsigned)((tid >> 3) * 128 + (((tid & 7) ^ ((tid >> 3) & 7)) << 4));
  const unsigned voff = (unsigned)((tid >> 2) * 64 + (((tid & 3) ^ ((tid >> 3) & 3)) << 4));
#define GLDS(gp, lp) __builtin_amdgcn_global_load_lds((const unsigned*)(gp), (LAS unsigned*)(lp), 16, 0, 0)
  const int tb = MODE == 1 ? (u.seg2row >> 6) - 4 : 0;
#define DMA8(ss_, j_) do { _Pragma("unroll") for (int _h = 0; _h < 2; ++_h) { const int _j = (j_) + _h, _t = _j < 4 ? _j : _j + tb; \
    GLDS(Kh + (size_t)_t * 8192 + koff, K_lds + ((ss_) * 2 + _h) * SHM8 + wv * 1024); GLDS(Vh + (size_t)_t * 8192 + voff, V_lds + ((ss_) * 2 + _h) * SHM8 + wv * 1024); } } while (0)
#define MASK8(p0_, p1_, j_) do { if constexpr (MODE == 1) mask_tile<1>(p0_, p1_, u, (j_), wid, r32, hi, (const LAS float*)nullptr); } while (0)
#define DWAIT() asm volatile("s_waitcnt vmcnt(0)" ::: "memory")
#define EXP16(p_) do { _Pragma("unroll") for (int r = 0; r < 16; ++r) p_[r] = __builtin_amdgcn_exp2f(p_[r]); } while (0)
  f32x16 pA0, pA1, pB0, pB1, acc0 = {}; i32x8 pf; const int NT = u.NT;
  DMA8(0, 0); DMA8(1, 2); DWAIT(); __syncthreads();
  qkt8(pA0, pA1, K_lds, q8, r32, hi, acc0);
  asm volatile("s_nop 7\n\ts_nop 7\n\ts_nop 7\n\ts_nop 7\n\ts_nop 7\n\ts_nop 7" : "+v"(pA0), "+v"(pA1));
  firstSM(pA0, pA1, m_reg);
#pragma unroll
  for (int r = 0; r < 16; ++r) acc0[r] = -m_reg;
  int s0 = 0, s1 = 1, s2 = 2;
  for (int j = 1; j + 1 < NT; j += 2) {
    if (j + 3 < NT) DMA8(s2, j + 3);
    { i32x8 vf[4]; SBAR(); { i32x8 kf[4]; kfrag8(kf, K_lds + (s0 * 2 + 1) * SHM8, r32, hi); qkmma8(pB0, pB1, kf, q8, acc0); }
      vfrag8(vf, V_lds + (s0 * 2) * SHM8, r32, hi);
      finishSM8(pA0, pA1, l_reg, pf); SBAR();
      pvmma8(o, vf, pf); }
    MASK8(pB0, pB1, j); EXP16(pB0);
    { i32x8 vf[4]; SBAR(); { i32x8 kf[4]; kfrag8(kf, K_lds + (s1 * 2) * SHM8, r32, hi); qkmma8(pA0, pA1, kf, q8, acc0); }
      vfrag8(vf, V_lds + (s0 * 2 + 1) * SHM8, r32, hi);
      finishSM8(pB0, pB1, l_reg, pf); SBAR();
      pvmma8(o, vf, pf); }
    MASK8(pA0, pA1, j + 1); EXP16(pA0);
    DWAIT(); __syncthreads();
    { const int t_ = s0; s0 = s1; s1 = s2; s2 = t_; }
  }
  SBAR(); qkt8(pB0, pB1, K_lds + (s0 * 2 + 1) * SHM8, q8, r32, hi, acc0);
  finishSM8(pA0, pA1, l_reg, pf); SBAR();
  pv8(o, V_lds + (s0 * 2) * SHM8, pf, r32, hi);
  MASK8(pB0, pB1, NT - 1); EXP16(pB0);
  finishSM8(pB0, pB1, l_reg, pf); SBAR();
  pv8(o, V_lds + (s0 * 2 + 1) * SHM8, pf, r32, hi);
  asm volatile("s_nop 7\n\ts_nop 7\n\ts_nop 7\n\ts_nop 7\n\ts_nop 7\n\ts_nop 7" : "+v"(o[0]), "+v"(o[1]), "+v"(o[2]), "+v"(o[3]));
  if (MODE == 1 && u.has_sink) l_reg += __builtin_amdgcn_exp2f(u.sink * 1.4426950408889634f - m_reg);
  if (hi == 0) li_l[r32] = l_reg; asm volatile("s_waitcnt lgkmcnt(0)" ::: "memory");
  float rli[16];
#pragma unroll
  for (int r = 0; r < 16; ++r) rli[r] = __builtin_amdgcn_rcpf(li_l[crow(r, hi)]);
  if constexpr (MODE == 3) { float* Ow = reinterpret_cast<float*>(O) + (size_t)(u.qrow0 + wid * QBLK) * DM + u.ocol;
#pragma unroll
    for (int r = 0; r < 16; ++r) { const int orow = crow(r, hi);
#pragma unroll
      for (int d0 = 0; d0 < 4; ++d0) Ow[(size_t)orow * DM + d0 * 32 + r32] = o[d0][r] * rli[r]; }
  } else
  if constexpr (MODE == 1) { bf16_t* Ow = O + (size_t)(u.qrow0 + wid * QBLK) * DM + u.ocol;
#pragma unroll
    for (int r = 0; r < 16; ++r) { const int orow = crow(r, hi);
#pragma unroll
      for (int d0 = 0; d0 < 4; ++d0) { const float v = o[d0][r] * rli[r]; Ow[(size_t)orow * DM + d0 * 32 + r32] = (bf16_t)(cvtpk(v, v) & 0xffffu); } }
  } else
  store_o8(reinterpret_cast<unsigned char*>(O) + (size_t)(u.qrow0 + wid * QBLK) * DM + u.ocol, o, rli, r32, hi);
  __syncthreads();
#undef GLDS
#undef DMA8
#undef MASK8
#undef DWAIT
#undef EXP16
}
__device__ __forceinline__ void attn_unit_b(const AUnit& u, const bf16_t* __restrict__ P, float* __restrict__ OB, LAS char* lds) {
  int tid = threadIdx.x; asm volatile("" : "+v"(tid));
  const int lane = tid & 63, r32 = lane & 31, hi = lane >> 5;
  const int wv = __builtin_amdgcn_readfirstlane(tid >> 6), rg = wv & 3, kh = wv >> 2;
  LAS char* K_lds = lds; LAS char* V_lds = lds + 2 * SHM_K;
  LAS char* Pex = lds + 2 * SHM_K + 4 * SHM_V;
  LAS float* st = (LAS float*)(lds + 2 * SHM_K + 4 * SHM_V + 2 * 8 * 2048);
  f32x16 o[4] = {}; bf16x8 qr[8];
  { const bf16_t* Qw = P + (size_t)(u.qrow0 + rg * QBLK + r32) * LDP + u.qcol + hi * 8; constexpr float C = SCALE * 1.4426950408889634f;
#pragma unroll
    for (int d0 = 0; d0 < 8; ++d0) { const u32x4 w = __builtin_bit_cast(u32x4, *reinterpret_cast<const bf16x8*>(Qw + d0 * 16)); u32x4 o_;
      o_.x = cvtpk(bflo(w.x) * C, bfhi(w.x) * C); o_.y = cvtpk(bflo(w.y) * C, bfhi(w.y) * C); o_.z = cvtpk(bflo(w.z) * C, bfhi(w.z) * C); o_.w = cvtpk(bflo(w.w) * C, bfhi(w.w) * C);
      qr[d0] = __builtin_bit_cast(bf16x8, o_); } }
  const char* Kh = (const char*)(P + (size_t)u.kbase * LDP + u.kcol); const char* Vh = (const char*)(P + (size_t)u.kbase * LDP + u.vcol);
  const unsigned koff0 = (unsigned)((tid >> 4) * (LDP * 2)) + (unsigned)(((tid & 15) * 16) ^ (((tid >> 4) & 7) << 4));
  const int vs_ = tid >> 5, vkk = (vs_ >> 2) * 8 + ((tid & 31) >> 2), vk0 = (vkk & ~0xC) | ((vkk & 4) << 1) | ((vkk & 8) >> 1), vc0 = (vs_ & 3) * 32 + (tid & 3) * 8;
  const unsigned voff0 = (unsigned)(vk0 * (LDP * 2)) + (unsigned)(vc0 * 2);
  constexpr unsigned RS32 = 32u * LDP * 2u;
  const int vrd = (int)(unsigned)(uintptr_t)V_lds + kh * (int)SHM_V + v_rd_base(lane);
#define GLDS(gp, lp) __builtin_amdgcn_global_load_lds((const unsigned*)(gp), (LAS unsigned*)(lp), 16, 0, 0)
#define DMAK(slot, k0) do { const size_t _kb = (size_t)(k0) * (LDP * 2); LAS char* _kd = K_lds + (slot) * SHM_K + wv * 1024; GLDS(Kh + _kb + koff0, _kd); GLDS(Kh + _kb + koff0 + RS32, _kd + 8192); } while (0)
#define DMAV(slot, k0) do { const size_t _kb = (size_t)(k0) * (LDP * 2); LAS char* _vd = V_lds + (slot) * (2 * SHM_V) + wv * 1024; \
    GLDS(Vh + _kb + voff0, _vd); GLDS(Vh + _kb + voff0 + RS32, _vd + 8192); GLDS(Vh + _kb + voff0 + 256, _vd + SHM_V); GLDS(Vh + _kb + voff0 + RS32 + 256, _vd + SHM_V + 8192); } while (0)
#define DWAIT() asm volatile("s_waitcnt vmcnt(0)" ::: "memory")
#define LWAIT() asm volatile("s_waitcnt lgkmcnt(0)" ::: "memory")
#define QKH(s_, ks, init_) do { f32x16 _s1 = {}; s_ = init_; const LAS char* _K = K_lds + (ks) * SHM_K; bf16x8 _kf[8]; \
    _Pragma("unroll") for (int d0 = 0; d0 < 8; ++d0) _kf[d0] = *reinterpret_cast<const LAS bf16x8*>(_K + KSWZ(kh * 32 + r32, (d0 * 16 + hi * 8) * 2)); \
    _Pragma("unroll") for (int d0 = 0; d0 < 8; d0 += 2) { s_ = __builtin_amdgcn_mfma_f32_32x32x16_bf16(_kf[d0], qr[d0], s_, 0, 0, 0); _s1 = __builtin_amdgcn_mfma_f32_32x32x16_bf16(_kf[d0 + 1], qr[d0 + 1], _s1, 0, 0, 0); } \
    _Pragma("unroll") for (int r = 0; r < 16; ++r) s_[r] += _s1[r]; } while (0)
#define PK4(Pv, BASE, OUT) do { unsigned a0 = cvtpk(Pv[BASE + 0], Pv[BASE + 1]), a1 = cvtpk(Pv[BASE + 2], Pv[BASE + 3]);   \
    unsigned b0 = cvtpk(Pv[BASE + 4], Pv[BASE + 5]), b1 = cvtpk(Pv[BASE + 6], Pv[BASE + 7]);                              \
    auto r0 = __builtin_amdgcn_permlane32_swap(a0, b0, false, false); auto r1 = __builtin_amdgcn_permlane32_swap(a1, b1, false, false); \
    u32x4 w = {r0[0], r1[0], r0[1], r1[1]}; OUT = *reinterpret_cast<bf16x8*>(&w); } while (0)
#define SOFT_PUB(s_, f0_, f1_, par) do { _Pragma("unroll") for (int r = 0; r < 16; ++r) { s_[r] = __builtin_amdgcn_exp2f(s_[r]); lsum += s_[r]; } \
    PK4(s_, 0, f0_); PK4(s_, 8, f1_); LAS char* _px = Pex + (par) * 16384 + wv * 2048 + lane * 16; *(LAS bf16x8*)_px = f0_; *(LAS bf16x8*)(_px + 1024) = f1_; } while (0)
  const int NT = u.NT; float lsum = 0.f; bf16x8 own0, own1; f32x16 sc, acc0 = {};
  DMAK(0, 0); DMAV(0, 0); DMAK(1, 64); DWAIT(); __syncthreads();
  QKH(sc, 0, acc0);
  { float pmax = sc[0];
#pragma unroll
    for (int r = 1; r < 16; ++r) pmax = fmaxf(pmax, sc[r]);
    { auto rr = __builtin_amdgcn_permlane32_swap(__float_as_uint(pmax), __float_as_uint(pmax), false, false); pmax = fmaxf(__uint_as_float(rr[0]), __uint_as_float(rr[1])); }
    if (hi == 0) st[wv * 64 + r32] = pmax; LWAIT(); __syncthreads();
    const float mref = fmaxf(pmax, st[(wv ^ 4) * 64 + r32]); LWAIT();
#pragma unroll
    for (int r = 0; r < 16; ++r) { acc0[r] = -mref; sc[r] -= mref; } }
  SOFT_PUB(sc, own0, own1, 0);
  LWAIT(); __syncthreads();
  for (int j = 0; j < NT; ++j) {
    if (j + 2 < NT) DMAK(j & 1, (j + 2) * 64);
    if (j + 1 < NT) DMAV((j + 1) & 1, (j + 1) * 64);
    const LAS char* _pq = Pex + (j & 1) * 16384 + (wv ^ 4) * 2048 + lane * 16;
    const bf16x8 q0 = *(const LAS bf16x8*)_pq, q1 = *(const LAS bf16x8*)(_pq + 1024);
    const bf16x8 pa0 = kh ? q0 : own0, pa1 = kh ? q1 : own1, pa2 = kh ? own0 : q0, pa3 = kh ? own1 : q1;
    pv_d0(o, vrd + (j & 1) * (2 * (int)SHM_V), pa0, pa1, pa2, pa3);
    if (j + 1 < NT) { QKH(sc, (j + 1) & 1, acc0); SOFT_PUB(sc, own0, own1, (j + 1) & 1); }
    LWAIT(); DWAIT(); __syncthreads();
  }
  { auto rr = __builtin_amdgcn_permlane32_swap(__float_as_uint(lsum), __float_as_uint(lsum), false, false); lsum = __uint_as_float(rr[0]) + __uint_as_float(rr[1]); }
  if (hi == 0) st[wv * 64 + r32] = lsum; LWAIT(); __syncthreads();
  float rli[16];
#pragma unroll
  for (int r = 0; r < 16; ++r) rli[r] = __builtin_amdgcn_rcpf(st[wv * 64 + crow(r, hi)] + st[(wv ^ 4) * 64 + crow(r, hi)]);
  float* Ow = OB + (size_t)(u.qrow0 + rg * QBLK) * DM + u.ocol + kh * 128;
#pragma unroll
  for (int r = 0; r < 16; ++r) { const int orow = crow(r, hi);
#pragma unroll
    for (int d0 = 0; d0 < 4; ++d0) Ow[(size_t)orow * DM + d0 * 32 + r32] = o[d0][r] * rli[r]; }
  LWAIT(); __syncthreads();
#undef GLDS
#undef DMAK
#undef DMAV
#undef DWAIT
#undef LWAIT
#undef QKH
#undef PK4
#undef SOFT_PUB
}
}

struct Ctx {
    LAS unsigned char* lds; int tid, lane, wave, G, bid, gw, NGW;
    float* mod; float* affl; float* affc; int* rows; float* gate; int* slot; float* xc; float* sax; float* sah; float* sas; float* wsc; float* shd; signed char* hid8; float* so; signed char* o8; bf16_t* dlt;
    bf16_t *win, *wout, *wgu, *wdn, *r1, *r2, *hid, *y; float* ob; unsigned char* y8; unsigned char* k8; unsigned char* v8; unsigned char* k8d; unsigned char* v8d;
};

__device__ __forceinline__ Ctx make_ctx(const Params& p, LAS unsigned char* lds) {
    Ctx F; int tid = threadIdx.x; asm volatile("" : "+v"(tid));
    unsigned long long wsb = (unsigned long long)p.ws; asm volatile("" : "+s"(wsb)); __attribute__((address_space(1))) unsigned char* ws = (__attribute__((address_space(1))) unsigned char*)wsb;
    int bid = blockIdx.x; asm volatile("" : "+s"(bid));
    F.lds = lds; F.tid = tid; F.lane = tid & 63; F.wave = __builtin_amdgcn_readfirstlane(tid >> 6);
    F.G = gridDim.x; F.bid = bid; F.gw = bid * NWAVES + F.wave; F.NGW = F.G * NWAVES;
    F.mod = (float*)(ws + WS_MOD); F.affl = (float*)(ws + WS_AFFL); F.affc = (float*)(ws + WS_AFFC); F.rows = (int*)(ws + WS_ROWS); F.gate = (float*)(ws + WS_GATE);
    F.slot = (int*)(ws + WS_SLOT); F.xc = (float*)(ws + WS_XC); F.sax = (float*)(ws + WS_SAX); F.sah = (float*)(ws + WS_SAH); F.sas = (float*)(ws + WS_SAS); F.wsc = (float*)(ws + WS_WSC); F.shd = (float*)(ws + WS_SHD); F.hid8 = (signed char*)(ws + WS_R2 + 204 * MiB); F.so = (float*)(ws + WS_SO); F.o8 = (signed char*)(ws + WS_R3); F.dlt = (bf16_t*)(ws + WS_DLT);
    F.win = (bf16_t*)(ws + WS_WIN); F.wout = (bf16_t*)(ws + WS_WOUT); F.wgu = (bf16_t*)(ws + WS_WGU); F.wdn = (bf16_t*)(ws + WS_WDN);
    F.r1 = (bf16_t*)(ws + WS_R1); F.r2 = (bf16_t*)(ws + WS_R2); F.hid = (bf16_t*)(ws + WS_R2); F.y = (bf16_t*)(ws + WS_R3); F.y8 = (unsigned char*)(ws + WS_R3); F.k8 = (unsigned char*)(ws + WS_K8); F.v8 = (unsigned char*)(ws + WS_V8); F.k8d = (unsigned char*)(ws + WS_K8D); F.v8d = (unsigned char*)(ws + WS_V8D); F.ob = (float*)(ws + WS_R3);
    return F;
}
__device__ __forceinline__ void transpose_item_i8(const float* __restrict__ src, int K, int N, signed char* __restrict__ dst, int rs, int roff, LAS float* scr, int idx, int lane, const float inv, const bool f8 = false) {
    const int nblk = N >> 6, kb = idx / nblk, nb = idx - kb * nblk, k0 = kb * 64, n0 = nb * 64;
    const int kr = lane >> 4, nc = (lane & 15) * 4;
    const float* s = src + (size_t)(k0 + kr) * N + n0 + nc;
    f32x4 v[16];
#pragma unroll
    for (int i = 0; i < 16; ++i) v[i] = __builtin_nontemporal_load((const f32x4*)(s + (size_t)(4 * i) * N));
#pragma unroll
    for (int i = 0; i < 16; ++i) { LAS float* q = scr + (kr + 4 * i) * 65 + nc; q[0] = v[i].x; q[1] = v[i].y; q[2] = v[i].z; q[3] = v[i].w; }
    LDS_WAIT();
    const int c = lane & 3;
#pragma unroll
    for (int j = 0; j < 4; ++j) { const int n = (lane >> 2) + 16 * j; const LAS float* q = scr + (16 * c) * 65 + n;
        u32x4 o; o.x = pack_q4(q[0], q[65], q[130], q[195], inv, f8); o.y = pack_q4(q[260], q[325], q[390], q[455], inv, f8);
        o.z = pack_q4(q[520], q[585], q[650], q[715], inv, f8); o.w = pack_q4(q[780], q[845], q[910], q[975], inv, f8);
        const int ng = n0 + n; int row;
        if (rs > 0) row = (ng >> 2) * rs + roff + (ng & 3);
        else { const bool roped = ng < 1280 || (ng >= 1536 && ng < 3584); const int d = ng & 127;
            row = roped ? (ng & ~127) + (d & 64) + ((d & 31) >> 2) * 8 + ((d >> 5) & 1) * 4 + (d & 3) : ng; }
        *(u32x4*)(dst + (size_t)row * K + k0 + 16 * c) = o; }
    LDS_WAIT();
}
#ifndef CV_INTERLEAVE
#define CV_INTERLEAVE 1
#endif
constexpr int CV_IN = 32 * 72, CV_OUT = 32 * 32, CV_E = 768, CV_PER_L = CV_IN + CV_OUT + 3 * NEXP * CV_E, CV_TOTAL = 2 * CV_PER_L, CV_FIRST = CV_INTERLEAVE ? CV_IN : CV_TOTAL;
__device__ __forceinline__ void conv_item(const Params& p, const Ctx& F, LAS float* scr, const int it, const int lane) {
    const int l = it / CV_PER_L; int r = it - l * CV_PER_L;
    if (r < CV_IN) { transpose_item_i8(p.w_in + (size_t)l * DM * INW, DM, INW, (signed char*)F.win + (size_t)l * INW * DM, l == 0 ? -1 : 4, 0, scr, r, lane, 1.f / F.wsc[l]); return; } r -= CV_IN;
    if (r < CV_OUT) { transpose_item_i8(p.w_out + (size_t)l * DM * DM, DM, DM, (signed char*)F.wout + (size_t)l * DM * DM, 4, 0, scr, r, lane, 1.f / F.wsc[98 + l], l == 1); return; } r -= CV_OUT;
    const int ty = r / (NEXP * CV_E), e = (r % (NEXP * CV_E)) / CV_E, idx = r % CV_E; const size_t le = (size_t)l * NEXP + e;
    if (ty == 0) transpose_item_i8(p.w_gate + le * DM * DEXP, DM, DEXP, (signed char*)F.wgu + le * 3072 * DM, 8, 0, scr, idx, lane, 1.f / F.wsc[2 + 2 * le]);
    else if (ty == 1) transpose_item_i8(p.w_up + le * DM * DEXP, DM, DEXP, (signed char*)F.wgu + le * 3072 * DM, 8, 4, scr, idx, lane, 1.f / F.wsc[3 + 2 * le]);
    else transpose_item_i8(p.w_down + le * DEXP * DM, DEXP, DM, (signed char*)F.wdn + le * DM * DEXP, 4, 0, scr, idx, lane, 1.f / F.wsc[66 + le], true);
}

__device__ __forceinline__ void conv_some(const Params& p, const Ctx& F, int& cv_it, const int k) {
    int t2 = threadIdx.x; asm volatile("" : "+v"(t2));
    const int lane = t2 & 63, wave = __builtin_amdgcn_readfirstlane(t2 >> 6);
    LAS float* scr = (LAS float*)(F.lds + wave * 16640);
    for (int q = 0; q < k && cv_it < CV_TOTAL; ++q, cv_it += F.NGW) conv_item(p, F, scr, cv_it, lane);
}

__device__ __forceinline__ void phase_prologue(const Params& p, const Ctx& F) {
    for (int item = F.bid; item < 192; item += F.G) {
        LAS float* sl = (LAS float*)F.lds; LAS float* red = (LAS float*)(F.lds + 73728);
        for (int i = F.tid; i < 9 * DM; i += NTHR) { const int r = i >> 11, d = i & 2047; const float v = r < 8 ? p.c[r * DM + d] : p.c_ctx[d]; sl[i] = silu_f(v); }
        __syncthreads();
        const int l = item / 96, cb = item % 96;
        const float* W = p.w_ada + ((size_t)l * DM + F.wave * 256) * MODW + cb * 128 + 2 * F.lane;
        float a0[9], a1[9];
#pragma unroll
        for (int r = 0; r < 9; ++r) { a0[r] = 0.f; a1[r] = 0.f; }
#pragma unroll 8
        for (int d = 0; d < 256; ++d) { const f32x2 w = *(const f32x2*)(W + (size_t)d * MODW);
#pragma unroll
            for (int r = 0; r < 9; ++r) { const float s = sl[r * DM + F.wave * 256 + d]; a0[r] += s * w.x; a1[r] += s * w.y; } }
#pragma unroll
        for (int r = 0; r < 9; ++r) { red[(F.wave * 9 + r) * 128 + 2 * F.lane] = a0[r]; red[(F.wave * 9 + r) * 128 + 2 * F.lane + 1] = a1[r]; }
        __syncthreads();
        for (int i = F.tid; i < 9 * 128; i += NTHR) { const int r = i >> 7, cc = i & 127; float s = p.b_ada[l * MODW + cb * 128 + cc];
#pragma unroll
            for (int w = 0; w < 8; ++w) s += red[(w * 9 + r) * 128 + cc];
            F.mod[(size_t)(l * 9 + r) * MODW + cb * 128 + cc] = s; }
        __syncthreads();
    }
    for (int m = F.bid; m < 100; m += F.G) {
        LAS float* red = (LAS float*)F.lds;
        const float* W; int N;
        if (m < 2) { W = p.w_in + (size_t)m * DM * INW; N = INW; }
        else if (m >= 98) { W = p.w_out + (size_t)(m - 98) * DM * DM; N = DM; }
        else if (m >= 66) { W = p.w_down + (size_t)(m - 66) * DEXP * DM; N = DM; }
        else { const int le = (m - 2) >> 1; W = ((m & 1) ? p.w_up : p.w_gate) + (size_t)le * DM * DEXP; N = DEXP; }
        float ss = 0.f;
        for (int i = F.tid; i < 8 * N; i += NTHR) { const float v = W[i]; ss += v * v; }
        ss = wave_sum(ss);
        if (F.lane == 0) red[F.wave] = ss;
        __syncthreads();
        if (F.tid == 0) { float t = 0.f;
#pragma unroll
            for (int w = 0; w < 8; ++w) t += red[w];
            F.wsc[m] = fmaxf(6.0f * sqrtf(t / (float)(8 * N)) * (1.f / 127.f), 1e-30f); }
        __syncthreads();
    }
}

__device__ __forceinline__ void row_ptrs(const Params& p, const Ctx& F, const int l, const int b, const int t, const float*& xs, float*& xd) {
    const unsigned long long blat = (l <= 1) ? (unsigned long long)p.x : (unsigned long long)p.out, bctx = (l <= 1) ? (unsigned long long)p.ctx : (unsigned long long)F.xc;
    const bool isctx = t < CTXL;
    const size_t roff = isctx ? ((size_t)b * CTXL + t) * DM : ((size_t)b * SEQ + (t - CTXL)) * DM;
    xs = (const float*)(isctx ? bctx : blat) + roff;
    xd = (isctx ? F.xc : p.out) + roff;
}
__device__ __forceinline__ void gather_y1(const Ctx& F, const int s, f32x4 (&acc)[8]) {
#pragma unroll
    for (int j = 0; j < 8; ++j) acc[j] = (f32x4){0.f, 0.f, 0.f, 0.f};
#pragma unroll 2
    for (int e = 0; e < 16; ++e) { const int se = __builtin_amdgcn_readlane(s, e);
        if (se >= 0) { const unsigned char* yr = F.y8 + (size_t)se * DM + 4 * F.lane;
#pragma unroll
            for (int j = 0; j < 8; ++j) { const unsigned w = __builtin_nontemporal_load((const unsigned*)(yr + 256 * j)); acc[j] += unpack_f8x4(w); } } }
}
__device__ __forceinline__ void gather_y(const Ctx& F, const int s, f32x4 (&acc)[8]) {
#pragma unroll
    for (int j = 0; j < 8; ++j) acc[j] = (f32x4){0.f, 0.f, 0.f, 0.f};
    unsigned m = (unsigned)__ballot(s >= 0) & 0xffffu;
    while (m) {
        const int e0 = __builtin_ctz(m); m &= m - 1;
        const bool two = m != 0; const int e1 = two ? __builtin_ctz(m) : e0; if (two) m &= m - 1;
        const int s0 = __builtin_amdgcn_readlane(s, e0), s1 = __builtin_amdgcn_readlane(s, e1);
        const unsigned char* y0 = F.y8 + (size_t)s0 * DM + 4 * F.lane; const unsigned char* y1 = F.y8 + (size_t)s1 * DM + 4 * F.lane;
        unsigned w0[8], w1[8];
#pragma unroll
        for (int j = 0; j < 8; ++j) w0[j] = __builtin_nontemporal_load((const unsigned*)(y0 + 256 * j));
#pragma unroll
        for (int j = 0; j < 8; ++j) w1[j] = __builtin_nontemporal_load((const unsigned*)(y1 + 256 * j));
        const float k1 = two ? 1.f : 0.f;
#pragma unroll
        for (int j = 0; j < 8; ++j) { acc[j] += unpack_f8x4(w0[j]); acc[j] += unpack_f8x4(w1[j]) * k1; }
    }
}
__device__ __forceinline__ void phase_norm1(const Params& p, const Ctx& F, const int l) {
    const bool fin = (l == 2), comb = (l > 0);
    if (l == 0) { LAS float* scr = (LAS float*)(F.lds + F.wave * 16640); for (int it = F.gw; it < CV_FIRST; it += F.NGW) conv_item(p, F, scr, it, F.lane); }
    const int b = F.gw & 7, tstride = F.NGW >> 3;
    int cur_m = -1; f32x4 A[8], Bv[8];
    int t = F.gw >> 3; if (fin) { while (t < CTXL) t += tstride; }
    f32x4 vn[8], accn[8]; u32x2 dn[8]; int sn = -1;
#pragma unroll
    for (int j = 0; j < 8; ++j) dn[j] = (u32x2){0u, 0u};
#pragma unroll
    for (int j = 0; j < 8; ++j) accn[j] = (f32x4){0.f, 0.f, 0.f, 0.f};
    if (t < TPB) { const float* xs; float* xd; row_ptrs(p, F, l, b, t, xs, xd);
#pragma unroll
        for (int j = 0; j < 8; ++j) vn[j] = __builtin_nontemporal_load((const f32x4*)xs + F.lane + 64 * j);
        if (comb) {
#pragma unroll
            for (int j = 0; j < 8; ++j) dn[j] = __builtin_nontemporal_load((const u32x2*)(F.dlt + ((size_t)b * TPB + t) * DM + 4 * F.lane + 256 * j)); }
        if (comb) { int s0 = -1; if (F.lane < 16) s0 = F.slot[(unsigned)((b * 16 + F.lane) * TPB + t)]; { if (fin) gather_y1(F, s0, accn); else gather_y(F, s0, accn); }
            if (t + tstride < TPB && F.lane < 16) sn = F.slot[(unsigned)((b * 16 + F.lane) * TPB + t + tstride)]; } }
    for (; t < TPB; t += tstride) {
        const bool isctx = t < CTXL;
        const int mrow = isctx ? 8 : b;
        const float* xs; float* xd; row_ptrs(p, F, l, b, t, xs, xd);
        f32x4 v[8];
#pragma unroll
        for (int j = 0; j < 8; ++j) v[j] = vn[j] + (f32x4){bflo(dn[j].x), bfhi(dn[j].x), bflo(dn[j].y), bfhi(dn[j].y)};
        if (comb) {
            const float* gt = F.mod + (size_t)((l - 1) * 9 + mrow) * MODW + 5 * DM;
#pragma unroll
            for (int j = 0; j < 8; ++j) { v[j] += *((const f32x4*)gt + F.lane + 64 * j) * accn[j] * (1.f / Y_SCALE); if (!fin) *((f32x4*)xd + F.lane + 64 * j) = v[j]; }
        }
        { const int t2 = t + tstride;
          if (t2 < TPB) { const float* xs2; float* xd2; row_ptrs(p, F, l, b, t2, xs2, xd2);
#pragma unroll
            for (int j = 0; j < 8; ++j) vn[j] = __builtin_nontemporal_load((const f32x4*)xs2 + F.lane + 64 * j);
            if (comb) {
#pragma unroll
                for (int j = 0; j < 8; ++j) dn[j] = __builtin_nontemporal_load((const u32x2*)(F.dlt + ((size_t)b * TPB + t2) * DM + 4 * F.lane + 256 * j)); }
            if (comb) { { if (fin) gather_y1(F, sn, accn); else gather_y(F, sn, accn); } const int t3 = t2 + tstride; sn = -1; if (t3 < TPB && F.lane < 16) sn = F.slot[(unsigned)((b * 16 + F.lane) * TPB + t3)]; } } }
        if (mrow != cur_m) { cur_m = mrow;
            if (!fin) {
                const float* mr = F.mod + (size_t)(l * 9 + mrow) * MODW;
#pragma unroll
                for (int j = 0; j < 8; ++j) { const f32x4 g = *((const f32x4*)(p.g_mix + l * DM) + F.lane + 64 * j), sc = *((const f32x4*)(mr + DM) + F.lane + 64 * j);
                    A[j] = g * (sc + 1.f); Bv[j] = *((const f32x4*)mr + F.lane + 64 * j); }
            }
        }
        float ss = 0.f;
#pragma unroll
        for (int j = 0; j < 8; ++j) ss += (v[j].x * v[j].x + v[j].y * v[j].y) + (v[j].z * v[j].z + v[j].w * v[j].w);
        const float rstd = rsqrtf(wave_sum(ss) * (1.f / DM) + EPS);
        if (fin) {
#pragma unroll
            for (int j = 0; j < 8; ++j) __builtin_nontemporal_store(v[j] * rstd * *((const f32x4*)p.g_final + F.lane + 64 * j), (f32x4*)xd + F.lane + 64 * j);
        } else {
            float am = 0.f;
#pragma unroll
            for (int j = 0; j < 8; ++j) { v[j] = v[j] * rstd * A[j] + Bv[j]; am = fmaxf(am, amax4(v[j])); }
            am = fmaxf(wave_max(am), 1e-20f); const float inv = 127.f / am;
            unsigned* xn = (unsigned*)((signed char*)F.r1 + ((size_t)b * TPB + t) * DM) + F.lane;
#pragma unroll
            for (int j = 0; j < 8; ++j) __builtin_nontemporal_store(pack_i8x4(v[j].x, v[j].y, v[j].z, v[j].w, inv), xn + 64 * j);
            if (F.lane == 0) F.sax[b * TPB + t] = am * (1.f / 127.f);
        }
    }
}

__device__ __forceinline__ void v8_tiles_n(const Ctx& F, const int col0, const int nh, unsigned char* dstb) {
        for (int it = F.gw; it < NB * nh * 68; it += F.NGW) {
            const int tile = it % 68, bk = it / 68, kvh = bk % nh, b = bk / nh;
            const bf16_t* srcv = F.r2 + (size_t)(b * TPB + tile * 64) * INW + col0 + kvh * 128 + 2 * F.lane;
            unsigned w[64];
#pragma unroll
            for (int kk = 0; kk < 64; ++kk) w[kk] = *(const unsigned*)(srcv + (size_t)kk * INW);
            unsigned char* dst = dstb + (size_t)it * 8192 + F.lane * 128;
#pragma unroll
            for (int half = 0; half < 2; ++half)
#pragma unroll
                for (int q = 0; q < 4; ++q) { u32x4 o;
#pragma unroll
                    for (int a = 0; a < 4; ++a) { const int s0 = 16 * q + 4 * a, hi_ = s0 >> 5, j = s0 & 31, key = 32 * (j >> 4) + 8 * ((j >> 2) & 3) + 4 * hi_;
                        float f[4];
#pragma unroll
                        for (int i = 0; i < 4; ++i) f[i] = half ? bfhi(w[key + i]) : bflo(w[key + i]);
                        o[a] = pack_f8x4(f[0], f[1], f[2], f[3], 1.f); }
                    *(u32x4*)(dst + half * 64 + q * 16) = o; }
        }
}
__device__ __forceinline__ void v8_tiles(const Ctx& F) { v8_tiles_n(F, 1280, 2, F.v8); }
__device__ __forceinline__ void phase_qkfix(const Params& p, const Ctx& F, const int l) {
    LAS f32x2* cs = (LAS f32x2*)F.lds;
    for (int i = F.tid; i < 2048; i += NTHR) { const int pp = i >> 5, fi = i & 31; const float inv = exp2f(-(float)fi * (13.287712379549449f / 32.f)); const float ang = (float)pp * inv;
        cs[i] = (f32x2){__cosf(ang), __sinf(ang)}; }
    __syncthreads();
    const int NV = l == 0 ? 26 : 2, nrows = l == 0 ? NB * SEQ : NROWS;
    const long total = (long)nrows * NV;
    const int sub = F.lane >> 4, jl = F.lane & 15, ax = jl >> 3, f0 = (jl & 7) * 4;
    for (long V0 = (long)F.gw * 4; V0 < total; V0 += (long)F.NGW * 4) {
        const long V = V0 + sub; const bool valid = V < total; const long Vc = valid ? V : 0;
        const int rr = (int)(Vc / NV), v = (int)(Vc % NV);
        int R, pos; bool lat;
        if (l == 0) { const int b = rr >> 12, s = rr & 4095; R = b * TPB + CTXL + s; pos = s; lat = true; }
        else { R = rr; const int t = rr % TPB; lat = t >= CTXL; pos = t - CTXL; }
        const int col = l == 0 ? v * 128 + (v >= 10 ? 256 : 0) : (8 + v) * 128;
        bf16_t* ptr = F.r2 + (size_t)R * INW + col + ax * 64 + f0;
        const u32x2 wl = *(const u32x2*)ptr, wh = *(const u32x2*)(ptr + 32);
        float xl[4] = {bflo(wl.x), bfhi(wl.x), bflo(wl.y), bfhi(wl.y)}, xh[4] = {bflo(wh.x), bfhi(wh.x), bflo(wh.y), bfhi(wh.y)};
        if (l == 1) {
            float ss = 0.f;
#pragma unroll
            for (int q = 0; q < 4; ++q) ss += xl[q] * xl[q] + xh[q] * xh[q];
            ss += __shfl_xor(ss, 1); ss += __shfl_xor(ss, 2); ss += __shfl_xor(ss, 4); ss += __shfl_xor(ss, 8);
            const float rstd = rsqrtf(ss * (1.f / 128.f) + EPS);
            const float* g = p.kn + ax * 64 + f0;
#pragma unroll
            for (int q = 0; q < 4; ++q) { xl[q] = xl[q] * rstd * g[q]; xh[q] = xh[q] * rstd * g[32 + q]; }
        }
        if (lat) {
            const int pp = ax == 0 ? (pos >> 6) : (pos & 63);
#pragma unroll
            for (int q = 0; q < 4; ++q) { const f32x2 c = cs[pp * 32 + f0 + q]; const float a = xl[q], bq = xh[q]; xl[q] = a * c.x - bq * c.y; xh[q] = bq * c.x + a * c.y; }
        }
        if (valid) {
            if (l == 0) { u32x2 o; o.x = cvtpk(xl[0], xl[1]); o.y = cvtpk(xl[2], xl[3]); *(u32x2*)ptr = o; o.x = cvtpk(xh[0], xh[1]); o.y = cvtpk(xh[2], xh[3]); *(u32x2*)(ptr + 32) = o; }
            else { unsigned char* k8 = F.k8 + ((size_t)v * NROWS + R) * 128 + ax * 64 + (f0 >> 4) * 32 + (f0 & 15);
                *(unsigned*)k8 = pack_f8x4(xl[0], xl[1], xl[2], xl[3], 1.f); *(unsigned*)(k8 + 16) = pack_f8x4(xh[0], xh[1], xh[2], xh[3], 1.f); } }
    }
    if (l == 1) v8_tiles(F);
}

__device__ __forceinline__ void bfinal_tile(const Params& p, const Ctx& F, const int qrow0, const int h) {
    int t2 = threadIdx.x; asm volatile("" : "+v"(t2));
    const int lane = t2 & 63, wave = __builtin_amdgcn_readfirstlane(t2 >> 6);
    const float lam_init = 0.2f;
    float s1 = p.lq1[lane] * p.lk1[lane] + p.lq1[lane + 64] * p.lk1[lane + 64], s2 = p.lq2[lane] * p.lk2[lane] + p.lq2[lane + 64] * p.lk2[lane + 64];
    s1 = wave_sum(s1); s2 = wave_sum(s2);
    const float lam = expf(s1) - expf(s2) + lam_init;
    const int sub = lane >> 4, jl = lane & 15;
    f32x4 g[4];
#pragma unroll
    for (int q = 0; q < 4; ++q) g[q] = *(const f32x4*)(p.subln + jl * 4 + 64 * q) * (1.f - lam_init);
    for (int it = 0; it < 8; ++it) {
        const int R = qrow0 + wave * 32 + it * 4 + sub;
        const float* o1 = F.ob + (size_t)R * DM + h * 512 + jl * 4; const float* o2 = o1 + 256;
        f32x4 v[4]; float ss = 0.f;
#pragma unroll
        for (int q = 0; q < 4; ++q) { v[q] = *(const f32x4*)(o1 + 64 * q) - lam * *(const f32x4*)(o2 + 64 * q); ss += (v[q].x * v[q].x + v[q].y * v[q].y) + (v[q].z * v[q].z + v[q].w * v[q].w); }
        ss += __shfl_xor(ss, 1); ss += __shfl_xor(ss, 2); ss += __shfl_xor(ss, 4); ss += __shfl_xor(ss, 8);
        const float rstd = rsqrtf(ss * (1.f / 256.f) + EPS);
        bf16_t* o = F.r1 + (size_t)R * DM + 1024 + h * 256 + jl * 4;
#pragma unroll
        for (int q = 0; q < 4; ++q) { const f32x4 y = v[q] * rstd * g[q]; u32x2 w; w.x = cvtpk(y.x, y.y); w.y = cvtpk(y.z, y.w); *(u32x2*)(o + 64 * q) = w; }
    }
}

__device__ __forceinline__ void phase_attn(const Params& p, const Ctx& F, const int l) {
    LAS char* lds = (LAS char*)F.lds;
    if (l == 1) { LAS float* bt = (LAS float*)(lds + att::BIAS_OFF);
        for (int i = F.tid; i < 8 * 480; i += NTHR) { const int h = i / 480, rem = i % 480, ro = rem >> 5, cc = rem & 31; bt[i] = cc < 31 ? p.rpb[(h * 15 + ro) * 31 + cc] * 1.4426950408889634f : 0.f; }
        __syncthreads(); }
    const int vcu = (F.G % 8 == 0) ? (F.bid % 8) * (F.G / 8) + F.bid / 8 : F.bid;
    constexpr int CV_PER_UNIT = 3;
    int cv_it = CV_FIRST + F.gw, cv_slot = 0;
    unsigned* a8cnt = (unsigned*)(p.ws + WS_CTL) + 8192;
    {
    if (l == 0) {
        for (int su = vcu; su < 544; su += F.G) {
            const bool lat = su < 512; int b, h, qt;
            if (lat) { qt = su & 15; h = (su >> 4) & 3; b = su >> 6; } else { const int uu = su - 512; qt = 0; h = uu & 3; b = uu >> 2; }
            const int qrow0 = b * TPB + (lat ? CTXL + qt * 256 : 0);
            for (int sp = 0; sp < 4; ++sp) {
                att::AUnit u; u.mode = 0; u.pa = 0; u.pb = 0; u.head = 0; u.has_sink = 0; u.sink = 0.f; u.seg2row = CTXL; u.kbase = b * TPB; u.outf32 = 1;
                if (false) {
                    const int mp = 0, rh = sp & 1;
                    u.qrow0 = qrow0 + rh * 128; u.qcol = 1536 + h * 256 + mp * 128; u.kcol = 2560 + h * 256 + mp * 128; u.vcol = 3584 + h * 256; u.NT = 68; u.ocol = h * 512 + mp * 256;
                    att::attn_unit_b(u, F.r2, F.ob, lds);
                } else if (lat) {
                    const int vh = sp & 1, mp = sp >> 1;
                    u.qrow0 = qrow0; u.qcol = 1536 + h * 256 + mp * 128; u.NT = 68; u.ocol = h * 512 + mp * 256 + vh * 128;
                    att::attn_unit_c8<3>(u, F.r2, F.k8d + ((size_t)(h * 2 + mp) * NROWS + u.kbase) * 128, F.v8d + (size_t)(b * 8 + h * 2 + vh) * (68 * 8192), nullptr, (bf16_t*)F.ob, lds);
                } else {
                    const int mp = sp >> 1, vh = sp & 1;
                    u.qrow0 = qrow0; u.qcol = 1536 + h * 256 + mp * 128; u.NT = 4; u.ocol = h * 512 + mp * 256 + vh * 128;
                    att::attn_unit_c8<3>(u, F.r2, F.k8d + ((size_t)(h * 2 + mp) * NROWS + u.kbase) * 128, F.v8d + (size_t)(b * 8 + h * 2 + vh) * (68 * 8192), nullptr, (bf16_t*)F.ob, lds);
                }
                if (((cv_slot++ ^ vcu) & 1) == 0) { conv_some(p, F, cv_it, 2 * CV_PER_UNIT); __syncthreads(); }
            }
            VM_WAIT(); __syncthreads();
            bfinal_tile(p, F, qrow0, h);
        }
        for (int ui = vcu; ui < 64; ui += F.G) {
            att::AUnit u; u.mode = 0; u.pa = 0; u.pb = 0; u.head = 0; u.outf32 = 0; u.seg2row = CTXL;
            const int h = ui & 7, b = ui >> 3;
            u.qrow0 = b * TPB; u.kbase = b * TPB;
            u.qcol = h * 128; u.kcol = 1024 + (h >> 2) * 128; u.vcol = 1280 + (h >> 2) * 128; u.ocol = h * 128;
            u.has_sink = 1; u.sink = p.a_sink[h]; u.NT = 4;
            att::attn_unit<0, 1>(u, F.r2, F.r1, F.ob, lds);
        }
    } else {
        for (int ui = vcu; ui < 1024; ui += F.G) {
            att::AUnit u; u.mode = 0; u.pa = 0; u.pb = 0; u.head = 0; u.has_sink = 0; u.sink = 0.f; u.outf32 = 0; u.seg2row = CTXL; u.NT = 68;
            const int qt = ui & 15, h = (ui >> 4) & 7, b = ui >> 7;
            u.qrow0 = b * TPB + CTXL + qt * 256; u.kbase = b * TPB;
            u.qcol = h * 128; u.kcol = 1024 + (h >> 2) * 128; u.vcol = 1280 + (h >> 2) * 128; u.ocol = h * 128;
            u.pa = qt * 256;
            att::attn_unit_c8<0>(u, F.r2, F.k8 + ((size_t)(h >> 2) * NROWS + u.kbase) * 128, F.v8 + (size_t)(b * 2 + (h >> 2)) * (68 * 8192), p.qn, (bf16_t*)F.o8, lds);
        }
    } }
    if (l == 0) {
    for (int ui = vcu; ui < 1024; ui += F.G) {
        att::AUnit u; u.mode = 1; u.head = 0; u.outf32 = 0;
        const int qt = ui & 15, h = (ui >> 4) & 7, b = ui >> 7;
        u.qrow0 = b * TPB + CTXL + qt * 256; u.kbase = b * TPB;
        u.qcol = h * 128; u.kcol = 1024 + (h >> 2) * 128; u.vcol = 1280 + (h >> 2) * 128; u.ocol = h * 128;
        u.has_sink = 1; u.sink = p.a_sink[h];
        const int s0 = qt * 256, lo = max(0, s0 - 128), hi2 = min(SEQ, s0 + 384); u.NT = 4 + (hi2 - lo) / 64; u.seg2row = CTXL + lo; u.pa = s0; u.pb = lo;
        att::attn_unit_c8<1>(u, F.r2, F.k8 + ((size_t)(h >> 2) * NROWS + u.kbase) * 128, F.v8 + (size_t)(b * 2 + (h >> 2)) * (68 * 8192), nullptr, F.r1, lds);
        if (((cv_slot++ ^ vcu) & 1) == 0) { conv_some(p, F, cv_it, 2 * CV_PER_UNIT); __syncthreads(); }
    }
    conv_some(p, F, cv_it, 1 << 20);
    __syncthreads(); }
    else {
    for (int ui = vcu; ui < 1024; ui += F.G) {
        att::AUnit u; u.mode = 2; u.has_sink = 0; u.sink = 0.f; u.outf32 = 0;
        const int qt = ui & 15, h = (ui >> 4) & 7, b = ui >> 7;
        u.qrow0 = b * TPB + CTXL + qt * 256; u.kbase = b * TPB;
        u.qcol = 1536 + h * 128; u.kcol = 2560 + h * 128; u.vcol = 3584 + h * 128; u.ocol = 1024 + h * 128; u.head = h;
        const int r0 = qt * 4; int lo = min(max(r0 - 4, 0), 56), hi2 = min(max(r0 - 1, 0), 56) + 7; if (((hi2 - lo + 1) & 1) != 0) { if (hi2 < 63) ++hi2; else --lo; }
        u.NT = 4 + (hi2 - lo + 1); u.seg2row = CTXL + lo * 64; u.pa = r0; u.pb = lo;
        att::attn_unit<2, 1>(u, F.r2, (bf16_t*)F.o8, F.ob, lds);
    } }
}

__device__ __forceinline__ void router_tail(const Ctx& F, const float (&lg)[16], const int b, const int t, const bool valid) {
    const bool b5 = (F.lane & 32) != 0, b4 = (F.lane & 16) != 0, b3 = (F.lane & 8) != 0, b2 = (F.lane & 4) != 0;
    float r8[8], r4[4], r2[2];
#pragma unroll
    for (int e = 0; e < 8; ++e) { const float keep = b5 ? lg[e + 8] : lg[e], send = b5 ? lg[e] : lg[e + 8]; r8[e] = keep + __shfl_xor(send, 32); }
#pragma unroll
    for (int e = 0; e < 4; ++e) { const float keep = b4 ? r8[e + 4] : r8[e], send = b4 ? r8[e] : r8[e + 4]; r4[e] = keep + __shfl_xor(send, 16); }
#pragma unroll
    for (int e = 0; e < 2; ++e) { const float keep = b3 ? r4[e + 2] : r4[e], send = b3 ? r4[e] : r4[e + 2]; r2[e] = keep + __shfl_xor(send, 8); }
    float lgt; { const float keep = b2 ? r2[1] : r2[0], send = b2 ? r2[0] : r2[1]; lgt = keep + __shfl_xor(send, 4); }
    lgt += __shfl_xor(lgt, 2); lgt += __shfl_xor(lgt, 1);
    float mx = lgt;
    mx = fmaxf(mx, __shfl_xor(mx, 4)); mx = fmaxf(mx, __shfl_xor(mx, 8)); mx = fmaxf(mx, __shfl_xor(mx, 16)); mx = fmaxf(mx, __shfl_xor(mx, 32));
    const float ex = expf(lgt - mx); float sum = ex;
    sum += __shfl_xor(sum, 4); sum += __shfl_xor(sum, 8); sum += __shfl_xor(sum, 16); sum += __shfl_xor(sum, 32);
    if (valid && (F.lane & 3) == 0) { const float af = ex / sum; const int e = F.lane >> 2;
        if (t < CTXL) F.affc[((size_t)(b * 16 + e)) * CTXL + t] = af; else F.affl[((size_t)(b * 16 + e)) * SEQ + (t - CTXL)] = af; }
}
__device__ __forceinline__ void phase_norm2(const Params& p, const Ctx& F, const int l) {
    LAS float* wr = (LAS float*)F.lds;
    for (int i = F.tid; i < DM * NEXP; i += NTHR) { const int d = i >> 4, e = i & 15; wr[e * DM + d] = p.w_router[(size_t)l * DM * NEXP + i]; }
    __syncthreads();
    const int b = F.gw & 7, tstride = F.NGW >> 3;
    int cur_m = -1; f32x4 A[8], Bv[8];
    int t = F.gw >> 3; if (l == 1) { while (t < CTXL) t += tstride; }
    while (t < TPB) {
        const bool isctx = t < CTXL;
        const int mrow = isctx ? 8 : b;
        const int tB = t + tstride;
        const bool two = !isctx && tB < TPB;
        f32x2 vv[8][4];
        { const float* xlat = l == 0 ? p.x : p.out; const float* xctx = l == 0 ? p.ctx : F.xc;
          const float* xs0 = isctx ? xctx + ((size_t)b * CTXL + t) * DM : xlat + ((size_t)b * SEQ + (t - CTXL)) * DM;
          const float* xs1 = two ? xlat + ((size_t)b * SEQ + (tB - CTXL)) * DM : xs0;
          const bf16_t* d0p = F.dlt + ((size_t)b * TPB + t) * DM + 4 * F.lane; const bf16_t* d1p = F.dlt + ((size_t)b * TPB + (two ? tB : t)) * DM + 4 * F.lane;
#pragma unroll
          for (int j = 0; j < 8; ++j) { f32x4 x0 = __builtin_nontemporal_load((const f32x4*)xs0 + F.lane + 64 * j), x1 = __builtin_nontemporal_load((const f32x4*)xs1 + F.lane + 64 * j);
              const u32x2 e0 = __builtin_nontemporal_load((const u32x2*)(d0p + 256 * j)), e1 = __builtin_nontemporal_load((const u32x2*)(d1p + 256 * j));
              x0 += (f32x4){bflo(e0.x), bfhi(e0.x), bflo(e0.y), bfhi(e0.y)}; x1 += (f32x4){bflo(e1.x), bfhi(e1.x), bflo(e1.y), bfhi(e1.y)};
#pragma unroll
              for (int c = 0; c < 4; ++c) vv[j][c] = (f32x2){x0[c], x1[c]}; } }
        if (mrow != cur_m) { cur_m = mrow; const float* mr = F.mod + (size_t)(l * 9 + mrow) * MODW;
#pragma unroll
            for (int j = 0; j < 8; ++j) { const f32x4 g = *((const f32x4*)(p.g_ffn + l * DM) + F.lane + 64 * j), sc = *((const f32x4*)(mr + 4 * DM) + F.lane + 64 * j);
                A[j] = g * (sc + 1.f); Bv[j] = *((const f32x4*)(mr + 3 * DM) + F.lane + 64 * j); } }
        f32x2 ss = {0.f, 0.f};
#pragma unroll
        for (int j = 0; j < 8; ++j)
#pragma unroll
            for (int c = 0; c < 4; ++c) ss += vv[j][c] * vv[j][c];
        const f32x2 rstd = {rsqrtf(wave_sum(ss.x) * (1.f / DM) + EPS), rsqrtf(wave_sum(ss.y) * (1.f / DM) + EPS)};
        f32x2 am = {0.f, 0.f};
#pragma unroll
        for (int j = 0; j < 8; ++j)
#pragma unroll
            for (int c = 0; c < 4; ++c) { vv[j][c] = vv[j][c] * rstd * A[j][c] + Bv[j][c]; am = __builtin_elementwise_max(am, __builtin_elementwise_abs(vv[j][c])); }
        const float am0 = fmaxf(wave_max(am.x), 1e-20f), am1 = fmaxf(wave_max(am.y), 1e-20f), inv0 = 127.f / am0, inv1 = 127.f / am1;
        unsigned* hn0 = (unsigned*)((signed char*)F.r1 + ((size_t)b * TPB + t) * DM) + F.lane;
        unsigned* hn1 = (unsigned*)((signed char*)F.r1 + ((size_t)b * TPB + (two ? tB : t)) * DM) + F.lane;
#pragma unroll
        for (int j = 0; j < 8; ++j) { __builtin_nontemporal_store(pack_i8x4(vv[j][0].x, vv[j][1].x, vv[j][2].x, vv[j][3].x, inv0), hn0 + 64 * j);
            if (two) __builtin_nontemporal_store(pack_i8x4(vv[j][0].y, vv[j][1].y, vv[j][2].y, vv[j][3].y, inv1), hn1 + 64 * j); }
        if (F.lane == 0) { F.sah[b * TPB + t] = am0 * (1.f / 127.f); if (two) F.sah[b * TPB + tB] = am1 * (1.f / 127.f); }
        f32x2 lg[16];
        unsigned wro = (unsigned)(uintptr_t)wr; asm volatile("" : "+v"(wro));
        const LAS float* wr2 = (const LAS float*)(uintptr_t)wro;
#pragma unroll
        for (int e = 0; e < 16; ++e) { f32x2 a = {0.f, 0.f};
#pragma unroll
            for (int j = 0; j < 8; ++j) { const f32x4 w = *((const LAS f32x4*)(wr2 + e * DM) + F.lane + 64 * j);
#pragma unroll
                for (int c = 0; c < 4; ++c) a += vv[j][c] * w[c]; }
            lg[e] = a; }
        float lg0[16], lg1[16];
#pragma unroll
        for (int e = 0; e < 16; ++e) { lg0[e] = lg[e].x; lg1[e] = lg[e].y; }
        router_tail(F, lg0, b, t, true);
        router_tail(F, lg1, b, tB, two);
        t += two ? 2 * tstride : tstride;
    }
}

__device__ __forceinline__ void phase_oq(const Params& p, const Ctx& F, const int l) {
    for (int R = F.gw; R < NROWS; R += F.NGW) {
        if (l == 1 && (R % TPB) < CTXL) continue;
        const bf16_t* src = F.r1 + (size_t)R * DM + 8 * F.lane;
        u32x4 w[4];
#pragma unroll
        for (int j = 0; j < 4; ++j) w[j] = __builtin_nontemporal_load((const u32x4*)(src + 512 * j));
        float v[4][8], am = 0.f;
#pragma unroll
        for (int j = 0; j < 4; ++j) { v[j][0] = bflo(w[j].x); v[j][1] = bfhi(w[j].x); v[j][2] = bflo(w[j].y); v[j][3] = bfhi(w[j].y); v[j][4] = bflo(w[j].z); v[j][5] = bfhi(w[j].z); v[j][6] = bflo(w[j].w); v[j][7] = bfhi(w[j].w);
#pragma unroll
            for (int q = 0; q < 8; ++q) am = fmaxf(am, fabsf(v[j][q])); }
        am = fmaxf(wave_max(am), 1e-20f); const float inv = 127.f / am;
        signed char* dst = F.o8 + (size_t)R * DM + 8 * F.lane;
#pragma unroll
        for (int j = 0; j < 4; ++j) { u32x2 o; o.x = pack_i8x4(v[j][0], v[j][1], v[j][2], v[j][3], inv); o.y = pack_i8x4(v[j][4], v[j][5], v[j][6], v[j][7], inv); *(u32x2*)(dst + 512 * j) = o; }
        if (F.lane == 0) F.so[R] = am * (1.f / 127.f);
    }
}

__device__ __forceinline__ void phase_hidq(const Params& p, const Ctx& F, const int l) {
    const int nrows = 16 * (l == 0 ? 4352 : 4096);
    for (int R = F.gw; R < nrows; R += F.NGW) {
        const bf16_t* src = F.hid + (size_t)R * DEXP + 8 * F.lane;
        u32x4 w[3]; float v[3][8]; float am = 0.f;
#pragma unroll
        for (int j = 0; j < 3; ++j) w[j] = __builtin_nontemporal_load((const u32x4*)(src + 512 * j));
#pragma unroll
        for (int j = 0; j < 3; ++j) { v[j][0] = bflo(w[j].x); v[j][1] = bfhi(w[j].x); v[j][2] = bflo(w[j].y); v[j][3] = bfhi(w[j].y); v[j][4] = bflo(w[j].z); v[j][5] = bfhi(w[j].z); v[j][6] = bflo(w[j].w); v[j][7] = bfhi(w[j].w);
#pragma unroll
            for (int q = 0; q < 8; ++q) am = fmaxf(am, fabsf(v[j][q])); }
        am = fmaxf(wave_max(am), 1e-20f); const float inv = 127.f / am;
        signed char* dst = F.hid8 + (size_t)R * DEXP + 8 * F.lane;
#pragma unroll
        for (int j = 0; j < 3; ++j) { u32x2 o; o.x = pack_i8x4(v[j][0], v[j][1], v[j][2], v[j][3], inv); o.y = pack_i8x4(v[j][4], v[j][5], v[j][6], v[j][7], inv); *(u32x2*)(dst + 512 * j) = o; }
        if (F.lane == 0) F.shd[R] = am * (1.f / 127.f);
    }
}

__device__ __forceinline__ void phase_topk(const Params& p, const Ctx& F, const int l) {
    LAS unsigned* cnt = (LAS unsigned*)F.lds;
    const int nunits = l == 0 ? 256 : 128, mexp = l == 0 ? 4352 : 4096;
    for (int ui = F.bid; ui < nunits; ui += F.G) {
        const bool lat = ui < 128; const int uu = ui & 127, b = uu >> 4, e = uu & 15;
        const int ntok = lat ? SEQ : CTXL, cap = lat ? 512 : 32;
        const float* aff = lat ? F.affl + (size_t)(b * 16 + e) * SEQ : F.affc + (size_t)(b * 16 + e) * CTXL;
        const int rowbase = l == 0 ? (lat ? 256 + b * 512 : b * 32) : b * 512;
        if (F.tid < 64) cnt[F.tid] = 0u;
        unsigned key[8];
#pragma unroll
        for (int i = 0; i < 8; ++i) { const int n = i * NTHR + F.tid; key[i] = n < ntok ? __float_as_uint(aff[n]) : 0u; }
        __syncthreads();
        unsigned prefix = 0u;
        for (int bit = 30; bit >= 0; --bit) {
            const unsigned cand = prefix | (1u << bit); unsigned c = 0u;
#pragma unroll
            for (int i = 0; i < 8; ++i) c += (unsigned)__popcll(__ballot(key[i] >= cand));
            if (F.lane == 0) __hip_atomic_fetch_add(&cnt[bit], c, __ATOMIC_RELAXED, __HIP_MEMORY_SCOPE_WORKGROUP);
            __syncthreads();
            if (cnt[bit] >= (unsigned)cap) prefix = cand;
        }
#pragma unroll
        for (int i = 0; i < 8; ++i) { const int n = i * NTHR + F.tid;
            if (n < ntok) { int slot = -1;
                if (key[i] > prefix) slot = (int)__hip_atomic_fetch_add(&cnt[32], 1u, __ATOMIC_RELAXED, __HIP_MEMORY_SCOPE_WORKGROUP);
                key[i] = (key[i] > prefix) ? (0x80000000u | (unsigned)slot) : (key[i] == prefix ? 0x40000000u : 0u); } else key[i] = 0u; }
        __syncthreads();
        const unsigned cgt = cnt[32];
#pragma unroll
        for (int i = 0; i < 8; ++i) { const int n = i * NTHR + F.tid;
            if (n < ntok) { int slot = -1;
                if (key[i] & 0x80000000u) slot = (int)(key[i] & 0xffffu);
                else if (key[i] & 0x40000000u) { const unsigned s2 = cgt + __hip_atomic_fetch_add(&cnt[33], 1u, __ATOMIC_RELAXED, __HIP_MEMORY_SCOPE_WORKGROUP); if (s2 < (unsigned)cap) slot = (int)s2; }
                const int t = lat ? CTXL + n : n;
                int yrow = -1;
                if (slot >= 0) { const int rr = rowbase + slot; yrow = e * mexp + rr; F.rows[e * MEXP_MAX + rr] = b * TPB + t; F.gate[e * mexp + rr] = aff[n]; F.sas[e * mexp + rr] = F.sah[b * TPB + t]; }
                F.slot[((size_t)(b * 16 + e)) * TPB + t] = yrow; } }
        __syncthreads();
    }
}

__global__ void __launch_bounds__(NTHR, 2) fwd_kernel(Params p) {
    extern __shared__ __attribute__((aligned(16))) unsigned char lds_raw[];
    unsigned char* ws = p.ws;
    LAS unsigned char* const lds0 = (LAS unsigned char*)lds_raw;
    volatile LAS unsigned* lctl = (volatile LAS unsigned*)(lds0 + LCTL_OFF);
    if (threadIdx.x < 128) lctl[threadIdx.x] = 0u;
    __syncthreads();
#if MK_MULTI
#define GRID_BAR() do { } while (0)
#else
    XcdBarrier bar = xcd_barrier_post((unsigned*)(ws + WS_CTL) + 4096, lctl + 8);
#define GRID_BAR() xcd_barrier(bar)
#endif
    const int lo = p.ph_lo, hi = p.ph_hi;
#define IN(k) (lo <= (k) && (k) < hi)
#define SEAM(k) do { if (IN((k) + 1)) GRID_BAR(); } while (0)
#ifndef PHMASK
#define PHMASK 0xfff
#endif
#define EN(s) (((PHMASK) >> (s)) & 1)
#ifndef REP_PRO
#define REP_PRO 1
#endif
#ifndef REP_HEAVY
#define REP_HEAVY 1
#endif
#ifndef REP_THIN
#define REP_THIN 1
#endif
#ifndef REP_ATT
#define REP_ATT 1
#endif

    if (EN(0) && IN(0)) { for (int rep = 0; rep < REP_PRO; ++rep) { const Ctx F = make_ctx(p, lds0); phase_prologue(p, F); __syncthreads(); } SEAM(0); }

    for (int l = 0; l < 2; ++l) {
        const int pb = 1 + l * 11;
        const int mexp = l == 0 ? 4352 : 4096;
        if (EN(1) && IN(pb + 0)) { for (int rep = 0; rep < (l == 0 ? REP_THIN : 1); ++rep) { const Ctx F = make_ctx(p, lds0); phase_norm1(p, F, l); } SEAM(pb + 0); }
        if (EN(2) && IN(pb + 1)) {
            const Ctx F = make_ctx(p, lds0);
            pg8::DenseOrder S{NROWS / 256, INW / 256, F.G, F.bid, 0, (const char*)F.r1, (const char*)F.win + (size_t)l * INW * DM, (size_t)256 * DM};
            pg8::EpiP E{(unsigned char*)F.k8 - WS_K8, l == 0 ? 1 : 0, F.wsc[l]};
            for (int rep = 0; rep < REP_HEAVY; ++rep) pg8::gemm_phase<pg8::EpiP, pg8::DenseOrder, false, true>(F.tid, F.lds, nullptr, DM, S, E);
            SEAM(pb + 1);
        }
        if (EN(3) && IN(pb + 2) && l == 1) { const Ctx F = make_ctx(p, lds0); phase_qkfix(p, F, l); SEAM(pb + 2); }
        if (EN(4) && IN(pb + 3)) { for (int rep = 0; rep < REP_ATT; ++rep) { const Ctx F = make_ctx(p, lds0); phase_attn(p, F, l); } SEAM(pb + 3); }
        if (EN(6) && IN(pb + 4) && l == 0) { const Ctx F = make_ctx(p, lds0); phase_oq(p, F, l); SEAM(pb + 4); }
        if (EN(6) && IN(pb + 5)) {
            const Ctx F = make_ctx(p, lds0);
            pg8::DenseOrder S{l == 0 ? NROWS / 256 : NB * 16, DM / 256, F.G, F.bid, l, (const char*)F.o8, (const char*)F.wout + (size_t)l * DM * DM, (size_t)256 * DM};
            if (l == 0) { pg8::EpiDelta E{F.dlt, F.mod + (size_t)l * 9 * MODW, F.so, F.wsc[98 + l]};
                pg8::gemm_phase<pg8::EpiDelta, pg8::DenseOrder, false, true>(F.tid, F.lds, nullptr, DM, S, E); }
            else { pg8::EpiDelta E{F.dlt, F.mod + (size_t)l * 9 * MODW, nullptr, F.wsc[98 + l] * (1.f / O8_SCALE)};
                pg8::gemm_phase<pg8::EpiDelta, pg8::DenseOrder, false, true, true>(F.tid, F.lds, nullptr, DM, S, E); }
            SEAM(pb + 5);
        }
        if (EN(7) && IN(pb + 6)) { for (int rep = 0; rep < REP_THIN; ++rep) { const Ctx F = make_ctx(p, lds0); phase_norm2(p, F, l); __syncthreads(); } SEAM(pb + 6); }
        if (EN(8) && IN(pb + 7)) { for (int rep = 0; rep < REP_THIN; ++rep) { const Ctx F = make_ctx(p, lds0); phase_topk(p, F, l); } SEAM(pb + 7); }
        if (EN(9) && IN(pb + 8)) {
            const Ctx F = make_ctx(p, lds0);
            pg8::MoeOrder S{mexp / 256, 3072 / 256, F.G, F.bid, (const char*)F.r1, 0, (const char*)F.wgu + (size_t)l * NEXP * 3072 * DM, (size_t)3072 * DM, (size_t)256 * DM};
            LAS unsigned* tab = (LAS unsigned*)(F.lds + TAB_OFF);
            { unsigned rv[14];
#pragma unroll
              for (int i = 0; i < 14; ++i) { pg8::Unit u; rv[i] = 0u; if (S.next(i, u) && F.tid < 256) rv[i] = (unsigned)F.rows[u.e * MEXP_MAX + u.pm * 256 + F.tid]; }
#pragma unroll
              for (int i = 0; i < 14; ++i) if (F.tid < 256) tab[i * 256 + F.tid] = rv[i] * (unsigned)DM; }
            __syncthreads();
            pg8::EpiSwiglu E{(unsigned char*)F.hid8, mexp, F.sas, F.wsc + 2 + 32 * l};
            for (int rep = 0; rep < REP_HEAVY; ++rep) pg8::gemm_phase<pg8::EpiSwiglu, pg8::MoeOrder, true, true>(F.tid, F.lds, tab, DM, S, E);
            SEAM(pb + 8);
        }
        if (EN(10) && IN(pb + 10)) {
            const Ctx F = make_ctx(p, lds0);
            pg8::MoeOrder S{mexp / 256, DM / 256, F.G, F.bid, (const char*)F.hid8, (size_t)mexp * DEXP, (const char*)F.wdn + (size_t)l * NEXP * DM * DEXP, (size_t)DM * DEXP, (size_t)256 * DEXP};
            pg8::EpiDown E{F.y8, F.gate, mexp, F.wsc + 66 + 16 * l};
            pg8::gemm_phase<pg8::EpiDown, pg8::MoeOrder, false, true, true>(F.tid, F.lds, nullptr, DEXP, S, E);
            SEAM(pb + 10);
        }
    }
    if (EN(11) && IN(23)) { const Ctx F = make_ctx(p, lds0); phase_norm1(p, F, 2); }
#undef IN
#undef SEAM
}

extern "C" void kernel_launch(void* const* d_in, const int* in_sizes, int n_in, void* d_out, int out_size, void* d_ws, size_t ws_size, hipStream_t stream) {
    static int grid = 0;
    if (grid == 0) {
        if (n_in != 24 || out_size != NB * SEQ * DM || ws_size < WS_END) { fprintf(stderr, "kernel_launch: unexpected shapes: n_in %d out %d ws %zu (need %zu)\n", n_in, out_size, ws_size, (size_t)WS_END); grid = -1; return; }
        int dev = 0, cus = 0, per_cu = 0;
        if (hipGetDevice(&dev) != hipSuccess || hipDeviceGetAttribute(&cus, hipDeviceAttributeMultiprocessorCount, dev) != hipSuccess) { fprintf(stderr, "kernel_launch: device query failed\n"); grid = -1; return; }
        if (hipFuncSetAttribute((const void*)fwd_kernel, hipFuncAttributeMaxDynamicSharedMemorySize, LDS_BYTES) != hipSuccess) { fprintf(stderr, "kernel_launch: hipFuncSetAttribute failed\n"); grid = -1; return; }
        if (hipOccupancyMaxActiveBlocksPerMultiprocessor(&per_cu, (const void*)fwd_kernel, NTHR, LDS_BYTES) != hipSuccess || per_cu < 1) fprintf(stderr, "kernel_launch: note: occupancy query reports %d\n", per_cu);
        (void)hipGetLastError();
        grid = cus;
    }
    if (grid < 0) return;
    if (hipMemsetAsync((char*)d_ws + WS_CTL, 0, CTL_ZERO_BYTES, stream) != hipSuccess) { fprintf(stderr, "kernel_launch: memset failed\n"); return; }
    Params p{};
    const float** pp = (const float**)&p;
    for (int i = 0; i < 24; ++i) pp[i] = (const float*)d_in[i];
    p.out = (float*)d_out; p.ws = (unsigned char*)d_ws;
#if MK_MULTI
    for (int ph = 0; ph < 24; ++ph) { p.ph_lo = ph; p.ph_hi = ph + 1;
        hipLaunchKernelGGL(fwd_kernel, dim3(grid), dim3(NTHR), LDS_BYTES, stream, p); }
#elif defined(PROBE_K)
    p.ph_lo = 0; p.ph_hi = PROBE_K + 1;
    hipLaunchKernelGGL(fwd_kernel, dim3(grid), dim3(NTHR), LDS_BYTES, stream, p);
    (void)hipMemsetAsync((char*)d_ws + WS_CTL, 0, CTL_ZERO_BYTES, stream);
    p.ph_lo = PROBE_K2; p.ph_hi = 24;
    hipLaunchKernelGGL(fwd_kernel, dim3(grid), dim3(NTHR), LDS_BYTES, stream, p);
#else
    p.ph_lo = 0; p.ph_hi = 24;
    hipLaunchKernelGGL(fwd_kernel, dim3(grid), dim3(NTHR), LDS_BYTES, stream, p);
#endif
    const hipError_t le = hipPeekAtLastError();
    if (le != hipSuccess) fprintf(stderr, "kernel_launch: launch failed: %s\n", hipGetErrorName(le));
}
```

```cpp
#include <hip/hip_runtime.h>
#include <cstdio>
#include <cstdint>
#include <type_traits>

#ifndef MK_MULTI
#define MK_MULTI 0
#endif

#define LAS __attribute__((address_space(3)))
typedef unsigned short bf16_t;
typedef short bf16x8 __attribute__((ext_vector_type(8)));
typedef short s16x4 __attribute__((ext_vector_type(4)));
typedef float f32x4 __attribute__((ext_vector_type(4)));
typedef float f32x2 __attribute__((ext_vector_type(2)));
typedef float f32x16 __attribute__((ext_vector_type(16)));
typedef unsigned u32x4 __attribute__((ext_vector_type(4)));
typedef unsigned u32x2 __attribute__((ext_vector_type(2)));
typedef int i32x4 __attribute__((ext_vector_type(4)));
typedef int i32x8 __attribute__((ext_vector_type(8)));

constexpr int DM = 2048, NB = 8, SEQ = 4096, CTXL = 256, TPB = SEQ + CTXL, NROWS = NB * TPB;
constexpr int INW = 4608, NEXP = 16, DEXP = 1536, MODW = 6 * DM;
constexpr int MEXP_MAX = 4352;
constexpr float EPS = 1e-6f;
constexpr int NWAVES = 8, NTHR = 512;

constexpr size_t MiB = 1u << 20;
constexpr size_t WS_CTL = 0, CTL_ZERO_BYTES = 1 * MiB;
constexpr size_t WS_MOD = 1 * MiB;
constexpr size_t WS_AFFL = 2 * MiB;
constexpr size_t WS_AFFC = 4 * MiB;
constexpr size_t WS_SHD = 4 * MiB + 256 * 1024;
constexpr size_t WS_SO = 4 * MiB + 640 * 1024;
constexpr size_t WS_ROWS = 5 * MiB;
constexpr size_t WS_GATE = 5 * MiB + 512 * 1024;
constexpr size_t WS_SLOT = 6 * MiB;
constexpr size_t WS_SAX = 9 * MiB;
constexpr size_t WS_SAH = 9 * MiB + 256 * 1024;
constexpr size_t WS_SAS = 9 * MiB + 512 * 1024;
constexpr size_t WS_WSC = 9 * MiB + 896 * 1024;
constexpr size_t WS_XC = 10 * MiB;
constexpr size_t WS_WIN = 26 * MiB;
constexpr size_t WS_WOUT = 62 * MiB;
constexpr size_t WS_WGU = 78 * MiB;
constexpr size_t WS_K8 = 272 * MiB;
constexpr size_t WS_V8 = 288 * MiB;
constexpr size_t WS_K8D = 306 * MiB;
constexpr size_t WS_V8D = 342 * MiB;
constexpr size_t WS_WDN = 462 * MiB;
constexpr size_t WS_R1 = 654 * MiB;
constexpr size_t WS_R2 = 790 * MiB;
constexpr size_t WS_R3 = 1096 * MiB;
constexpr size_t WS_DLT = 1368 * MiB;
constexpr size_t WS_END = 1504 * MiB;

constexpr int RING_BYTES = 131072;
constexpr int TAB_OFF = 131072;
constexpr int LCTL_OFF = 146944;
constexpr int LDS_BYTES = 147456;

__device__ __forceinline__ unsigned cvtpk(float lo, float hi) { unsigned r; asm volatile("v_cvt_pk_bf16_f32 %0, %1, %2" : "=v"(r) : "v"(lo), "v"(hi)); return r; }
__device__ __forceinline__ float bflo(unsigned w) { return __uint_as_float(w << 16); }
__device__ __forceinline__ float bfhi(unsigned w) { return __uint_as_float(w & 0xffff0000u); }
__device__ __forceinline__ float wave_sum(float v) {
#pragma unroll
    for (int o = 1; o < 64; o <<= 1) v += __shfl_xor(v, o);
    return v;
}
__device__ __forceinline__ float wave_max(float v) {
#pragma unroll
    for (int o = 1; o < 64; o <<= 1) v = fmaxf(v, __shfl_xor(v, o));
    return v;
}
__device__ __forceinline__ f32x4 tof(const f32x4& a) { return a; }
__device__ __forceinline__ f32x4 tof(const i32x4& a) { return (f32x4){(float)a.x, (float)a.y, (float)a.z, (float)a.w}; }
__device__ __forceinline__ unsigned q8u(float x, float inv) { int q = __float2int_rn(x * inv); q = min(max(q, -127), 127); return (unsigned)q & 0xffu; }
__device__ __forceinline__ unsigned pack_i8x4(float a, float b, float c, float d, float inv) { return q8u(a, inv) | (q8u(b, inv) << 8) | (q8u(c, inv) << 16) | (q8u(d, inv) << 24); }
__device__ __forceinline__ float clamp_f8(float x) { return __builtin_amdgcn_fmed3f(x, -448.f, 448.f); }
__device__ __forceinline__ unsigned pack_f8x4(float a, float b, float c, float d, float inv) {
    int w = 0; w = __builtin_amdgcn_cvt_pk_fp8_f32(clamp_f8(a * inv), clamp_f8(b * inv), w, false); w = __builtin_amdgcn_cvt_pk_fp8_f32(clamp_f8(c * inv), clamp_f8(d * inv), w, true); return (unsigned)w; }
__device__ __forceinline__ unsigned pack_q4(float a, float b, float c, float d, float inv, bool f8) { const unsigned i = pack_i8x4(a, b, c, d, inv), f = pack_f8x4(a, b, c, d, inv); return f8 ? f : i; }
constexpr float HID_SCALE = 8.f;
constexpr float O8_SCALE = 64.f;
constexpr float Y_SCALE = 32.f;
__device__ __forceinline__ f32x4 unpack_f8x4(unsigned w) { const auto lo = __builtin_amdgcn_cvt_pk_f32_fp8((int)w, false), hi = __builtin_amdgcn_cvt_pk_f32_fp8((int)w, true); return (f32x4){lo[0], lo[1], hi[0], hi[1]}; }
__device__ __forceinline__ float amax4(const f32x4& v) { return fmaxf(fmaxf(fabsf(v.x), fabsf(v.y)), fmaxf(fabsf(v.z), fabsf(v.w))); }
__device__ __forceinline__ float silu_f(float x) { return x / (1.f + __expf(-x)); }
#define LDS_WAIT() asm volatile("s_waitcnt lgkmcnt(0)" ::: "memory")
#define VM_WAIT() asm volatile("s_waitcnt vmcnt(0)" ::: "memory")

struct Params {
    const float *x, *c, *ctx, *c_ctx, *w_ada, *b_ada, *g_mix, *g_ffn, *w_in, *w_out, *a_sink, *lq1, *lk1, *lq2, *lk2, *subln, *qn, *kn, *rpb, *w_router, *w_gate, *w_up, *w_down, *g_final;
    float* out; unsigned char* ws; int ph_lo, ph_hi;
};

#define XB_TMO      128
#define XB_XCNT(j)  (256  + 64 * (j))
#define XB_XSUB(j)  (1280 + 64 * (j))
#define XB_XGEN(j)  (2304 + 64 * (j))
#define XB_TOP      3328
#define XB_TOPGEN   3392
#define XCD_BAR_WORDS 3456
#define XB_SPIN_CAP (1u << 18)

__device__ __forceinline__ unsigned xb_ld(unsigned* p)              { return __hip_atomic_load(p, __ATOMIC_RELAXED, __HIP_MEMORY_SCOPE_AGENT); }
__device__ __forceinline__ unsigned xb_add(unsigned* p, unsigned v) { return __hip_atomic_fetch_add(p, v, __ATOMIC_RELAXED, __HIP_MEMORY_SCOPE_AGENT); }
__device__ __forceinline__ unsigned xb_xcc_id() { return (unsigned)__builtin_amdgcn_s_getreg((3 << 11) | 20) & 0xFu; }
#define XB_SPIN(cond, bar) do { unsigned _sp = 0; while (cond) { __builtin_amdgcn_s_sleep(1); \
    if ((++_sp & 255u) == 0u) { if (xb_ld(&(bar)[XB_TMO])) break; if (_sp > XB_SPIN_CAP) { atomicAdd(&(bar)[XB_TMO], 1u); break; } } } } while (0)

struct XcdBarrier { unsigned* bar; unsigned x; volatile LAS unsigned* st; };

__device__ __forceinline__ XcdBarrier xcd_barrier_post(unsigned* bar, volatile LAS unsigned* st) {
    XcdBarrier b; b.bar = bar; b.x = xb_xcc_id(); b.st = st;
    if (threadIdx.x == 0) (void)xb_add(&bar[XB_XCNT(b.x)], 1u);
    return b;
}
__device__ __forceinline__ void xcd_barrier_complete(unsigned* bar, unsigned x, unsigned& nloc, unsigned& nx) {
    const unsigned G = gridDim.x * gridDim.y * gridDim.z;
    unsigned sum, cnt, mine, sp = 0u;
    for (;;) {
        sum = 0u; cnt = 0u; mine = 0u;
#pragma unroll
        for (unsigned j = 0; j < 16; ++j) { const unsigned c = xb_ld(&bar[XB_XCNT(j)]); sum += c; cnt += (c > 0u) ? 1u : 0u; mine = (j == x) ? c : mine; }
        if (sum == G) break;
        __builtin_amdgcn_s_sleep(1);
        if ((++sp & 255u) == 0u) { if (xb_ld(&bar[XB_TMO])) break; if (sp > XB_SPIN_CAP) { atomicAdd(&bar[XB_TMO], 1u); break; } }
    }
    nloc = mine > 0u ? mine : 1u; nx = cnt > 0u ? cnt : 1u;
}
__device__ __forceinline__ void xcd_barrier(const XcdBarrier& b) {
    asm volatile("s_waitcnt vmcnt(0)" ::: "memory");
    __syncthreads();
    if (threadIdx.x == 0) {
        unsigned* bar = b.bar;
        __builtin_amdgcn_s_waitcnt(0);
        unsigned nloc = b.st[0], nx = b.st[1];
        if (nloc == 0u) { xcd_barrier_complete(bar, b.x, nloc, nx); b.st[0] = nloc; b.st[1] = nx; }
        const unsigned old = xb_add(&bar[XB_XSUB(b.x)], 1u);
        const unsigned gen = old / nloc;
        if (old + 1u == (gen + 1u) * nloc) {
            __builtin_amdgcn_fence(__ATOMIC_RELEASE, "agent");
            asm volatile("s_waitcnt vmcnt(0)" ::: "memory");
            const unsigned og = xb_add(&bar[XB_TOP], 1u);
            const unsigned tg = og / nx;
            if (og + 1u == (tg + 1u) * nx) xb_add(&bar[XB_TOPGEN], 1u);
            else XB_SPIN(xb_ld(&bar[XB_TOPGEN]) == tg, bar);
            __builtin_amdgcn_fence(__ATOMIC_ACQUIRE, "agent");
            xb_add(&bar[XB_XGEN(b.x)], 1u);
            asm volatile("s_waitcnt vmcnt(0)" ::: "memory");
        } else {
            XB_SPIN(xb_ld(&bar[XB_XGEN(b.x)]) == gen, bar);
            __builtin_amdgcn_fence(__ATOMIC_ACQUIRE, "agent");
            asm volatile("s_waitcnt vmcnt(0)" ::: "memory");
        }
    }
    __syncthreads();
}

namespace pg8 {
constexpr int BM = 256, BK = 64, HALF = 128, HTB = HALF * BK * 2, STAGE_BYTES = 8 * HTB, NXCD = 8, WGM = 8;
__device__ __forceinline__ int lds_byte(int r, int c) { const int st = (r >> 4) * 2 + (c >> 5), rr = r & 15, cc = c & 31, ob = rr * 64 + cc * 2; return st * 1024 + (ob ^ (((ob >> 9) & 1) << 5)); }
__device__ __forceinline__ void stage_rc(int b, int& R, int& C) { const int st = b / 1024, sb = b % 1024, swz = sb ^ (((sb >> 9) & 1) << 5); R = (st >> 1) * 16 + swz / 64; C = (st & 1) * 32 + (swz % 64) / 2; }
__device__ __forceinline__ int perm32(int rho) { const int n = rho >> 4, i = rho & 15; return 8 * (i >> 2) + 4 * n + (i & 3); }

struct Unit { int pm, pn, e; };

__device__ __forceinline__ bool static_tile(long L, int nM, int nN, int& pm, int& pn) {
    const int nwg = nM * nN; if (L >= nwg) return false;
    int wgid = (int)L; { const int q = nwg / NXCD, r = nwg % NXCD, xcd = wgid % NXCD, off = wgid / NXCD; wgid = (xcd < r ? xcd * (q + 1) : r * (q + 1) + (xcd - r) * q) + off; }
    const int nig = WGM * nN, gid = wgid / nig, fm = gid * WGM, gsz = (nM - fm) < WGM ? (nM - fm) : WGM;
    pm = fm + ((wgid % nig) % gsz); pn = (wgid % nig) / gsz; return true;
}
struct DenseOrder {
    int nM, nN, G, c, skipctx; const char* A; const char* Bt; size_t tstep;
    __device__ __forceinline__ bool next(int i, Unit& u) const {
        int pm, pn; if (!static_tile((long)i * G + c, nM, nN, pm, pn)) return false;
        u.pm = skipctx ? (pm >> 4) * 17 + 1 + (pm & 15) : pm; u.pn = pn; u.e = 0; return true; }
    __device__ __forceinline__ const char* a_base(const Unit& u) const { return A + (size_t)u.pm * tstep; }
    __device__ __forceinline__ const char* b_base(const Unit& u) const { return Bt + (size_t)u.pn * tstep; }
};
struct MoeOrder {
    int nMe, nN, G, c; const char* A; size_t a_estride; const char* Bt; size_t b_estride; size_t tstep;
    __device__ __forceinline__ bool next(int i, Unit& u) const {
        const int per_e = nMe * nN, nwg = per_e * NEXP; const long L = (long)i * G + c; if (L >= nwg) return false;
        int wgid = (int)L; { const int q = nwg / NXCD, r = nwg % NXCD, xcd = wgid % NXCD, off = wgid / NXCD; wgid = (xcd < r ? xcd * (q + 1) : r * (q + 1) + (xcd - r) * q) + off; }
        u.e = wgid / per_e; const int loc = wgid % per_e;
        const int nig = WGM * nN, gid = loc / nig, fm = gid * WGM, gsz = (nMe - fm) < WGM ? (nMe - fm) : WGM;
        u.pm = fm + ((loc % nig) % gsz); u.pn = (loc % nig) / gsz; return true; }
    __device__ __forceinline__ const char* a_base(const Unit& u) const { return A + (size_t)u.e * a_estride + (a_estride ? (size_t)u.pm * tstep : 0); }
    __device__ __forceinline__ const char* b_base(const Unit& u) const { return Bt + (size_t)u.e * b_estride + (size_t)u.pn * tstep; }
};

struct EpiP {
    static constexpr bool PERM = true; unsigned char* wsb; int rope; float sw;
    template <class AT> __device__ __forceinline__ void operator()(const AT (&acc)[2][2][4][2], const Unit& u, int wr, int wc, int fr, int fq) const {
        const int row0 = u.pm * BM + wr * 64 + fr, col0 = u.pn * BM + wc * 32 + 8 * fq;
        const int pt = u.pm % 17;
        bf16_t* const O = (bf16_t*)(wsb + WS_R2); const float* const sa = (const float*)(wsb + WS_SAX);
        unsigned char* const k8a = wsb + WS_K8; unsigned char* const k8b = wsb + WS_K8D; unsigned char* const v8a = wsb + WS_V8; unsigned char* const v8b = wsb + WS_V8D;
        int frl = fr, fql = fq; asm volatile("" : "+v"(frl), "+v"(fql));
        unsigned char* kq = nullptr;
        if (rope) { if (u.pn == 4) kq = k8a; else if (u.pn >= 10 && u.pn <= 13) kq = k8b + (size_t)(u.pn - 10) * 2 * NROWS * 128; }
        if (rope && (u.pn == 5 || u.pn >= 14)) {
            const int b = u.pm / 17, qi = frl & 3, a4 = frl >> 2, nhv = u.pn == 5 ? 2 : 8, hv0 = u.pn == 5 ? 0 : (u.pn - 14) * 2; unsigned char* vq = u.pn == 5 ? v8a : v8b;
            const unsigned sel = (unsigned)qi | ((unsigned)(4 + qi) << 8) | 0x0c0c0000u;
#pragma unroll
            for (int ai = 0; ai < 2; ++ai)
#pragma unroll
                for (int m = 0; m < 4; ++m) { const float rsc = sa[row0 + ai * HALF + m * 16] * sw;
                    const int tile = (u.pm % 17) * 4 + wr + 2 * ai, pos0 = 32 * (a4 & 1) + 16 * (m >> 1) + 4 * ((2 * m + (a4 >> 1)) & 3);
#pragma unroll
                    for (int bj = 0; bj < 2; ++bj) { const f32x4 v0 = tof(acc[ai][bj][m][0]) * rsc, v1 = tof(acc[ai][bj][m][1]) * rsc;
                        unsigned char* tb_ = vq + ((size_t)((b * nhv + hv0 + bj) * 68 + tile)) * 8192 + (size_t)(wc * 32 + 8 * fql) * 64 + pos0;
#pragma unroll
                        for (int hh = 0; hh < 2; ++hh) { const f32x4 vv = hh ? v1 : v0; const int w = (int)pack_f8x4(vv[0], vv[1], vv[2], vv[3], 1.f);
                            const unsigned p0 = (unsigned)__builtin_amdgcn_update_dpp(0, w, 0x00, 0xf, 0xf, false), p1 = (unsigned)__builtin_amdgcn_update_dpp(0, w, 0x55, 0xf, 0xf, false);
                            const unsigned p2 = (unsigned)__builtin_amdgcn_update_dpp(0, w, 0xaa, 0xf, 0xf, false), p3 = (unsigned)__builtin_amdgcn_update_dpp(0, w, 0xff, 0xf, 0xf, false);
                            const unsigned t01 = __builtin_amdgcn_perm(p1, p0, sel), t23 = __builtin_amdgcn_perm(p3, p2, sel);
                            *(unsigned*)(tb_ + (hh * 4 + qi) * 64) = t01 | (t23 << 16); } } }
            return;
        }
        const bool dorope = rope && pt != 0 && (u.pn <= 4 || (u.pn >= 6 && u.pn <= 13));
        const int jf = ((wc & 1) * 4 + fq) * 4;
        float inv[4];
#pragma unroll
        for (int i = 0; i < 4; ++i) inv[i] = exp2f(-(float)(jf + i) * (13.287712379549449f / 32.f));
#pragma unroll
        for (int ai = 0; ai < 2; ++ai)
#pragma unroll
            for (int m = 0; m < 4; ++m) { bf16_t* rowp = O + (size_t)(row0 + ai * HALF + m * 16) * INW + col0; const float rsc = sa[row0 + ai * HALF + m * 16] * sw;
                float cs[4], sn[4];
                if (dorope) { const int pos = (pt - 1) * 256 + wr * 64 + ai * HALF + m * 16 + fr; const float pp = (float)((wc >> 1) == 0 ? (pos >> 6) : (pos & 63));
#pragma unroll
                    for (int i = 0; i < 4; ++i) { const float ang = pp * inv[i]; cs[i] = __cosf(ang); sn[i] = __sinf(ang); } }
#pragma unroll
                for (int bj = 0; bj < 2; ++bj) { f32x4 v0 = tof(acc[ai][bj][m][0]) * rsc, v1 = tof(acc[ai][bj][m][1]) * rsc;
                    if (dorope) {
#pragma unroll
                        for (int i = 0; i < 4; ++i) { const float a = v0[i], b = v1[i]; v0[i] = a * cs[i] - b * sn[i]; v1[i] = b * cs[i] + a * sn[i]; } }
                    u32x4 w; w.x = cvtpk(v0[0], v0[1]); w.y = cvtpk(v0[2], v0[3]); w.z = cvtpk(v1[0], v1[1]); w.w = cvtpk(v1[2], v1[3]);
                    if (kq == nullptr) *(u32x4*)(rowp + bj * HALF) = w;
                    if (kq != nullptr) { u32x2 w8; w8.x = pack_f8x4(v0[0], v0[1], v0[2], v0[3], 1.f); w8.y = pack_f8x4(v1[0], v1[1], v1[2], v1[3], 1.f);
                        *(u32x2*)(kq + ((size_t)bj * NROWS + (u.pm * BM + wr * 64 + frl + ai * HALF + m * 16)) * 128 + wc * 32 + 8 * fql) = w8; } } }
    }
};
struct EpiDelta {
    static constexpr bool PERM = true; bf16_t* D; const float* modl; const float* so; float sw;
    template <class AT> __device__ __forceinline__ void operator()(const AT (&acc)[2][2][4][2], const Unit& u, int wr, int wc, int fr, int fq) const {
        const int b = u.pm / 17, pt = u.pm % 17;
        const float* gt = modl + (size_t)(pt == 0 ? 8 : b) * MODW + 2 * DM;
        const int row0 = u.pm * BM + wr * 64 + fr, col0 = u.pn * BM + wc * 32 + 8 * fq;
        f32x4 g[2][2];
#pragma unroll
        for (int bj = 0; bj < 2; ++bj)
#pragma unroll
            for (int n = 0; n < 2; ++n) g[bj][n] = *(const f32x4*)(gt + col0 + bj * HALF + 4 * n) * sw;
#pragma unroll
        for (int ai = 0; ai < 2; ++ai)
#pragma unroll
            for (int m = 0; m < 4; ++m) { const int row = row0 + ai * HALF + m * 16; const float rs = so ? so[row] : 1.f; bf16_t* rowp = D + (size_t)row * DM + col0;
#pragma unroll
                for (int bj = 0; bj < 2; ++bj) { const f32x4 v0 = tof(acc[ai][bj][m][0]) * g[bj][0] * rs, v1 = tof(acc[ai][bj][m][1]) * g[bj][1] * rs;
                    u32x4 w; w.x = cvtpk(v0[0], v0[1]); w.y = cvtpk(v0[2], v0[3]); w.z = cvtpk(v1[0], v1[1]); w.w = cvtpk(v1[2], v1[3]);
                    *(u32x4*)(rowp + bj * HALF) = w; } }
    }
};
struct EpiSwiglu {
    static constexpr bool PERM = true; unsigned char* H; int mexp; const float* sas; const float* wsc;
    template <class AT> __device__ __forceinline__ void operator()(const AT (&acc)[2][2][4][2], const Unit& u, int wr, int wc, int fr, int fq) const {
        const int row0 = u.e * mexp + u.pm * BM + wr * 64 + fr, col0 = u.pn * 128 + wc * 16 + 4 * fq;
        const float sg = wsc[2 * u.e], su = wsc[2 * u.e + 1];
#pragma unroll
        for (int ai = 0; ai < 2; ++ai)
#pragma unroll
            for (int m = 0; m < 4; ++m) { unsigned char* rowp = H + (size_t)(row0 + ai * HALF + m * 16) * DEXP + col0; const float rs_ = sas[row0 + ai * HALF + m * 16];
#pragma unroll
                for (int bj = 0; bj < 2; ++bj) { const f32x4 g = tof(acc[ai][bj][m][0]) * (rs_ * sg), up = tof(acc[ai][bj][m][1]) * (rs_ * su); f32x4 h;
#pragma unroll
                    for (int q = 0; q < 4; ++q) h[q] = g[q] * __builtin_amdgcn_rcpf(1.f + __expf(-g[q])) * up[q];
                    *(unsigned*)(rowp + bj * 64) = pack_f8x4(h[0], h[1], h[2], h[3], HID_SCALE); } }
    }
};
struct EpiDown {
    static constexpr bool PERM = true; unsigned char* Y; const float* gate; int mexp; const float* wsc;
    template <class AT> __device__ __forceinline__ void operator()(const AT (&acc)[2][2][4][2], const Unit& u, int wr, int wc, int fr, int fq) const {
        const int row0 = u.e * mexp + u.pm * BM + wr * 64 + fr, col0 = u.pn * BM + wc * 32 + 8 * fq;
#pragma unroll
        for (int ai = 0; ai < 2; ++ai)
#pragma unroll
            for (int m = 0; m < 4; ++m) { const int row = row0 + ai * HALF + m * 16; const float gv = gate[row] * (wsc[u.e] * (Y_SCALE / HID_SCALE)); unsigned char* rowp = Y + (size_t)row * DM + col0;
#pragma unroll
                for (int bj = 0; bj < 2; ++bj) { const f32x4 v0 = tof(acc[ai][bj][m][0]) * gv, v1 = tof(acc[ai][bj][m][1]) * gv;
                    u32x2 w; w.x = pack_f8x4(v0[0], v0[1], v0[2], v0[3], 1.f); w.y = pack_f8x4(v1[0], v1[1], v1[2], v1[3], 1.f);
                    *(u32x2*)(rowp + bj * HALF) = w; } }
    }
};

__device__ __forceinline__ void mfma_f8(f32x4& acc, const i32x8 a, const i32x8 b) { asm volatile("v_mfma_f32_16x16x128_f8f6f4 %0, %1, %2, %0" : "+v"(acc) : "v"(a), "v"(b)); }
__device__ __forceinline__ void mfma_f8(i32x4& acc, const i32x8 a, const i32x8 b) { }
template <class Epi, class Sched, bool GATHER, bool I8, bool F8 = false>
__device__ __forceinline__ void gemm_phase(const int tid, LAS unsigned char* lds, const LAS unsigned* rowtab, const int KB, const Sched& S, const Epi& E) {
    const int wid = __builtin_amdgcn_readfirstlane(tid >> 6), lane = tid & 63, wr = wid >> 2, wc = wid & 3, fr = lane & 15, fq = lane >> 4;
    const int nt = KB / (BK * 2);
    const unsigned hstep = (unsigned)HALF * KB;
    const size_t kstep = (size_t)(BK * 2);
    unsigned voffB[2], vAc[2][2];
#pragma unroll
    for (int i = 0; i < 2; ++i) { int R, C; stage_rc(tid * 16 + i * 8192, R, C); const int Rb = Epi::PERM ? ((R & ~31) + perm32(R & 31)) : R;
        voffB[i] = (unsigned)(Rb * KB) + (unsigned)C * 2u; }
    const unsigned ldsw = (unsigned)wid * 1024u;
    const int aoff = lds_byte(wr * 64 + fr, fq * 8), boff = lds_byte(wc * 32 + fr, fq * 8);
#define PG8_SA(b, h) (((b) * 2 + (h)) * HTB)
#define PG8_SB(b, h) ((4 + (b) * 2 + (h)) * HTB)
#define PG8_STAGE(bufoff, gbase, voff) do { _Pragma("unroll") for (int _i = 0; _i < 2; ++_i) \
        __builtin_amdgcn_global_load_lds((const unsigned*)((const char*)(gbase) + (voff)[_i]), (LAS unsigned*)(lds + (bufoff) + ldsw + _i * 8192), 16, 0, 0); } while (0)
#define PG8_LDA(dst, b, h) do { _Pragma("unroll") for (int m = 0; m < 4; ++m) _Pragma("unroll") for (int k = 0; k < 2; ++k) dst[m][k] = *(const LAS bf16x8*)(lds + PG8_SA(b, h) + aoff + m * 2048 + k * 1024); } while (0)
#define PG8_LDB(dst, b, h) do { _Pragma("unroll") for (int n = 0; n < 2; ++n) _Pragma("unroll") for (int k = 0; k < 2; ++k) dst[n][k] = *(const LAS bf16x8*)(lds + PG8_SB(b, h) + boff + n * 2048 + k * 1024); } while (0)
#define PG8_MMA(ai, bj, At, Bt) do { __builtin_amdgcn_s_setprio(1); _Pragma("unroll") for (int m = 0; m < 4; ++m) _Pragma("unroll") for (int n = 0; n < 2; ++n) \
        if constexpr (F8) mfma_f8(acc[ai][bj][m][n], __builtin_shufflevector(__builtin_bit_cast(i32x4, Bt[n][0]), __builtin_bit_cast(i32x4, Bt[n][1]), 0, 1, 2, 3, 4, 5, 6, 7), \
            __builtin_shufflevector(__builtin_bit_cast(i32x4, At[m][0]), __builtin_bit_cast(i32x4, At[m][1]), 0, 1, 2, 3, 4, 5, 6, 7)); \
        else _Pragma("unroll") for (int k = 0; k < 2; ++k) \
        { if constexpr (I8) acc[ai][bj][m][n] = __builtin_amdgcn_mfma_i32_16x16x64_i8(__builtin_bit_cast(i32x4, Bt[n][k]), __builtin_bit_cast(i32x4, At[m][k]), acc[ai][bj][m][n], 0, 0, 0); \
          else acc[ai][bj][m][n] = __builtin_amdgcn_mfma_f32_16x16x32_bf16(Bt[n][k], At[m][k], acc[ai][bj][m][n], 0, 0, 0); } __builtin_amdgcn_s_setprio(0); } while (0)
#define PG8_WAIT_V(n) asm volatile("s_waitcnt vmcnt(" #n ")" ::: "memory")
#define PG8_WAIT_L(n) asm volatile("s_waitcnt lgkmcnt(" #n ")" ::: "memory")
#define PG8_BAR __builtin_amdgcn_s_barrier()
#define PG8_SCHED __builtin_amdgcn_sched_barrier(0)
#define PG8_LOADTAB(dst, ui_) do { _Pragma("unroll") for (int _i = 0; _i < 2; ++_i) { int _R, _C; stage_rc(tid * 16 + _i * 8192, _R, _C); _Pragma("unroll") for (int _h = 0; _h < 2; ++_h) \
        dst[_h][_i] = GATHER ? rowtab[(ui_) * 256 + _h * HALF + _R] + (unsigned)_C * 2u : (unsigned)((_h * HALF + _R) * KB) + (unsigned)_C * 2u; } } while (0)
    Unit cur, nxt; int ui = 0;
    if (!S.next(0, cur)) return;
    typedef typename std::conditional<I8 && !F8, i32x4, f32x4>::type acc_t;
    acc_t acc[2][2][4][2];
#pragma unroll
    for (int a = 0; a < 2; ++a)
#pragma unroll
        for (int b = 0; b < 2; ++b)
#pragma unroll
            for (int m = 0; m < 4; ++m)
#pragma unroll
                for (int n = 0; n < 2; ++n) acc[a][b][m][n] = acc_t{};
    bf16x8 At[4][2], B0[2][2], B1[2][2];
    const char* cA = S.a_base(cur); const char* cB = S.b_base(cur);
    PG8_LOADTAB(vAc, 0);
    PG8_STAGE(PG8_SB(0, 0), cB, voffB); PG8_STAGE(PG8_SB(0, 1), cB + hstep, voffB); PG8_STAGE(PG8_SA(0, 0), cA, vAc[0]); PG8_STAGE(PG8_SA(0, 1), cA, vAc[1]);
    if (wr == 1) PG8_BAR;
    PG8_WAIT_V(2); PG8_BAR;
    PG8_STAGE(PG8_SB(1, 0), cB + kstep, voffB); PG8_STAGE(PG8_SA(1, 0), cA + kstep, vAc[0]); PG8_STAGE(PG8_SB(1, 1), cB + hstep + kstep, voffB);
    PG8_WAIT_V(6); PG8_BAR;
    for (;;) {
        const bool has_next = S.next(ui + 1, nxt);
        const char* nA = has_next ? S.a_base(nxt) : cA; const char* nB = has_next ? S.b_base(nxt) : cB;
        for (int t = 0; t < nt; t += 2) {
            const bool last = (t == nt - 2);
            const char* a1 = cA + (size_t)(t + 1) * kstep;
            const char* a2 = last ? nA : cA + (size_t)(t + 2) * kstep; const char* b2 = last ? nB : cB + (size_t)(t + 2) * kstep;
            const char* a3 = a2 + kstep; const char* b3 = b2 + kstep;
            PG8_LDB(B0, 0, 0); PG8_LDB(B1, 0, 1); PG8_SCHED; PG8_LDA(At, 0, 0); PG8_STAGE(PG8_SA(1, 1), a1, vAc[1]);
            if (GATHER) { if (last && has_next) { PG8_LOADTAB(vAc, ui + 1); } }
            PG8_WAIT_V(8); PG8_WAIT_L(0); PG8_BAR; PG8_MMA(0, 0, At, B0); PG8_MMA(0, 1, At, B1); PG8_BAR; PG8_SCHED;
            PG8_LDA(At, 0, 1); PG8_STAGE(PG8_SB(0, 0), b2, voffB); PG8_STAGE(PG8_SB(0, 1), b2 + hstep, voffB); PG8_STAGE(PG8_SA(0, 0), a2, vAc[0]);
            PG8_WAIT_V(8); PG8_WAIT_L(0); PG8_BAR; PG8_MMA(1, 0, At, B0); PG8_MMA(1, 1, At, B1); PG8_BAR; PG8_SCHED;
            PG8_LDB(B0, 1, 0); PG8_LDB(B1, 1, 1); PG8_SCHED; PG8_LDA(At, 1, 0); PG8_STAGE(PG8_SA(0, 1), a2, vAc[1]);
            PG8_WAIT_V(8); PG8_WAIT_L(0); PG8_BAR; PG8_MMA(0, 0, At, B0); PG8_MMA(0, 1, At, B1); PG8_BAR; PG8_SCHED;
            PG8_LDA(At, 1, 1); PG8_STAGE(PG8_SB(1, 0), b3, voffB); PG8_STAGE(PG8_SB(1, 1), b3 + hstep, voffB); PG8_STAGE(PG8_SA(1, 0), a3, vAc[0]);
            PG8_WAIT_V(8); PG8_WAIT_L(0); PG8_BAR; PG8_MMA(1, 0, At, B0); PG8_MMA(1, 1, At, B1); PG8_BAR; PG8_SCHED;
        }
        if (wr == 0) PG8_BAR;
        E(acc, cur, wr, wc, fr, fq);
        if (!has_next) break;
#pragma unroll
        for (int a = 0; a < 2; ++a)
#pragma unroll
            for (int b = 0; b < 2; ++b)
#pragma unroll
                for (int m = 0; m < 4; ++m)
#pragma unroll
                    for (int n = 0; n < 2; ++n) acc[a][b][m][n] = acc_t{};
        cur = nxt; cA = nA; cB = nB; ++ui;
        if (wr == 1) PG8_BAR;
    }
    PG8_WAIT_V(0);
    PG8_BAR;
#undef PG8_SA
#undef PG8_SB
#undef PG8_STAGE
#undef PG8_LDA
#undef PG8_LDB
#undef PG8_MMA
#undef PG8_WAIT_V
#undef PG8_WAIT_L
#undef PG8_BAR
#undef PG8_SCHED
#undef PG8_LOADTAB
}
}

namespace att {
constexpr int D = 128, NW = 8, QBLK = 32, KVBLK = 64, LDP = INW;
constexpr float SCALE = 0.088388347648318440f;
constexpr float THR = 8.f;
constexpr int NBUF = 3;
constexpr int SHM_V = KVBLK * D * 2, SHM_K = KVBLK * D * 2, SHM_ATTN = NBUF * SHM_V + NBUF * SHM_K + NW * 64 * 4;
constexpr int BIAS_OFF = 100352;
#define KSWZ(row, colB) ((row) * 256 + ((colB) ^ (((row) & 7) << 4)))
#define SBAR() __builtin_amdgcn_sched_barrier(0)
__device__ __forceinline__ int crow(int r, int hi) { return (r & 3) + 8 * (r >> 2) + 4 * hi; }

struct AUnit { int qrow0, qcol, kcol, vcol, kbase, NT, seg2row, mode, pa, pb, head, ocol, outf32, has_sink; float sink; };

template <bool FIXREF = false> __device__ __forceinline__ void partialSM(f32x16& p0, f32x16& p1, float& m_reg, float& mn, float& alpha) {
  constexpr float C = SCALE * 1.4426950408889634f;
  if constexpr (FIXREF) { mn = m_reg; alpha = 1.f;
#pragma unroll
    for (int r = 0; r < 16; ++r) p0[r] = __builtin_amdgcn_exp2f(p0[r]);
    return; }
  float pmax = p0[0];
#pragma unroll
  for (int r = 1; r < 16; ++r) pmax = fmaxf(pmax, p0[r]);
#pragma unroll
  for (int r = 0; r < 16; ++r) pmax = fmaxf(pmax, p1[r]);
  { auto rr = __builtin_amdgcn_permlane32_swap(__float_as_uint(pmax), __float_as_uint(pmax), false, false);
    pmax = fmaxf(__uint_as_float(rr[0]), __uint_as_float(rr[1])); }
  if (__builtin_expect(__all(pmax - m_reg <= THR / SCALE), 1)) { mn = m_reg; alpha = 1.f; }
  else { mn = fmaxf(m_reg, pmax); alpha = __builtin_amdgcn_exp2f((m_reg - mn) * C); m_reg = mn; }
  float mnC = -mn * C;
#pragma unroll
  for (int r = 0; r < 16; ++r) p0[r] = fmaf(p0[r], C, mnC);
#pragma unroll
  for (int r = 0; r < 16; ++r) p1[r] = fmaf(p1[r], C, mnC);
#pragma unroll
  for (int r = 0; r < 16; ++r) p0[r] = __builtin_amdgcn_exp2f(p0[r]);
}
__device__ __forceinline__ void firstSM(f32x16& p0, f32x16& p1, float& m_reg) {
  float pmax = p0[0];
#pragma unroll
  for (int r = 1; r < 16; ++r) pmax = fmaxf(pmax, p0[r]);
#pragma unroll
  for (int r = 0; r < 16; ++r) pmax = fmaxf(pmax, p1[r]);
  { auto rr = __builtin_amdgcn_permlane32_swap(__float_as_uint(pmax), __float_as_uint(pmax), false, false);
    pmax = fmaxf(__uint_as_float(rr[0]), __uint_as_float(rr[1])); }
  m_reg = pmax;
#pragma unroll
  for (int r = 0; r < 16; ++r) p0[r] = __builtin_amdgcn_exp2f(p0[r] - pmax);
#pragma unroll
  for (int r = 0; r < 16; ++r) p1[r] -= pmax;
}
__device__ __forceinline__ void finishSM(f32x16& p0, f32x16& p1, float alpha, float& l_reg, bf16x8& pa0, bf16x8& pa1, bf16x8& pa2, bf16x8& pa3) {
#pragma unroll
  for (int r = 0; r < 16; ++r) p1[r] = __builtin_amdgcn_exp2f(p1[r]);
  float ps = 0;
#pragma unroll
  for (int r = 0; r < 16; ++r) ps += p0[r];
#pragma unroll
  for (int r = 0; r < 16; ++r) ps += p1[r];
  { auto rr = __builtin_amdgcn_permlane32_swap(__float_as_uint(ps), __float_as_uint(ps), false, false);
    ps = __uint_as_float(rr[0]) + __uint_as_float(rr[1]); }
  l_reg = l_reg * alpha + ps;
#define PK4(P, BASE, OUT) do { unsigned a0 = cvtpk(P[BASE + 0], P[BASE + 1]), a1 = cvtpk(P[BASE + 2], P[BASE + 3]);   \
    unsigned b0 = cvtpk(P[BASE + 4], P[BASE + 5]), b1 = cvtpk(P[BASE + 6], P[BASE + 7]);                              \
    auto r0 = __builtin_amdgcn_permlane32_swap(a0, b0, false, false); auto r1 = __builtin_amdgcn_permlane32_swap(a1, b1, false, false); \
    u32x4 w = {r0[0], r1[0], r0[1], r1[1]}; OUT = *reinterpret_cast<bf16x8*>(&w); } while (0)
  PK4(p0, 0, pa0); PK4(p0, 8, pa1); PK4(p1, 0, pa2); PK4(p1, 8, pa3);
#undef PK4
}
__device__ __forceinline__ void qkt(f32x16& p0, f32x16& p1, const LAS char* Ks, const bf16x8* qr, int r32, int hi, const f32x16& init) {
  p0 = init; p1 = init;
#pragma unroll
  for (int d0 = 0; d0 < 8; ++d0) { int cb = (d0 * 16 + hi * 8) * 2;
    bf16x8 b0 = *reinterpret_cast<const LAS bf16x8*>(Ks + KSWZ(r32, cb));
    bf16x8 b1 = *reinterpret_cast<const LAS bf16x8*>(Ks + KSWZ(32 + r32, cb));
    p0 = __builtin_amdgcn_mfma_f32_32x32x16_bf16(b0, qr[d0], p0, 0, 0, 0);
    p1 = __builtin_amdgcn_mfma_f32_32x32x16_bf16(b1, qr[d0], p1, 0, 0, 0); }
}
__device__ __forceinline__ int v_st(int k, int c) { const int kk = (k & ~0xC) | ((k & 4) << 1) | ((k & 8) >> 1); return ((kk >> 3) * 4 + (c >> 5)) * 512 + ((kk & 7) * 32 + (c & 31)) * 2; }
__device__ __forceinline__ int v_rd_base(int lane) { return ((lane & 3) << 3) | (((lane >> 2) & 3) << 6) | (((lane >> 4) & 1) << 5) | (((lane >> 5) & 1) << 8); }
constexpr int v_rd_off(int d0, int ks, int half) { return d0 * 512 + ks * 4096 + half * 2048; }
template <int OFF> __device__ __forceinline__ s16x4 tr_read(int vb) {
  s16x4 r; asm volatile("ds_read_b64_tr_b16 %0, %1 offset:%2" : "=&v"(r) : "v"(vb), "i"(OFF) : "memory"); return r;
}
template <int D0> __device__ __forceinline__ void pv_one(f32x16& od, int vb, bf16x8 pa0, bf16x8 pa1, bf16x8 pa2, bf16x8 pa3) {
  const s16x4 l0 = tr_read<v_rd_off(D0, 0, 0)>(vb), h0 = tr_read<v_rd_off(D0, 0, 1)>(vb), l1 = tr_read<v_rd_off(D0, 1, 0)>(vb), h1 = tr_read<v_rd_off(D0, 1, 1)>(vb);
  const s16x4 l2 = tr_read<v_rd_off(D0, 2, 0)>(vb), h2 = tr_read<v_rd_off(D0, 2, 1)>(vb), l3 = tr_read<v_rd_off(D0, 3, 0)>(vb), h3 = tr_read<v_rd_off(D0, 3, 1)>(vb);
  asm volatile("s_waitcnt lgkmcnt(0)" ::: "memory"); SBAR();
#define PK(L, H) (bf16x8){L[0], L[1], L[2], L[3], H[0], H[1], H[2], H[3]}
  od = __builtin_amdgcn_mfma_f32_32x32x16_bf16(pa0, PK(l0, h0), od, 0, 0, 0);
  od = __builtin_amdgcn_mfma_f32_32x32x16_bf16(pa1, PK(l1, h1), od, 0, 0, 0);
  od = __builtin_amdgcn_mfma_f32_32x32x16_bf16(pa2, PK(l2, h2), od, 0, 0, 0);
  od = __builtin_amdgcn_mfma_f32_32x32x16_bf16(pa3, PK(l3, h3), od, 0, 0, 0);
#undef PK
}
__device__ __forceinline__ void pv_d0(f32x16* o, int vb, bf16x8 pa0, bf16x8 pa1, bf16x8 pa2, bf16x8 pa3) {
  pv_one<0>(o[0], vb, pa0, pa1, pa2, pa3); pv_one<1>(o[1], vb, pa0, pa1, pa2, pa3); pv_one<2>(o[2], vb, pa0, pa1, pa2, pa3); pv_one<3>(o[3], vb, pa0, pa1, pa2, pa3);
}
template <int MODE> __device__ __forceinline__ void mask_tile(f32x16& p0, f32x16& p1, const AUnit& u, int j, int wid, int r32, int hi, const LAS float* btab) {
  if (MODE == 0 || j < 4) return;
  if (MODE == 1) {
    const int qpos = u.pa + wid * 32 + r32, k0 = u.pb + (j - 4) * 64 + 4 * hi;
#pragma unroll
    for (int r = 0; r < 16; ++r) { const int d = qpos - (k0 + (r & 3) + 8 * (r >> 2));
      p0[r] = (d <= 128 && d >= -128) ? p0[r] : -1e30f; const int d1 = d - 32; p1[r] = (d1 <= 128 && d1 >= -128) ? p1[r] : -1e30f; }
  } else {
    const int qr = u.pa + (wid >> 1), qc = (wid & 1) * 32 + r32, kr = u.pb + (j - 4);
    const int rs = min(max(qr - 4, 0), 56), cs = min(max(qc - 8, 0), 48);
    const bool rowok = (kr >= rs) && (kr < rs + 8);
    const LAS float* tb = btab + u.head * 480 + (kr - qr + 7) * 32 + (15 - qc) + 4 * hi;
#pragma unroll
    for (int r = 0; r < 16; ++r) { const int kc = (r & 3) + 8 * (r >> 2), kf = kc + 4 * hi;
      const float b0 = tb[kc], b1 = tb[kc + 32];
      p0[r] = (rowok && kf >= cs && kf < cs + 16) ? p0[r] + b0 : -1e30f;
      p1[r] = (rowok && kf + 32 >= cs && kf + 32 < cs + 16) ? p1[r] + b1 : -1e30f; }
  }
}

__device__ __forceinline__ void store_o8(unsigned char* Ow, const f32x16 (&o)[4], const float (&rli)[16], const int r32, const int hi) {
  const int qi = r32 & 3; const unsigned sel = (unsigned)qi | ((unsigned)(4 + qi) << 8) | 0x0c0c0000u;
  unsigned char* base = Ow + qi * 32 + (r32 & ~3);
#pragma unroll
  for (int r = 0; r < 16; ++r) { const float sc = rli[r] * O8_SCALE;
    int w = 0; w = __builtin_amdgcn_cvt_pk_fp8_f32(clamp_f8(o[0][r] * sc), clamp_f8(o[1][r] * sc), w, false); w = __builtin_amdgcn_cvt_pk_fp8_f32(clamp_f8(o[2][r] * sc), clamp_f8(o[3][r] * sc), w, true);
    const unsigned p0 = (unsigned)__builtin_amdgcn_update_dpp(0, w, 0x00, 0xf, 0xf, false), p1 = (unsigned)__builtin_amdgcn_update_dpp(0, w, 0x55, 0xf, 0xf, false);
    const unsigned p2 = (unsigned)__builtin_amdgcn_update_dpp(0, w, 0xaa, 0xf, 0xf, false), p3 = (unsigned)__builtin_amdgcn_update_dpp(0, w, 0xff, 0xf, 0xf, false);
    const unsigned t01 = __builtin_amdgcn_perm(p1, p0, sel), t23 = __builtin_amdgcn_perm(p3, p2, sel);
    *reinterpret_cast<unsigned*>(base + (size_t)crow(r, hi) * DM) = t01 | (t23 << 16); }
}
template <int MODE, int SDEPTH> __device__ __forceinline__ void attn_unit(const AUnit& u, const bf16_t* __restrict__ P, bf16_t* __restrict__ O, float* __restrict__ OB, LAS char* lds) {
  int tid = threadIdx.x; asm volatile("" : "+v"(tid));
  const int wid = tid >> 6, lane = tid & 63, r32 = lane & 31, hi = lane >> 5;
  LAS char* V_lds = lds; LAS char* K_lds = lds + NBUF * SHM_V;
  LAS float* ws = (LAS float*)(lds + NBUF * SHM_V + NBUF * SHM_K) + wid * 64; LAS float* li_l = ws; LAS float* al_l = ws + 32;
  const LAS float* btab = (const LAS float*)(lds + BIAS_OFF);
  float m_reg = -1e30f, l_reg = 0; f32x16 o[4] = {}; bf16x8 qr[8];
  const bf16_t* Qw = P + (size_t)(u.qrow0 + wid * QBLK + r32) * LDP + u.qcol + hi * 8;
#pragma unroll
  for (int d0 = 0; d0 < 8; ++d0) qr[d0] = *reinterpret_cast<const bf16x8*>(Qw + d0 * 16);
  f32x16 acc0 = {};
  {
    constexpr float C = SCALE * 1.4426950408889634f;
#pragma unroll
    for (int d0 = 0; d0 < 8; ++d0) { const u32x4 w = __builtin_bit_cast(u32x4, qr[d0]); u32x4 o_;
      o_.x = cvtpk(bflo(w.x) * C, bfhi(w.x) * C); o_.y = cvtpk(bflo(w.y) * C, bfhi(w.y) * C); o_.z = cvtpk(bflo(w.z) * C, bfhi(w.z) * C); o_.w = cvtpk(bflo(w.w) * C, bfhi(w.w) * C);
      qr[d0] = __builtin_bit_cast(bf16x8, o_); } }
  const char* Kh = (const char*)(P + (size_t)u.kbase * LDP + u.kcol); const char* Vh = (const char*)(P + (size_t)u.kbase * LDP + u.vcol);
  const int wv = __builtin_amdgcn_readfirstlane(tid >> 6);
  const unsigned koff0 = (unsigned)((tid >> 4) * (LDP * 2)) + (unsigned)(((tid & 15) * 16) ^ (((tid >> 4) & 7) << 4));
  const int vs_ = tid >> 5, vkk = (vs_ >> 2) * 8 + ((tid & 31) >> 2), vk0 = (vkk & ~0xC) | ((vkk & 4) << 1) | ((vkk & 8) >> 1), vc0 = (vs_ & 3) * 32 + (tid & 3) * 8;
  const unsigned voff0 = (unsigned)(vk0 * (LDP * 2)) + (unsigned)(vc0 * 2);
  constexpr unsigned RS32 = 32u * LDP * 2u;
  const int vb0 = (int)(unsigned)(uintptr_t)V_lds + v_rd_base(lane);
#define KROW(j) ((j) < 4 ? (j) * 64 : u.seg2row + ((j) - 4) * 64)
#define GLDS(gp, lp) __builtin_amdgcn_global_load_lds((const unsigned*)(gp), (LAS unsigned*)(lp), 16, 0, 0)
#define DMA(slot, k0) do { const size_t _kb = (size_t)(k0) * (LDP * 2); LAS char* _kd = K_lds + (slot) * SHM_K + wv * 1024; LAS char* _vd = V_lds + (slot) * SHM_V + wv * 1024; \
    GLDS(Kh + _kb + koff0, _kd); GLDS(Kh + _kb + koff0 + RS32, _kd + 8192); GLDS(Vh + _kb + voff0, _vd); GLDS(Vh + _kb + voff0 + RS32, _vd + 8192); } while (0)
#define DWAIT() asm volatile("s_waitcnt vmcnt(0)" ::: "memory")
#define RESC(a) do { if (__any((a) < 1.f)) { if (hi == 0) al_l[r32] = (a); asm volatile("s_waitcnt lgkmcnt(0)" ::: "memory"); \
    _Pragma("unroll") for (int d = 0; d < 4; ++d) _Pragma("unroll") for (int r = 0; r < 16; ++r) o[d][r] *= al_l[crow(r, hi)]; } } while (0)
  f32x16 pA0, pA1, pB0, pB1; float mnA, mnB, alA, alB; bf16x8 pa0, pa1, pa2, pa3; const int NT = u.NT;
  int bp = 0, bc = 1, bn = 2;
  DMA(0, 0); DWAIT(); __syncthreads();
  qkt(pA0, pA1, K_lds, qr, r32, hi, acc0);
  { firstSM(pA0, pA1, m_reg); mnA = m_reg; alA = 1.f;
#pragma unroll
    for (int r = 0; r < 16; ++r) acc0[r] = -m_reg; }
  DMA(1, KROW(1)); DWAIT(); __syncthreads();
#define TILE_OK(j_) (MODE != 2 || (j_) < 4 || (u.pb + (j_) - 4 >= nb_rs && u.pb + (j_) - 4 < nb_rs + 8))
  const int nb_rs = min(max(u.pa + (wv >> 1) - 4, 0), 56);
  bool okA = true, okB = true;
  for (int j = 1; j + 1 < NT; j += 2) {
    DMA(bn, KROW(j + 1));
    okB = TILE_OK(j);
    SBAR(); if (okB) qkt(pB0, pB1, K_lds + bc * SHM_K, qr, r32, hi, acc0);
    if (okA) { finishSM(pA0, pA1, alA, l_reg, pa0, pa1, pa2, pa3); SBAR();
      pv_d0(o, vb0 + bp * (int)SHM_V, pa0, pa1, pa2, pa3); }
    if (okB) { mask_tile<MODE>(pB0, pB1, u, j, wid, r32, hi, btab); partialSM<true>(pB0, pB1, m_reg, mnB, alB); }
    DWAIT(); __syncthreads();
    bp = bc; bc = bn; bn = (bn == NBUF - 1) ? 0 : bn + 1;
    if (j + 2 < NT) DMA(bn, KROW(j + 2));
    okA = TILE_OK(j + 1);
    SBAR(); if (okA) qkt(pA0, pA1, K_lds + bc * SHM_K, qr, r32, hi, acc0);
    if (okB) { finishSM(pB0, pB1, alB, l_reg, pa0, pa1, pa2, pa3); SBAR();
      pv_d0(o, vb0 + bp * (int)SHM_V, pa0, pa1, pa2, pa3); }
    if (okA) { mask_tile<MODE>(pA0, pA1, u, j + 1, wid, r32, hi, btab); partialSM<true>(pA0, pA1, m_reg, mnA, alA); }
    DWAIT(); __syncthreads();
    bp = bc; bc = bn; bn = (bn == NBUF - 1) ? 0 : bn + 1;
  }
  okB = TILE_OK(NT - 1);
  SBAR(); if (okB) qkt(pB0, pB1, K_lds + bc * SHM_K, qr, r32, hi, acc0);
  if (okA) { finishSM(pA0, pA1, alA, l_reg, pa0, pa1, pa2, pa3); SBAR();
    pv_d0(o, vb0 + bp * (int)SHM_V, pa0, pa1, pa2, pa3); }
  if (okB) { mask_tile<MODE>(pB0, pB1, u, NT - 1, wid, r32, hi, btab); partialSM<true>(pB0, pB1, m_reg, mnB, alB);
    finishSM(pB0, pB1, alB, l_reg, pa0, pa1, pa2, pa3); SBAR();
    pv_d0(o, vb0 + bc * (int)SHM_V, pa0, pa1, pa2, pa3); }
#undef TILE_OK
  if (u.has_sink) l_reg += __builtin_amdgcn_exp2f(u.sink * 1.4426950408889634f - m_reg);
  if (hi == 0) li_l[r32] = l_reg; asm volatile("s_waitcnt lgkmcnt(0)" ::: "memory");
  float rli[16];
#pragma unroll
  for (int r = 0; r < 16; ++r) rli[r] = __builtin_amdgcn_rcpf(li_l[crow(r, hi)]);
  if (u.outf32) {
    float* Ow = OB + (size_t)(u.qrow0 + wid * QBLK) * DM + u.ocol;
#pragma unroll
    for (int r = 0; r < 16; ++r) { const int orow = crow(r, hi);
#pragma unroll
      for (int d0 = 0; d0 < 4; ++d0) Ow[(size_t)orow * DM + d0 * 32 + r32] = o[d0][r] * rli[r]; }
  } else {
    if constexpr (MODE == 2) {
      store_o8(reinterpret_cast<unsigned char*>(O) + (size_t)(u.qrow0 + wid * QBLK) * DM + u.ocol, o, rli, r32, hi);
    } else {
    bf16_t* Ow = O + (size_t)(u.qrow0 + wid * QBLK) * DM + u.ocol;
#pragma unroll
    for (int r = 0; r < 16; ++r) { const int orow = crow(r, hi);
#pragma unroll
      for (int d0 = 0; d0 < 4; ++d0) { const float v = o[d0][r] * rli[r]; Ow[(size_t)orow * DM + d0 * 32 + r32] = (bf16_t)(cvtpk(v, v) & 0xffffu); } }
    }
  }
  __syncthreads();
#undef KROW
#undef GLDS
#undef DMA
#undef DWAIT
#undef RESC
}
constexpr int SHM8 = 8192;
__device__ __forceinline__ void mfma8_32(f32x16& acc, const i32x8 a, const i32x8 b) { asm volatile("v_mfma_f32_32x32x64_f8f6f4 %0, %1, %2, %0" : "+v"(acc) : "v"(a), "v"(b)); }
__device__ __forceinline__ i32x8 cat8(const i32x4 a, const i32x4 b) { return __builtin_shufflevector(a, b, 0, 1, 2, 3, 4, 5, 6, 7); }
__device__ __forceinline__ int cvt4_f8(float a, float b, float c, float d) { int w = 0; w = __builtin_amdgcn_cvt_pk_fp8_f32(a, b, w, false); w = __builtin_amdgcn_cvt_pk_fp8_f32(c, d, w, true); return w; }
__device__ __forceinline__ void mfma8_32c(f32x16& d, const i32x8 a, const i32x8 b, const f32x16& c) { asm volatile("v_mfma_f32_32x32x64_f8f6f4 %0, %1, %2, %3" : "=&v"(d) : "v"(a), "v"(b), "v"(c)); }
__device__ __forceinline__ void kfrag8(i32x8 (&kf)[4], const LAS char* Ks, int r32, int hi) {
  const int x0 = r32 & 7; const LAS char* k0 = Ks + r32 * 128; const LAS char* k1 = k0 + 32 * 128;
#define KF8(kp, s) cat8(*reinterpret_cast<const LAS i32x4*>((kp) + (((4 * (s) + 2 * hi) ^ x0) << 4)), *reinterpret_cast<const LAS i32x4*>((kp) + (((4 * (s) + 2 * hi + 1) ^ x0) << 4)))
  kf[0] = KF8(k0, 0); kf[1] = KF8(k1, 0); kf[2] = KF8(k0, 1); kf[3] = KF8(k1, 1);
#undef KF8
}
__device__ __forceinline__ void qkmma8(f32x16& p0, f32x16& p1, const i32x8 (&kf)[4], const i32x8 (&q8)[2], const f32x16& init) {
  mfma8_32c(p0, kf[0], q8[0], init); mfma8_32c(p1, kf[1], q8[0], init); mfma8_32(p0, kf[2], q8[1]); mfma8_32(p1, kf[3], q8[1]);
}
__device__ __forceinline__ void qkt8(f32x16& p0, f32x16& p1, const LAS char* Ks, const i32x8 (&q8)[2], int r32, int hi, const f32x16& init) {
  i32x8 kf[4]; kfrag8(kf, Ks, r32, hi); qkmma8(p0, p1, kf, q8, init);
}
__device__ __forceinline__ void finishSM8(f32x16& p0, f32x16& p1, float& l_reg, i32x8& pf) {
#pragma unroll
  for (int r = 0; r < 16; ++r) p1[r] = __builtin_amdgcn_exp2f(p1[r]);
  float ps = 0;
#pragma unroll
  for (int r = 0; r < 16; ++r) ps += p0[r];
#pragma unroll
  for (int r = 0; r < 16; ++r) ps += p1[r];
  { auto rr = __builtin_amdgcn_permlane32_swap(__float_as_uint(ps), __float_as_uint(ps), false, false);
    ps = __uint_as_float(rr[0]) + __uint_as_float(rr[1]); }
  l_reg += ps;
#pragma unroll
  for (int i = 0; i < 4; ++i) { pf[i] = cvt4_f8(p0[4 * i], p0[4 * i + 1], p0[4 * i + 2], p0[4 * i + 3]); pf[4 + i] = cvt4_f8(p1[4 * i], p1[4 * i + 1], p1[4 * i + 2], p1[4 * i + 3]); }
}
__device__ __forceinline__ void vfrag8(i32x8 (&vf)[4], const LAS char* Vs, int r32, int hi) {
  const int xs = (r32 >> 1) & 3; const LAS char* vp = Vs + r32 * 64;
#pragma unroll
  for (int d0 = 0; d0 < 4; ++d0) vf[d0] = cat8(*reinterpret_cast<const LAS i32x4*>(vp + d0 * 2048 + (((2 * hi) ^ xs) << 4)), *reinterpret_cast<const LAS i32x4*>(vp + d0 * 2048 + (((2 * hi + 1) ^ xs) << 4)));
}
__device__ __forceinline__ void pvmma8(f32x16* o, const i32x8 (&vf)[4], const i32x8 pf) {
#pragma unroll
  for (int d0 = 0; d0 < 4; ++d0) mfma8_32(o[d0], pf, vf[d0]);
}
__device__ __forceinline__ void pv8(f32x16* o, const LAS char* Vs, const i32x8 pf, int r32, int hi) { i32x8 vf[4]; vfrag8(vf, Vs, r32, hi); pvmma8(o, vf, pf); }
template <int MODE> __device__ __forceinline__ void attn_unit_c8(const AUnit& u, const bf16_t* __restrict__ P, const unsigned char* __restrict__ Kh, const unsigned char* __restrict__ Vh, const float* __restrict__ qn, bf16_t* __restrict__ O, LAS char* lds) {
  int tid = threadIdx.x; asm volatile("" : "+v"(tid));
  const int wid = tid >> 6, lane = tid & 63, r32 = lane & 31, hi = lane >> 5;
  const int wv = __builtin_amdgcn_readfirstlane(tid >> 6);
  LAS char* V_lds = lds; LAS char* K_lds = lds + 6 * SHM8;
  LAS float* li_l = (LAS float*)(lds + 12 * SHM8) + wid * 64;
  float m_reg = -1e30f, l_reg = 0; f32x16 o[4] = {}; i32x8 q8[2];
  if constexpr (MODE != 0) {
    const bf16_t* Qw = P + (size_t)(u.qrow0 + wid * QBLK + r32) * LDP + u.qcol + hi * 32; constexpr float C = SCALE * 1.4426950408889634f;
#pragma unroll
    for (int s = 0; s < 2; ++s)
#pragma unroll
      for (int c = 0; c < 4; ++c) { const u32x4 w = *reinterpret_cast<const u32x4*>(Qw + s * 64 + c * 8);
        q8[s][2 * c] = cvt4_f8(bflo(w.x) * C, bfhi(w.x) * C, bflo(w.y) * C, bfhi(w.y) * C); q8[s][2 * c + 1] = cvt4_f8(bflo(w.z) * C, bfhi(w.z) * C, bflo(w.w) * C, bfhi(w.w) * C); }
  } else
  { const bf16_t* Qw = P + (size_t)(u.qrow0 + wid * QBLK + r32) * LDP + u.qcol + hi * 16; constexpr float C = SCALE * 1.4426950408889634f;
    float xa[2][16], xb[2][16]; float ss = 0.f;
#pragma unroll
    for (int s = 0; s < 2; ++s)
#pragma unroll
      for (int c = 0; c < 2; ++c) { const u32x4 wa = *reinterpret_cast<const u32x4*>(Qw + s * 64 + c * 8), wb = *reinterpret_cast<const u32x4*>(Qw + s * 64 + 32 + c * 8);
        xa[s][8 * c + 0] = bflo(wa.x); xa[s][8 * c + 1] = bfhi(wa.x); xa[s][8 * c + 2] = bflo(wa.y); xa[s][8 * c + 3] = bfhi(wa.y); xa[s][8 * c + 4] = bflo(wa.z); xa[s][8 * c + 5] = bfhi(wa.z); xa[s][8 * c + 6] = bflo(wa.w); xa[s][8 * c + 7] = bfhi(wa.w);
        xb[s][8 * c + 0] = bflo(wb.x); xb[s][8 * c + 1] = bfhi(wb.x); xb[s][8 * c + 2] = bflo(wb.y); xb[s][8 * c + 3] = bfhi(wb.y); xb[s][8 * c + 4] = bflo(wb.z); xb[s][8 * c + 5] = bfhi(wb.z); xb[s][8 * c + 6] = bflo(wb.w); xb[s][8 * c + 7] = bfhi(wb.w); }
#pragma unroll
    for (int s = 0; s < 2; ++s)
#pragma unroll
      for (int j = 0; j < 16; ++j) ss += xa[s][j] * xa[s][j] + xb[s][j] * xb[s][j];
    { auto rr = __builtin_amdgcn_permlane32_swap(__float_as_uint(ss), __float_as_uint(ss), false, false); ss = __uint_as_float(rr[0]) + __uint_as_float(rr[1]); }
    const float rq = rsqrtf(ss * (1.f / 128.f) + EPS) * C;
    const int pos = u.pa + wid * QBLK + r32;
#pragma unroll
    for (int s = 0; s < 2; ++s) { const float pp = (float)(s == 0 ? (pos >> 6) : (pos & 63));
#pragma unroll
      for (int j = 0; j < 16; ++j) { const float ga = qn[64 * s + 16 * hi + j], gb = qn[64 * s + 32 + 16 * hi + j];
        const float ang = pp * exp2f(-(float)(16 * hi + j) * (13.287712379549449f / 32.f)); const float cs_ = __cosf(ang), sn_ = __sinf(ang);
        const float a = xa[s][j] * rq * ga, b = xb[s][j] * rq * gb; xa[s][j] = a * cs_ - b * sn_; xb[s][j] = b * cs_ + a * sn_; }
#pragma unroll
      for (int i = 0; i < 4; ++i) { q8[s][i] = cvt4_f8(xa[s][4 * i], xa[s][4 * i + 1], xa[s][4 * i + 2], xa[s][4 * i + 3]); q8[s][4 + i] = cvt4_f8(xb[s][4 * i], xb[s][4 * i + 1], xb[s][4 * i + 2], xb[s][4 * i + 3]); } } }
  const unsigned koff = (unsigned)((tid >> 3) * 128 + (((tid & 7) ^ ((tid >> 3) & 7)) << 4));
  const unsigned voff = (unsigned)((tid >> 2) * 64 + (((tid & 3) ^ ((tid >> 3) & 3)) << 4));
#define GLDS(gp, lp) __builtin_amdgcn_global_load_lds((const unsigned*)(gp), (LAS unsigned*)(lp), 16, 0, 0)
  const int tb = MODE == 1 ? (u.seg2row >> 6) - 4 : 0;
#define DMA8(ss_, j_) do { _Pragma("unroll") for (int _h = 0; _h < 2; ++_h) { const int _j = (j_) + _h, _t = _j < 4 ? _j : _j + tb; \
    GLDS(Kh + (size_t)_t * 8192 + koff, K_lds + ((ss_) * 2 + _h) * SHM8 + wv * 1024); GLDS(Vh + (size_t)_t * 8192 + voff, V_lds + ((ss_) * 2 + _h) * SHM8 + wv * 1024); } } while (0)
#define MASK8(p0_, p1_, j_) do { if constexpr (MODE == 1) mask_tile<1>(p0_, p1_, u, (j_), wid, r32, hi, (const LAS float*)nullptr); } while (0)
#define DWAIT() asm volatile("s_waitcnt vmcnt(0)" ::: "memory")
#define EXP16(p_) do { _Pragma("unroll") for (int r = 0; r < 16; ++r) p_[r] = __builtin_amdgcn_exp2f(p_[r]); } while (0)
  f32x16 pA0, pA1, pB0, pB1, acc0 = {}; i32x8 pf; const int NT = u.NT;
  DMA8(0, 0); DMA8(1, 2); DWAIT(); __syncthreads();
  qkt8(pA0, pA1, K_lds, q8, r32, hi, acc0);
  asm volatile("s_nop 7\n\ts_nop 7\n\ts_nop 7\n\ts_nop 7\n\ts_nop 7\n\ts_nop 7" : "+v"(pA0), "+v"(pA1));
  firstSM(pA0, pA1, m_reg);
#pragma unroll
  for (int r = 0; r < 16; ++r) acc0[r] = -m_reg;
  int s0 = 0, s1 = 1, s2 = 2;
  for (int j = 1; j + 1 < NT; j += 2) {
    if (j + 3 < NT) DMA8(s2, j + 3);
    { i32x8 vf[4]; SBAR(); { i32x8 kf[4]; kfrag8(kf, K_lds + (s0 * 2 + 1) * SHM8, r32, hi); qkmma8(pB0, pB1, kf, q8, acc0); }
      vfrag8(vf, V_lds + (s0 * 2) * SHM8, r32, hi);
      finishSM8(pA0, pA1, l_reg, pf); SBAR();
      pvmma8(o, vf, pf); }
    MASK8(pB0, pB1, j); EXP16(pB0);
    { i32x8 vf[4]; SBAR(); { i32x8 kf[4]; kfrag8(kf, K_lds + (s1 * 2) * SHM8, r32, hi); qkmma8(pA0, pA1, kf, q8, acc0); }
      vfrag8(vf, V_lds + (s0 * 2 + 1) * SHM8, r32, hi);
      finishSM8(pB0, pB1, l_reg, pf); SBAR();
      pvmma8(o, vf, pf); }
    MASK8(pA0, pA1, j + 1); EXP16(pA0);
    DWAIT(); __syncthreads();
    { const int t_ = s0; s0 = s1; s1 = s2; s2 = t_; }
  }
  SBAR(); qkt8(pB0, pB1, K_lds + (s0 * 2 + 1) * SHM8, q8, r32, hi, acc0);
  finishSM8(pA0, pA1, l_reg, pf); SBAR();
  pv8(o, V_lds + (s0 * 2) * SHM8, pf, r32, hi);
  MASK8(pB0, pB1, NT - 1); EXP16(pB0);
  finishSM8(pB0, pB1, l_reg, pf); SBAR();
  pv8(o, V_lds + (s0 * 2 + 1) * SHM8, pf, r32, hi);
  asm volatile("s_nop 7\n\ts_nop 7\n\ts_nop 7\n\ts_nop 7\n\ts_nop 7\n\ts_nop 7" : "+v"(o[0]), "+v"(o[1]), "+v"(o[2]), "+v"(o[3]));
  if (MODE == 1 && u.has_sink) l_reg += __builtin_amdgcn_exp2f(u.sink * 1.4426950408889634f - m_reg);
  if (hi == 0) li_l[r32] = l_reg; asm volatile("s_waitcnt lgkmcnt(0)" ::: "memory");
  float rli[16];
#pragma unroll
  for (int r = 0; r < 16; ++r) rli[r] = __builtin_amdgcn_rcpf(li_l[crow(r, hi)]);
  if constexpr (MODE == 3) { float* Ow = reinterpret_cast<float*>(O) + (size_t)(u.qrow0 + wid * QBLK) * DM + u.ocol;
#pragma unroll
    for (int r = 0; r < 16; ++r) { const int orow = crow(r, hi);
#pragma unroll
      for (int d0 = 0; d0 < 4; ++d0) Ow[(size_t)orow * DM + d0 * 32 + r32] = o[d0][r] * rli[r]; }
  } else
  if constexpr (MODE == 1) { bf16_t* Ow = O + (size_t)(u.qrow0 + wid * QBLK) * DM + u.ocol;
#pragma unroll
    for (int r = 0; r < 16; ++r) { const int orow = crow(r, hi);
#pragma unroll
      for (int d0 = 0; d0 < 4; ++d0) { const float v = o[d0][r] * rli[r]; Ow[(size_t)orow * DM + d0 * 32 + r32] = (bf16_t)(cvtpk(v, v) & 0xffffu); } }
  } else
  store_o8(reinterpret_cast<unsigned char*>(O) + (size_t)(u.qrow0 + wid * QBLK) * DM + u.ocol, o, rli, r32, hi);
  __syncthreads();
#undef GLDS
#undef DMA8
#undef MASK8
#undef DWAIT
#undef EXP16
}
__device__ __forceinline__ void attn_unit_b(const AUnit& u, const bf16_t* __restrict__ P, float* __restrict__ OB, LAS char* lds) {
  int tid = threadIdx.x; asm volatile("" : "+v"(tid));
  const int lane = tid & 63, r32 = lane & 31, hi = lane >> 5;
  const int wv = __builtin_amdgcn_readfirstlane(tid >> 6), rg = wv & 3, kh = wv >> 2;
  LAS char* K_lds = lds; LAS char* V_lds = lds + 2 * SHM_K;
  LAS char* Pex = lds + 2 * SHM_K + 4 * SHM_V;
  LAS float* st = (LAS float*)(lds + 2 * SHM_K + 4 * SHM_V + 2 * 8 * 2048);
  f32x16 o[4] = {}; bf16x8 qr[8];
  { const bf16_t* Qw = P + (size_t)(u.qrow0 + rg * QBLK + r32) * LDP + u.qcol + hi * 8; constexpr float C = SCALE * 1.4426950408889634f;
#pragma unroll
    for (int d0 = 0; d0 < 8; ++d0) { const u32x4 w = __builtin_bit_cast(u32x4, *reinterpret_cast<const bf16x8*>(Qw + d0 * 16)); u32x4 o_;
      o_.x = cvtpk(bflo(w.x) * C, bfhi(w.x) * C); o_.y = cvtpk(bflo(w.y) * C, bfhi(w.y) * C); o_.z = cvtpk(bflo(w.z) * C, bfhi(w.z) * C); o_.w = cvtpk(bflo(w.w) * C, bfhi(w.w) * C);
      qr[d0] = __builtin_bit_cast(bf16x8, o_); } }
  const char* Kh = (const char*)(P + (size_t)u.kbase * LDP + u.kcol); const char* Vh = (const char*)(P + (size_t)u.kbase * LDP + u.vcol);
  const unsigned koff0 = (unsigned)((tid >> 4) * (LDP * 2)) + (unsigned)(((tid & 15) * 16) ^ (((tid >> 4) & 7) << 4));
  const int vs_ = tid >> 5, vkk = (vs_ >> 2) * 8 + ((tid & 31) >> 2), vk0 = (vkk & ~0xC) | ((vkk & 4) << 1) | ((vkk & 8) >> 1), vc0 = (vs_ & 3) * 32 + (tid & 3) * 8;
  const unsigned voff0 = (unsigned)(vk0 * (LDP * 2)) + (unsigned)(vc0 * 2);
  constexpr unsigned RS32 = 32u * LDP * 2u;
  const int vrd = (int)(unsigned)(uintptr_t)V_lds + kh * (int)SHM_V + v_rd_base(lane);
#define GLDS(gp, lp) __builtin_amdgcn_global_load_lds((const unsigned*)(gp), (LAS unsigned*)(lp), 16, 0, 0)
#define DMAK(slot, k0) do { const size_t _kb = (size_t)(k0) * (LDP * 2); LAS char* _kd = K_lds + (slot) * SHM_K + wv * 1024; GLDS(Kh + _kb + koff0, _kd); GLDS(Kh + _kb + koff0 + RS32, _kd + 8192); } while (0)
#define DMAV(slot, k0) do { const size_t _kb = (size_t)(k0) * (LDP * 2); LAS char* _vd = V_lds + (slot) * (2 * SHM_V) + wv * 1024; \
    GLDS(Vh + _kb + voff0, _vd); GLDS(Vh + _kb + voff0 + RS32, _vd + 8192); GLDS(Vh + _kb + voff0 + 256, _vd + SHM_V); GLDS(Vh + _kb + voff0 + RS32 + 256, _vd + SHM_V + 8192); } while (0)
#define DWAIT() asm volatile("s_waitcnt vmcnt(0)" ::: "memory")
#define LWAIT() asm volatile("s_waitcnt lgkmcnt(0)" ::: "memory")
#define QKH(s_, ks, init_) do { f32x16 _s1 = {}; s_ = init_; const LAS char* _K = K_lds + (ks) * SHM_K; bf16x8 _kf[8]; \
    _Pragma("unroll") for (int d0 = 0; d0 < 8; ++d0) _kf[d0] = *reinterpret_cast<const LAS bf16x8*>(_K + KSWZ(kh * 32 + r32, (d0 * 16 + hi * 8) * 2)); \
    _Pragma("unroll") for (int d0 = 0; d0 < 8; d0 += 2) { s_ = __builtin_amdgcn_mfma_f32_32x32x16_bf16(_kf[d0], qr[d0], s_, 0, 0, 0); _s1 = __builtin_amdgcn_mfma_f32_32x32x16_bf16(_kf[d0 + 1], qr[d0 + 1], _s1, 0, 0, 0); } \
    _Pragma("unroll") for (int r = 0; r < 16; ++r) s_[r] += _s1[r]; } while (0)
#define PK4(Pv, BASE, OUT) do { unsigned a0 = cvtpk(Pv[BASE + 0], Pv[BASE + 1]), a1 = cvtpk(Pv[BASE + 2], Pv[BASE + 3]);   \
    unsigned b0 = cvtpk(Pv[BASE + 4], Pv[BASE + 5]), b1 = cvtpk(Pv[BASE + 6], Pv[BASE + 7]);                              \
    auto r0 = __builtin_amdgcn_permlane32_swap(a0, b0, false, false); auto r1 = __builtin_amdgcn_permlane32_swap(a1, b1, false, false); \
    u32x4 w = {r0[0], r1[0], r0[1], r1[1]}; OUT = *reinterpret_cast<bf16x8*>(&w); } while (0)
#define SOFT_PUB(s_, f0_, f1_, par) do { _Pragma("unroll") for (int r = 0; r < 16; ++r) { s_[r] = __builtin_amdgcn_exp2f(s_[r]); lsum += s_[r]; } \
    PK4(s_, 0, f0_); PK4(s_, 8, f1_); LAS char* _px = Pex + (par) * 16384 + wv * 2048 + lane * 16; *(LAS bf16x8*)_px = f0_; *(LAS bf16x8*)(_px + 1024) = f1_; } while (0)
  const int NT = u.NT; float lsum = 0.f; bf16x8 own0, own1; f32x16 sc, acc0 = {};
  DMAK(0, 0); DMAV(0, 0); DMAK(1, 64); DWAIT(); __syncthreads();
  QKH(sc, 0, acc0);
  { float pmax = sc[0];
#pragma unroll
    for (int r = 1; r < 16; ++r) pmax = fmaxf(pmax, sc[r]);
    { auto rr = __builtin_amdgcn_permlane32_swap(__float_as_uint(pmax), __float_as_uint(pmax), false, false); pmax = fmaxf(__uint_as_float(rr[0]), __uint_as_float(rr[1])); }
    if (hi == 0) st[wv * 64 + r32] = pmax; LWAIT(); __syncthreads();
    const float mref = fmaxf(pmax, st[(wv ^ 4) * 64 + r32]); LWAIT();
#pragma unroll
    for (int r = 0; r < 16; ++r) { acc0[r] = -mref; sc[r] -= mref; } }
  SOFT_PUB(sc, own0, own1, 0);
  LWAIT(); __syncthreads();
  for (int j = 0; j < NT; ++j) {
    if (j + 2 < NT) DMAK(j & 1, (j + 2) * 64);
    if (j + 1 < NT) DMAV((j + 1) & 1, (j + 1) * 64);
    const LAS char* _pq = Pex + (j & 1) * 16384 + (wv ^ 4) * 2048 + lane * 16;
    const bf16x8 q0 = *(const LAS bf16x8*)_pq, q1 = *(const LAS bf16x8*)(_pq + 1024);
    const bf16x8 pa0 = kh ? q0 : own0, pa1 = kh ? q1 : own1, pa2 = kh ? own0 : q0, pa3 = kh ? own1 : q1;
    pv_d0(o, vrd + (j & 1) * (2 * (int)SHM_V), pa0, pa1, pa2, pa3);
    if (j + 1 < NT) { QKH(sc, (j + 1) & 1, acc0); SOFT_PUB(sc, own0, own1, (j + 1) & 1); }
    LWAIT(); DWAIT(); __syncthreads();
  }
  { auto rr = __builtin_amdgcn_permlane32_swap(__float_as_uint(lsum), __float_as_uint(lsum), false, false); lsum = __uint_as_float(rr[0]) + __uint_as_float(rr[1]); }
  if (hi == 0) st[wv * 64 + r32] = lsum; LWAIT(); __syncthreads();
  float rli[16];
#pragma unroll
  for (int r = 0; r < 16; ++r) rli[r] = __builtin_amdgcn_rcpf(st[wv * 64 + crow(r, hi)] + st[(wv ^ 4) * 64 + crow(r, hi)]);
  float* Ow = OB + (size_t)(u.qrow0 + rg * QBLK) * DM + u.ocol + kh * 128;
#pragma unroll
  for (int r = 0; r < 16; ++r) { const int orow = crow(r, hi);
#pragma unroll
    for (int d0 = 0; d0 < 4; ++d0) Ow[(size_t)orow * DM + d0 * 32 + r32] = o[d0][r] * rli[r]; }
  LWAIT(); __syncthreads();
#undef GLDS
#undef DMAK
#undef DMAV
#undef DWAIT
#undef LWAIT
#undef QKH
#undef PK4
#undef SOFT_PUB
}
}

struct Ctx {
    LAS unsigned char* lds; int tid, lane, wave, G, bid, gw, NGW;
    float* mod; float* affl; float* affc; int* rows; float* gate; int* slot; float* xc; float* sax; float* sah; float* sas; float* wsc; float* shd; signed char* hid8; float* so; signed char* o8; bf16_t* dlt;
    bf16_t *win, *wout, *wgu, *wdn, *r1, *r2, *hid, *y; float* ob; unsigned char* y8; unsigned char* k8; unsigned char* v8; unsigned char* k8d; unsigned char* v8d;
};

__device__ __forceinline__ Ctx make_ctx(const Params& p, LAS unsigned char* lds) {
    Ctx F; int tid = threadIdx.x; asm volatile("" : "+v"(tid));
    unsigned long long wsb = (unsigned long long)p.ws; asm volatile("" : "+s"(wsb)); __attribute__((address_space(1))) unsigned char* ws = (__attribute__((address_space(1))) unsigned char*)wsb;
    int bid = blockIdx.x; asm volatile("" : "+s"(bid));
    F.lds = lds; F.tid = tid; F.lane = tid & 63; F.wave = __builtin_amdgcn_readfirstlane(tid >> 6);
    F.G = gridDim.x; F.bid = bid; F.gw = bid * NWAVES + F.wave; F.NGW = F.G * NWAVES;
    F.mod = (float*)(ws + WS_MOD); F.affl = (float*)(ws + WS_AFFL); F.affc = (float*)(ws + WS_AFFC); F.rows = (int*)(ws + WS_ROWS); F.gate = (float*)(ws + WS_GATE);
    F.slot = (int*)(ws + WS_SLOT); F.xc = (float*)(ws + WS_XC); F.sax = (float*)(ws + WS_SAX); F.sah = (float*)(ws + WS_SAH); F.sas = (float*)(ws + WS_SAS); F.wsc = (float*)(ws + WS_WSC); F.shd = (float*)(ws + WS_SHD); F.hid8 = (signed char*)(ws + WS_R2 + 204 * MiB); F.so = (float*)(ws + WS_SO); F.o8 = (signed char*)(ws + WS_R3); F.dlt = (bf16_t*)(ws + WS_DLT);
    F.win = (bf16_t*)(ws + WS_WIN); F.wout = (bf16_t*)(ws + WS_WOUT); F.wgu = (bf16_t*)(ws + WS_WGU); F.wdn = (bf16_t*)(ws + WS_WDN);
    F.r1 = (bf16_t*)(ws + WS_R1); F.r2 = (bf16_t*)(ws + WS_R2); F.hid = (bf16_t*)(ws + WS_R2); F.y = (bf16_t*)(ws + WS_R3); F.y8 = (unsigned char*)(ws + WS_R3); F.k8 = (unsigned char*)(ws + WS_K8); F.v8 = (unsigned char*)(ws + WS_V8); F.k8d = (unsigned char*)(ws + WS_K8D); F.v8d = (unsigned char*)(ws + WS_V8D); F.ob = (float*)(ws + WS_R3);
    return F;
}
__device__ __forceinline__ void transpose_item_i8(const float* __restrict__ src, int K, int N, signed char* __restrict__ dst, int rs, int roff, LAS float* scr, int idx, int lane, const float inv, const bool f8 = false) {
    const int nblk = N >> 6, kb = idx / nblk, nb = idx - kb * nblk, k0 = kb * 64, n0 = nb * 64;
    const int kr = lane >> 4, nc = (lane & 15) * 4;
    const float* s = src + (size_t)(k0 + kr) * N + n0 + nc;
    f32x4 v[16];
#pragma unroll
    for (int i = 0; i < 16; ++i) v[i] = __builtin_nontemporal_load((const f32x4*)(s + (size_t)(4 * i) * N));
#pragma unroll
    for (int i = 0; i < 16; ++i) { LAS float* q = scr + (kr + 4 * i) * 65 + nc; q[0] = v[i].x; q[1] = v[i].y; q[2] = v[i].z; q[3] = v[i].w; }
    LDS_WAIT();
    const int c = lane & 3;
#pragma unroll
    for (int j = 0; j < 4; ++j) { const int n = (lane >> 2) + 16 * j; const LAS float* q = scr + (16 * c) * 65 + n;
        u32x4 o; o.x = pack_q4(q[0], q[65], q[130], q[195], inv, f8); o.y = pack_q4(q[260], q[325], q[390], q[455], inv, f8);
        o.z = pack_q4(q[520], q[585], q[650], q[715], inv, f8); o.w = pack_q4(q[780], q[845], q[910], q[975], inv, f8);
        const int ng = n0 + n; int row;
        if (rs > 0) row = (ng >> 2) * rs + roff + (ng & 3);
        else { const bool roped = ng < 1280 || (ng >= 1536 && ng < 3584); const int d = ng & 127;
            row = roped ? (ng & ~127) + (d & 64) + ((d & 31) >> 2) * 8 + ((d >> 5) & 1) * 4 + (d & 3) : ng; }
        *(u32x4*)(dst + (size_t)row * K + k0 + 16 * c) = o; }
    LDS_WAIT();
}
#ifndef CV_INTERLEAVE
#define CV_INTERLEAVE 1
#endif
constexpr int CV_IN = 32 * 72, CV_OUT = 32 * 32, CV_E = 768, CV_PER_L = CV_IN + CV_OUT + 3 * NEXP * CV_E, CV_TOTAL = 2 * CV_PER_L, CV_FIRST = CV_INTERLEAVE ? CV_IN : CV_TOTAL;
__device__ __forceinline__ void conv_item(const Params& p, const Ctx& F, LAS float* scr, const int it, const int lane) {
    const int l = it / CV_PER_L; int r = it - l * CV_PER_L;
    if (r < CV_IN) { transpose_item_i8(p.w_in + (size_t)l * DM * INW, DM, INW, (signed char*)F.win + (size_t)l * INW * DM, l == 0 ? -1 : 4, 0, scr, r, lane, 1.f / F.wsc[l]); return; } r -= CV_IN;
    if (r < CV_OUT) { transpose_item_i8(p.w_out + (size_t)l * DM * DM, DM, DM, (signed char*)F.wout + (size_t)l * DM * DM, 4, 0, scr, r, lane, 1.f / F.wsc[98 + l], l == 1); return; } r -= CV_OUT;
    const int ty = r / (NEXP * CV_E), e = (r % (NEXP * CV_E)) / CV_E, idx = r % CV_E; const size_t le = (size_t)l * NEXP + e;
    if (ty == 0) transpose_item_i8(p.w_gate + le * DM * DEXP, DM, DEXP, (signed char*)F.wgu + le * 3072 * DM, 8, 0, scr, idx, lane, 1.f / F.wsc[2 + 2 * le]);
    else if (ty == 1) transpose_item_i8(p.w_up + le * DM * DEXP, DM, DEXP, (signed char*)F.wgu + le * 3072 * DM, 8, 4, scr, idx, lane, 1.f / F.wsc[3 + 2 * le]);
    else transpose_item_i8(p.w_down + le * DEXP * DM, DEXP, DM, (signed char*)F.wdn + le * DM * DEXP, 4, 0, scr, idx, lane, 1.f / F.wsc[66 + le], true);
}

__device__ __forceinline__ void conv_some(const Params& p, const Ctx& F, int& cv_it, const int k) {
    int t2 = threadIdx.x; asm volatile("" : "+v"(t2));
    const int lane = t2 & 63, wave = __builtin_amdgcn_readfirstlane(t2 >> 6);
    LAS float* scr = (LAS float*)(F.lds + wave * 16640);
    for (int q = 0; q < k && cv_it < CV_TOTAL; ++q, cv_it += F.NGW) conv_item(p, F, scr, cv_it, lane);
}

__device__ __forceinline__ void phase_prologue(const Params& p, const Ctx& F) {
    for (int item = F.bid; item < 192; item += F.G) {
        LAS float* sl = (LAS float*)F.lds; LAS float* red = (LAS float*)(F.lds + 73728);
        for (int i = F.tid; i < 9 * DM; i += NTHR) { const int r = i >> 11, d = i & 2047; const float v = r < 8 ? p.c[r * DM + d] : p.c_ctx[d]; sl[i] = silu_f(v); }
        __syncthreads();
        const int l = item / 96, cb = item % 96;
        const float* W = p.w_ada + ((size_t)l * DM + F.wave * 256) * MODW + cb * 128 + 2 * F.lane;
        float a0[9], a1[9];
#pragma unroll
        for (int r = 0; r < 9; ++r) { a0[r] = 0.f; a1[r] = 0.f; }
#pragma unroll 8
        for (int d = 0; d < 256; ++d) { const f32x2 w = *(const f32x2*)(W + (size_t)d * MODW);
#pragma unroll
            for (int r = 0; r < 9; ++r) { const float s = sl[r * DM + F.wave * 256 + d]; a0[r] += s * w.x; a1[r] += s * w.y; } }
#pragma unroll
        for (int r = 0; r < 9; ++r) { red[(F.wave * 9 + r) * 128 + 2 * F.lane] = a0[r]; red[(F.wave * 9 + r) * 128 + 2 * F.lane + 1] = a1[r]; }
        __syncthreads();
        for (int i = F.tid; i < 9 * 128; i += NTHR) { const int r = i >> 7, cc = i & 127; float s = p.b_ada[l * MODW + cb * 128 + cc];
#pragma unroll
            for (int w = 0; w < 8; ++w) s += red[(w * 9 + r) * 128 + cc];
            F.mod[(size_t)(l * 9 + r) * MODW + cb * 128 + cc] = s; }
        __syncthreads();
    }
    for (int m = F.bid; m < 100; m += F.G) {
        LAS float* red = (LAS float*)F.lds;
        const float* W; int N;
        if (m < 2) { W = p.w_in + (size_t)m * DM * INW; N = INW; }
        else if (m >= 98) { W = p.w_out + (size_t)(m - 98) * DM * DM; N = DM; }
        else if (m >= 66) { W = p.w_down + (size_t)(m - 66) * DEXP * DM; N = DM; }
        else { const int le = (m - 2) >> 1; W = ((m & 1) ? p.w_up : p.w_gate) + (size_t)le * DM * DEXP; N = DEXP; }
        float ss = 0.f;
        for (int i = F.tid; i < 8 * N; i += NTHR) { const float v = W[i]; ss += v * v; }
        ss = wave_sum(ss);
        if (F.lane == 0) red[F.wave] = ss;
        __syncthreads();
        if (F.tid == 0) { float t = 0.f;
#pragma unroll
            for (int w = 0; w < 8; ++w) t += red[w];
            F.wsc[m] = fmaxf(6.0f * sqrtf(t / (float)(8 * N)) * (1.f / 127.f), 1e-30f); }
        __syncthreads();
    }
}

__device__ __forceinline__ void row_ptrs(const Params& p, const Ctx& F, const int l, const int b, const int t, const float*& xs, float*& xd) {
    const unsigned long long blat = (l <= 1) ? (unsigned long long)p.x : (unsigned long long)p.out, bctx = (l <= 1) ? (unsigned long long)p.ctx : (unsigned long long)F.xc;
    const bool isctx = t < CTXL;
    const size_t roff = isctx ? ((size_t)b * CTXL + t) * DM : ((size_t)b * SEQ + (t - CTXL)) * DM;
    xs = (const float*)(isctx ? bctx : blat) + roff;
    xd = (isctx ? F.xc : p.out) + roff;
}
__device__ __forceinline__ void gather_y1(const Ctx& F, const int s, f32x4 (&acc)[8]) {
#pragma unroll
    for (int j = 0; j < 8; ++j) acc[j] = (f32x4){0.f, 0.f, 0.f, 0.f};
#pragma unroll 2
    for (int e = 0; e < 16; ++e) { const int se = __builtin_amdgcn_readlane(s, e);
        if (se >= 0) { const unsigned char* yr = F.y8 + (size_t)se * DM + 4 * F.lane;
#pragma unroll
            for (int j = 0; j < 8; ++j) { const unsigned w = __builtin_nontemporal_load((const unsigned*)(yr + 256 * j)); acc[j] += unpack_f8x4(w); } } }
}
__device__ __forceinline__ void gather_y(const Ctx& F, const int s, f32x4 (&acc)[8]) {
#pragma unroll
    for (int j = 0; j < 8; ++j) acc[j] = (f32x4){0.f, 0.f, 0.f, 0.f};
    unsigned m = (unsigned)__ballot(s >= 0) & 0xffffu;
    while (m) {
        const int e0 = __builtin_ctz(m); m &= m - 1;
        const bool two = m != 0; const int e1 = two ? __builtin_ctz(m) : e0; if (two) m &= m - 1;
        const int s0 = __builtin_amdgcn_readlane(s, e0), s1 = __builtin_amdgcn_readlane(s, e1);
        const unsigned char* y0 = F.y8 + (size_t)s0 * DM + 4 * F.lane; const unsigned char* y1 = F.y8 + (size_t)s1 * DM + 4 * F.lane;
        unsigned w0[8], w1[8];
#pragma unroll
        for (int j = 0; j < 8; ++j) w0[j] = __builtin_nontemporal_load((const unsigned*)(y0 + 256 * j));
#pragma unroll
        for (int j = 0; j < 8; ++j) w1[j] = __builtin_nontemporal_load((const unsigned*)(y1 + 256 * j));
        const float k1 = two ? 1.f : 0.f;
#pragma unroll
        for (int j = 0; j < 8; ++j) { acc[j] += unpack_f8x4(w0[j]); acc[j] += unpack_f8x4(w1[j]) * k1; }
    }
}
__device__ __forceinline__ void phase_norm1(const Params& p, const Ctx& F, const int l) {
    const bool fin = (l == 2), comb = (l > 0);
    if (l == 0) { LAS float* scr = (LAS float*)(F.lds + F.wave * 16640); for (int it = F.gw; it < CV_FIRST; it += F.NGW) conv_item(p, F, scr, it, F.lane); }
    const int b = F.gw & 7, tstride = F.NGW >> 3;
    int cur_m = -1; f32x4 A[8], Bv[8];
    int t = F.gw >> 3; if (fin) { while (t < CTXL) t += tstride; }
    f32x4 vn[8], accn[8]; u32x2 dn[8]; int sn = -1;
#pragma unroll
    for (int j = 0; j < 8; ++j) dn[j] = (u32x2){0u, 0u};
#pragma unroll
    for (int j = 0; j < 8; ++j) accn[j] = (f32x4){0.f, 0.f, 0.f, 0.f};
    if (t < TPB) { const float* xs; float* xd; row_ptrs(p, F, l, b, t, xs, xd);
#pragma unroll
        for (int j = 0; j < 8; ++j) vn[j] = __builtin_nontemporal_load((const f32x4*)xs + F.lane + 64 * j);
        if (comb) {
#pragma unroll
            for (int j = 0; j < 8; ++j) dn[j] = __builtin_nontemporal_load((const u32x2*)(F.dlt + ((size_t)b * TPB + t) * DM + 4 * F.lane + 256 * j)); }
        if (comb) { int s0 = -1; if (F.lane < 16) s0 = F.slot[(unsigned)((b * 16 + F.lane) * TPB + t)]; { if (fin) gather_y1(F, s0, accn); else gather_y(F, s0, accn); }
            if (t + tstride < TPB && F.lane < 16) sn = F.slot[(unsigned)((b * 16 + F.lane) * TPB + t + tstride)]; } }
    for (; t < TPB; t += tstride) {
        const bool isctx = t < CTXL;
        const int mrow = isctx ? 8 : b;
        const float* xs; float* xd; row_ptrs(p, F, l, b, t, xs, xd);
        f32x4 v[8];
#pragma unroll
        for (int j = 0; j < 8; ++j) v[j] = vn[j] + (f32x4){bflo(dn[j].x), bfhi(dn[j].x), bflo(dn[j].y), bfhi(dn[j].y)};
        if (comb) {
            const float* gt = F.mod + (size_t)((l - 1) * 9 + mrow) * MODW + 5 * DM;
#pragma unroll
            for (int j = 0; j < 8; ++j) { v[j] += *((const f32x4*)gt + F.lane + 64 * j) * accn[j] * (1.f / Y_SCALE); if (!fin) *((f32x4*)xd + F.lane + 64 * j) = v[j]; }
        }
        { const int t2 = t + tstride;
          if (t2 < TPB) { const float* xs2; float* xd2; row_ptrs(p, F, l, b, t2, xs2, xd2);
#pragma unroll
            for (int j = 0; j < 8; ++j) vn[j] = __builtin_nontemporal_load((const f32x4*)xs2 + F.lane + 64 * j);
            if (comb) {
#pragma unroll
                for (int j = 0; j < 8; ++j) dn[j] = __builtin_nontemporal_load((const u32x2*)(F.dlt + ((size_t)b * TPB + t2) * DM + 4 * F.lane + 256 * j)); }
            if (comb) { { if (fin) gather_y1(F, sn, accn); else gather_y(F, sn, accn); } const int t3 = t2 + tstride; sn = -1; if (t3 < TPB && F.lane < 16) sn = F.slot[(unsigned)((b * 16 + F.lane) * TPB + t3)]; } } }
        if (mrow != cur_m) { cur_m = mrow;
            if (!fin) {
                const float* mr = F.mod + (size_t)(l * 9 + mrow) * MODW;
#pragma unroll
                for (int j = 0; j < 8; ++j) { const f32x4 g = *((const f32x4*)(p.g_mix + l * DM) + F.lane + 64 * j), sc = *((const f32x4*)(mr + DM) + F.lane + 64 * j);
                    A[j] = g * (sc + 1.f); Bv[j] = *((const f32x4*)mr + F.lane + 64 * j); }
            }
        }
        float ss = 0.f;
#pragma unroll
        for (int j = 0; j < 8; ++j) ss += (v[j].x * v[j].x + v[j].y * v[j].y) + (v[j].z * v[j].z + v[j].w * v[j].w);
        const float rstd = rsqrtf(wave_sum(ss) * (1.f / DM) + EPS);
        if (fin) {
#pragma unroll
            for (int j = 0; j < 8; ++j) __builtin_nontemporal_store(v[j] * rstd * *((const f32x4*)p.g_final + F.lane + 64 * j), (f32x4*)xd + F.lane + 64 * j);
        } else {
            float am = 0.f;
#pragma unroll
            for (int j = 0; j < 8; ++j) { v[j] = v[j] * rstd * A[j] + Bv[j]; am = fmaxf(am, amax4(v[j])); }
            am = fmaxf(wave_max(am), 1e-20f); const float inv = 127.f / am;
            unsigned* xn = (unsigned*)((signed char*)F.r1 + ((size_t)b * TPB + t) * DM) + F.lane;
#pragma unroll
            for (int j = 0; j < 8; ++j) __builtin_nontemporal_store(pack_i8x4(v[j].x, v[j].y, v[j].z, v[j].w, inv), xn + 64 * j);
            if (F.lane == 0) F.sax[b * TPB + t] = am * (1.f / 127.f);
        }
    }
}

__device__ __forceinline__ void v8_tiles_n(const Ctx& F, const int col0, const int nh, unsigned char* dstb) {
        for (int it = F.gw; it < NB * nh * 68; it += F.NGW) {
            const int tile = it % 68, bk = it / 68, kvh = bk % nh, b = bk / nh;
            const bf16_t* srcv = F.r2 + (size_t)(b * TPB + tile * 64) * INW + col0 + kvh * 128 + 2 * F.lane;
            unsigned w[64];
#pragma unroll
            for (int kk = 0; kk < 64; ++kk) w[kk] = *(const unsigned*)(srcv + (size_t)kk * INW);
            unsigned char* dst = dstb + (size_t)it * 8192 + F.lane * 128;
#pragma unroll
            for (int half = 0; half < 2; ++half)
#pragma unroll
                for (int q = 0; q < 4; ++q) { u32x4 o;
#pragma unroll
                    for (int a = 0; a < 4; ++a) { const int s0 = 16 * q + 4 * a, hi_ = s0 >> 5, j = s0 & 31, key = 32 * (j >> 4) + 8 * ((j >> 2) & 3) + 4 * hi_;
                        float f[4];
#pragma unroll
                        for (int i = 0; i < 4; ++i) f[i] = half ? bfhi(w[key + i]) : bflo(w[key + i]);
                        o[a] = pack_f8x4(f[0], f[1], f[2], f[3], 1.f); }
                    *(u32x4*)(dst + half * 64 + q * 16) = o; }
        }
}
__device__ __forceinline__ void v8_tiles(const Ctx& F) { v8_tiles_n(F, 1280, 2, F.v8); }
__device__ __forceinline__ void phase_qkfix(const Params& p, const Ctx& F, const int l) {
    LAS f32x2* cs = (LAS f32x2*)F.lds;
    for (int i = F.tid; i < 2048; i += NTHR) { const int pp = i >> 5, fi = i & 31; const float inv = exp2f(-(float)fi * (13.287712379549449f / 32.f)); const float ang = (float)pp * inv;
        cs[i] = (f32x2){__cosf(ang), __sinf(ang)}; }
    __syncthreads();
    const int NV = l == 0 ? 26 : 2, nrows = l == 0 ? NB * SEQ : NROWS;
    const long total = (long)nrows * NV;
    const int sub = F.lane >> 4, jl = F.lane & 15, ax = jl >> 3, f0 = (jl & 7) * 4;
    for (long V0 = (long)F.gw * 4; V0 < total; V0 += (long)F.NGW * 4) {
        const long V = V0 + sub; const bool valid = V < total; const long Vc = valid ? V : 0;
        const int rr = (int)(Vc / NV), v = (int)(Vc % NV);
        int R, pos; bool lat;
        if (l == 0) { const int b = rr >> 12, s = rr & 4095; R = b * TPB + CTXL + s; pos = s; lat = true; }
        else { R = rr; const int t = rr % TPB; lat = t >= CTXL; pos = t - CTXL; }
        const int col = l == 0 ? v * 128 + (v >= 10 ? 256 : 0) : (8 + v) * 128;
        bf16_t* ptr = F.r2 + (size_t)R * INW + col + ax * 64 + f0;
        const u32x2 wl = *(const u32x2*)ptr, wh = *(const u32x2*)(ptr + 32);
        float xl[4] = {bflo(wl.x), bfhi(wl.x), bflo(wl.y), bfhi(wl.y)}, xh[4] = {bflo(wh.x), bfhi(wh.x), bflo(wh.y), bfhi(wh.y)};
        if (l == 1) {
            float ss = 0.f;
#pragma unroll
            for (int q = 0; q < 4; ++q) ss += xl[q] * xl[q] + xh[q] * xh[q];
            ss += __shfl_xor(ss, 1); ss += __shfl_xor(ss, 2); ss += __shfl_xor(ss, 4); ss += __shfl_xor(ss, 8);
            const float rstd = rsqrtf(ss * (1.f / 128.f) + EPS);
            const float* g = p.kn + ax * 64 + f0;
#pragma unroll
            for (int q = 0; q < 4; ++q) { xl[q] = xl[q] * rstd * g[q]; xh[q] = xh[q] * rstd * g[32 + q]; }
        }
        if (lat) {
            const int pp = ax == 0 ? (pos >> 6) : (pos & 63);
#pragma unroll
            for (int q = 0; q < 4; ++q) { const f32x2 c = cs[pp * 32 + f0 + q]; const float a = xl[q], bq = xh[q]; xl[q] = a * c.x - bq * c.y; xh[q] = bq * c.x + a * c.y; }
        }
        if (valid) {
            if (l == 0) { u32x2 o; o.x = cvtpk(xl[0], xl[1]); o.y = cvtpk(xl[2], xl[3]); *(u32x2*)ptr = o; o.x = cvtpk(xh[0], xh[1]); o.y = cvtpk(xh[2], xh[3]); *(u32x2*)(ptr + 32) = o; }
            else { unsigned char* k8 = F.k8 + ((size_t)v * NROWS + R) * 128 + ax * 64 + (f0 >> 4) * 32 + (f0 & 15);
                *(unsigned*)k8 = pack_f8x4(xl[0], xl[1], xl[2], xl[3], 1.f); *(unsigned*)(k8 + 16) = pack_f8x4(xh[0], xh[1], xh[2], xh[3], 1.f); } }
    }
    if (l == 1) v8_tiles(F);
}

__device__ __forceinline__ void bfinal_tile(const Params& p, const Ctx& F, const int qrow0, const int h) {
    int t2 = threadIdx.x; asm volatile("" : "+v"(t2));
    const int lane = t2 & 63, wave = __builtin_amdgcn_readfirstlane(t2 >> 6);
    const float lam_init = 0.2f;
    float s1 = p.lq1[lane] * p.lk1[lane] + p.lq1[lane + 64] * p.lk1[lane + 64], s2 = p.lq2[lane] * p.lk2[lane] + p.lq2[lane + 64] * p.lk2[lane + 64];
    s1 = wave_sum(s1); s2 = wave_sum(s2);
    const float lam = expf(s1) - expf(s2) + lam_init;
    const int sub = lane >> 4, jl = lane & 15;
    f32x4 g[4];
#pragma unroll
    for (int q = 0; q < 4; ++q) g[q] = *(const f32x4*)(p.subln + jl * 4 + 64 * q) * (1.f - lam_init);
    for (int it = 0; it < 8; ++it) {
        const int R = qrow0 + wave * 32 + it * 4 + sub;
        const float* o1 = F.ob + (size_t)R * DM + h * 512 + jl * 4; const float* o2 = o1 + 256;
        f32x4 v[4]; float ss = 0.f;
#pragma unroll
        for (int q = 0; q < 4; ++q) { v[q] = *(const f32x4*)(o1 + 64 * q) - lam * *(const f32x4*)(o2 + 64 * q); ss += (v[q].x * v[q].x + v[q].y * v[q].y) + (v[q].z * v[q].z + v[q].w * v[q].w); }
        ss += __shfl_xor(ss, 1); ss += __shfl_xor(ss, 2); ss += __shfl_xor(ss, 4); ss += __shfl_xor(ss, 8);
        const float rstd = rsqrtf(ss * (1.f / 256.f) + EPS);
        bf16_t* o = F.r1 + (size_t)R * DM + 1024 + h * 256 + jl * 4;
#pragma unroll
        for (int q = 0; q < 4; ++q) { const f32x4 y = v[q] * rstd * g[q]; u32x2 w; w.x = cvtpk(y.x, y.y); w.y = cvtpk(y.z, y.w); *(u32x2*)(o + 64 * q) = w; }
    }
}

__device__ __forceinline__ void phase_attn(const Params& p, const Ctx& F, const int l) {
    LAS char* lds = (LAS char*)F.lds;
    if (l == 1) { LAS float* bt = (LAS float*)(lds + att::BIAS_OFF);
        for (int i = F.tid; i < 8 * 480; i += NTHR) { const int h = i / 480, rem = i % 480, ro = rem >> 5, cc = rem & 31; bt[i] = cc < 31 ? p.rpb[(h * 15 + ro) * 31 + cc] * 1.4426950408889634f : 0.f; }
        __syncthreads(); }
    const int vcu = (F.G % 8 == 0) ? (F.bid % 8) * (F.G / 8) + F.bid / 8 : F.bid;
    constexpr int CV_PER_UNIT = 3;
    int cv_it = CV_FIRST + F.gw, cv_slot = 0;
    unsigned* a8cnt = (unsigned*)(p.ws + WS_CTL) + 8192;
    {
    if (l == 0) {
        for (int su = vcu; su < 544; su += F.G) {
            const bool lat = su < 512; int b, h, qt;
            if (lat) { qt = su & 15; h = (su >> 4) & 3; b = su >> 6; } else { const int uu = su - 512; qt = 0; h = uu & 3; b = uu >> 2; }
            const int qrow0 = b * TPB + (lat ? CTXL + qt * 256 : 0);
            for (int sp = 0; sp < 4; ++sp) {
                att::AUnit u; u.mode = 0; u.pa = 0; u.pb = 0; u.head = 0; u.has_sink = 0; u.sink = 0.f; u.seg2row = CTXL; u.kbase = b * TPB; u.outf32 = 1;
                if (false) {
                    const int mp = 0, rh = sp & 1;
                    u.qrow0 = qrow0 + rh * 128; u.qcol = 1536 + h * 256 + mp * 128; u.kcol = 2560 + h * 256 + mp * 128; u.vcol = 3584 + h * 256; u.NT = 68; u.ocol = h * 512 + mp * 256;
                    att::attn_unit_b(u, F.r2, F.ob, lds);
                } else if (lat) {
                    const int vh = sp & 1, mp = sp >> 1;
                    u.qrow0 = qrow0; u.qcol = 1536 + h * 256 + mp * 128; u.NT = 68; u.ocol = h * 512 + mp * 256 + vh * 128;
                    att::attn_unit_c8<3>(u, F.r2, F.k8d + ((size_t)(h * 2 + mp) * NROWS + u.kbase) * 128, F.v8d + (size_t)(b * 8 + h * 2 + vh) * (68 * 8192), nullptr, (bf16_t*)F.ob, lds);
                } else {
                    const int mp = sp >> 1, vh = sp & 1;
                    u.qrow0 = qrow0; u.qcol = 1536 + h * 256 + mp * 128; u.NT = 4; u.ocol = h * 512 + mp * 256 + vh * 128;
                    att::attn_unit_c8<3>(u, F.r2, F.k8d + ((size_t)(h * 2 + mp) * NROWS + u.kbase) * 128, F.v8d + (size_t)(b * 8 + h * 2 + vh) * (68 * 8192), nullptr, (bf16_t*)F.ob, lds);
                }
                if (((cv_slot++ ^ vcu) & 1) == 0) { conv_some(p, F, cv_it, 2 * CV_PER_UNIT); __syncthreads(); }
            }
            VM_WAIT(); __syncthreads();
            bfinal_tile(p, F, qrow0, h);
        }
        for (int ui = vcu; ui < 64; ui += F.G) {
            att::AUnit u; u.mode = 0; u.pa = 0; u.pb = 0; u.head = 0; u.outf32 = 0; u.seg2row = CTXL;
            const int h = ui & 7, b = ui >> 3;
            u.qrow0 = b * TPB; u.kbase = b * TPB;
            u.qcol = h * 128; u.kcol = 1024 + (h >> 2) * 128; u.vcol = 1280 + (h >> 2) * 128; u.ocol = h * 128;
            u.has_sink = 1; u.sink = p.a_sink[h]; u.NT = 4;
            att::attn_unit_c8<1>(u, F.r2, F.k8 + ((size_t)(h >> 2) * NROWS + u.kbase) * 128, F.v8 + (size_t)(b * 2 + (h >> 2)) * (68 * 8192), nullptr, F.r1, lds);
        }
    } else {
        for (int ui = vcu; ui < 1024; ui += F.G) {
            att::AUnit u; u.mode = 0; u.pa = 0; u.pb = 0; u.head = 0; u.has_sink = 0; u.sink = 0.f; u.outf32 = 0; u.seg2row = CTXL; u.NT = 68;
            const int qt = ui & 15, h = (ui >> 4) & 7, b = ui >> 7;
            u.qrow0 = b * TPB + CTXL + qt * 256; u.kbase = b * TPB;
            u.qcol = h * 128; u.kcol = 1024 + (h >> 2) * 128; u.vcol = 1280 + (h >> 2) * 128; u.ocol = h * 128;
            u.pa = qt * 256;
            att::attn_unit_c8<0>(u, F.r2, F.k8 + ((size_t)(h >> 2) * NROWS + u.kbase) * 128, F.v8 + (size_t)(b * 2 + (h >> 2)) * (68 * 8192), p.qn, (bf16_t*)F.o8, lds);
        }
    } }
    if (l == 0) {
    for (int ui = vcu; ui < 1024; ui += F.G) {
        att::AUnit u; u.mode = 1; u.head = 0; u.outf32 = 0;
        const int qt = ui & 15, h = (ui >> 4) & 7, b = ui >> 7;
        u.qrow0 = b * TPB + CTXL + qt * 256; u.kbase = b * TPB;
        u.qcol = h * 128; u.kcol = 1024 + (h >> 2) * 128; u.vcol = 1280 + (h >> 2) * 128; u.ocol = h * 128;
        u.has_sink = 1; u.sink = p.a_sink[h];
        const int s0 = qt * 256, lo = max(0, s0 - 128), hi2 = min(SEQ, s0 + 384); u.NT = 4 + (hi2 - lo) / 64; u.seg2row = CTXL + lo; u.pa = s0; u.pb = lo;
        att::attn_unit_c8<1>(u, F.r2, F.k8 + ((size_t)(h >> 2) * NROWS + u.kbase) * 128, F.v8 + (size_t)(b * 2 + (h >> 2)) * (68 * 8192), nullptr, F.r1, lds);
        if (((cv_slot++ ^ vcu) & 1) == 0) { conv_some(p, F, cv_it, 2 * CV_PER_UNIT); __syncthreads(); }
    }
    conv_some(p, F, cv_it, 1 << 20);
    __syncthreads(); }
    else {
    for (int ui = vcu; ui < 1024; ui += F.G) {
        att::AUnit u; u.mode = 2; u.has_sink = 0; u.sink = 0.f; u.outf32 = 0;
        const int qt = ui & 15, h = (ui >> 4) & 7, b = ui >> 7;
        u.qrow0 = b * TPB + CTXL + qt * 256; u.kbase = b * TPB;
        u.qcol = 1536 + h * 128; u.kcol = 2560 + h * 128; u.vcol = 3584 + h * 128; u.ocol = 1024 + h * 128; u.head = h;
        const int r0 = qt * 4; int lo = min(max(r0 - 4, 0), 56), hi2 = min(max(r0 - 1, 0), 56) + 7; if (((hi2 - lo + 1) & 1) != 0) { if (hi2 < 63) ++hi2; else --lo; }
        u.NT = 4 + (hi2 - lo + 1); u.seg2row = CTXL + lo * 64; u.pa = r0; u.pb = lo;
        att::attn_unit<2, 1>(u, F.r2, (bf16_t*)F.o8, F.ob, lds);
    } }
}

__device__ __forceinline__ void router_tail(const Ctx& F, const float (&lg)[16], const int b, const int t, const bool valid) {
    const bool b5 = (F.lane & 32) != 0, b4 = (F.lane & 16) != 0, b3 = (F.lane & 8) != 0, b2 = (F.lane & 4) != 0;
    float r8[8], r4[4], r2[2];
#pragma unroll
    for (int e = 0; e < 8; ++e) { const float keep = b5 ? lg[e + 8] : lg[e], send = b5 ? lg[e] : lg[e + 8]; r8[e] = keep + __shfl_xor(send, 32); }
#pragma unroll
    for (int e = 0; e < 4; ++e) { const float keep = b4 ? r8[e + 4] : r8[e], send = b4 ? r8[e] : r8[e + 4]; r4[e] = keep + __shfl_xor(send, 16); }
#pragma unroll
    for (int e = 0; e < 2; ++e) { const float keep = b3 ? r4[e + 2] : r4[e], send = b3 ? r4[e] : r4[e + 2]; r2[e] = keep + __shfl_xor(send, 8); }
    float lgt; { const float keep = b2 ? r2[1] : r2[0], send = b2 ? r2[0] : r2[1]; lgt = keep + __shfl_xor(send, 4); }
    lgt += __shfl_xor(lgt, 2); lgt += __shfl_xor(lgt, 1);
    float mx = lgt;
    mx = fmaxf(mx, __shfl_xor(mx, 4)); mx = fmaxf(mx, __shfl_xor(mx, 8)); mx = fmaxf(mx, __shfl_xor(mx, 16)); mx = fmaxf(mx, __shfl_xor(mx, 32));
    const float ex = expf(lgt - mx); float sum = ex;
    sum += __shfl_xor(sum, 4); sum += __shfl_xor(sum, 8); sum += __shfl_xor(sum, 16); sum += __shfl_xor(sum, 32);
    if (valid && (F.lane & 3) == 0) { const float af = ex / sum; const int e = F.lane >> 2;
        if (t < CTXL) F.affc[((size_t)(b * 16 + e)) * CTXL + t] = af; else F.affl[((size_t)(b * 16 + e)) * SEQ + (t - CTXL)] = af; }
}
__device__ __forceinline__ void phase_norm2(const Params& p, const Ctx& F, const int l) {
    LAS float* wr = (LAS float*)F.lds;
    for (int i = F.tid; i < DM * NEXP; i += NTHR) { const int d = i >> 4, e = i & 15; wr[e * DM + d] = p.w_router[(size_t)l * DM * NEXP + i]; }
    __syncthreads();
    const int b = F.gw & 7, tstride = F.NGW >> 3;
    int cur_m = -1; f32x4 A[8], Bv[8];
    int t = F.gw >> 3; if (l == 1) { while (t < CTXL) t += tstride; }
    while (t < TPB) {
        const bool isctx = t < CTXL;
        const int mrow = isctx ? 8 : b;
        const int tB = t + tstride;
        const bool two = !isctx && tB < TPB;
        f32x2 vv[8][4];
        { const float* xlat = l == 0 ? p.x : p.out; const float* xctx = l == 0 ? p.ctx : F.xc;
          const float* xs0 = isctx ? xctx + ((size_t)b * CTXL + t) * DM : xlat + ((size_t)b * SEQ + (t - CTXL)) * DM;
          const float* xs1 = two ? xlat + ((size_t)b * SEQ + (tB - CTXL)) * DM : xs0;
          const bf16_t* d0p = F.dlt + ((size_t)b * TPB + t) * DM + 4 * F.lane; const bf16_t* d1p = F.dlt + ((size_t)b * TPB + (two ? tB : t)) * DM + 4 * F.lane;
#pragma unroll
          for (int j = 0; j < 8; ++j) { f32x4 x0 = __builtin_nontemporal_load((const f32x4*)xs0 + F.lane + 64 * j), x1 = __builtin_nontemporal_load((const f32x4*)xs1 + F.lane + 64 * j);
              const u32x2 e0 = __builtin_nontemporal_load((const u32x2*)(d0p + 256 * j)), e1 = __builtin_nontemporal_load((const u32x2*)(d1p + 256 * j));
              x0 += (f32x4){bflo(e0.x), bfhi(e0.x), bflo(e0.y), bfhi(e0.y)}; x1 += (f32x4){bflo(e1.x), bfhi(e1.x), bflo(e1.y), bfhi(e1.y)};
#pragma unroll
              for (int c = 0; c < 4; ++c) vv[j][c] = (f32x2){x0[c], x1[c]}; } }
        if (mrow != cur_m) { cur_m = mrow; const float* mr = F.mod + (size_t)(l * 9 + mrow) * MODW;
#pragma unroll
            for (int j = 0; j < 8; ++j) { const f32x4 g = *((const f32x4*)(p.g_ffn + l * DM) + F.lane + 64 * j), sc = *((const f32x4*)(mr + 4 * DM) + F.lane + 64 * j);
                A[j] = g * (sc + 1.f); Bv[j] = *((const f32x4*)(mr + 3 * DM) + F.lane + 64 * j); } }
        f32x2 ss = {0.f, 0.f};
#pragma unroll
        for (int j = 0; j < 8; ++j)
#pragma unroll
            for (int c = 0; c < 4; ++c) ss += vv[j][c] * vv[j][c];
        const f32x2 rstd = {rsqrtf(wave_sum(ss.x) * (1.f / DM) + EPS), rsqrtf(wave_sum(ss.y) * (1.f / DM) + EPS)};
        f32x2 am = {0.f, 0.f};
#pragma unroll
        for (int j = 0; j < 8; ++j)
#pragma unroll
            for (int c = 0; c < 4; ++c) { vv[j][c] = vv[j][c] * rstd * A[j][c] + Bv[j][c]; am = __builtin_elementwise_max(am, __builtin_elementwise_abs(vv[j][c])); }
        const float am0 = fmaxf(wave_max(am.x), 1e-20f), am1 = fmaxf(wave_max(am.y), 1e-20f), inv0 = 127.f / am0, inv1 = 127.f / am1;
        unsigned* hn0 = (unsigned*)((signed char*)F.r1 + ((size_t)b * TPB + t) * DM) + F.lane;
        unsigned* hn1 = (unsigned*)((signed char*)F.r1 + ((size_t)b * TPB + (two ? tB : t)) * DM) + F.lane;
#pragma unroll
        for (int j = 0; j < 8; ++j) { __builtin_nontemporal_store(pack_i8x4(vv[j][0].x, vv[j][1].x, vv[j][2].x, vv[j][3].x, inv0), hn0 + 64 * j);
            if (two) __builtin_nontemporal_store(pack_i8x4(vv[j][0].y, vv[j][1].y, vv[j][2].y, vv[j][3].y, inv1), hn1 + 64 * j); }
        if (F.lane == 0) { F.sah[b * TPB + t] = am0 * (1.f / 127.f); if (two) F.sah[b * TPB + tB] = am1 * (1.f / 127.f); }
        f32x2 lg[16];
        unsigned wro = (unsigned)(uintptr_t)wr; asm volatile("" : "+v"(wro));
        const LAS float* wr2 = (const LAS float*)(uintptr_t)wro;
#pragma unroll
        for (int e = 0; e < 16; ++e) { f32x2 a = {0.f, 0.f};
#pragma unroll
            for (int j = 0; j < 8; ++j) { const f32x4 w = *((const LAS f32x4*)(wr2 + e * DM) + F.lane + 64 * j);
#pragma unroll
                for (int c = 0; c < 4; ++c) a += vv[j][c] * w[c]; }
            lg[e] = a; }
        float lg0[16], lg1[16];
#pragma unroll
        for (int e = 0; e < 16; ++e) { lg0[e] = lg[e].x; lg1[e] = lg[e].y; }
        router_tail(F, lg0, b, t, true);
        router_tail(F, lg1, b, tB, two);
        t += two ? 2 * tstride : tstride;
    }
}

__device__ __forceinline__ void phase_oq(const Params& p, const Ctx& F, const int l) {
    for (int R = F.gw; R < NROWS; R += F.NGW) {
        if (l == 1 && (R % TPB) < CTXL) continue;
        const bf16_t* src = F.r1 + (size_t)R * DM + 8 * F.lane;
        u32x4 w[4];
#pragma unroll
        for (int j = 0; j < 4; ++j) w[j] = __builtin_nontemporal_load((const u32x4*)(src + 512 * j));
        float v[4][8], am = 0.f;
#pragma unroll
        for (int j = 0; j < 4; ++j) { v[j][0] = bflo(w[j].x); v[j][1] = bfhi(w[j].x); v[j][2] = bflo(w[j].y); v[j][3] = bfhi(w[j].y); v[j][4] = bflo(w[j].z); v[j][5] = bfhi(w[j].z); v[j][6] = bflo(w[j].w); v[j][7] = bfhi(w[j].w);
#pragma unroll
            for (int q = 0; q < 8; ++q) am = fmaxf(am, fabsf(v[j][q])); }
        am = fmaxf(wave_max(am), 1e-20f); const float inv = 127.f / am;
        signed char* dst = F.o8 + (size_t)R * DM + 8 * F.lane;
#pragma unroll
        for (int j = 0; j < 4; ++j) { u32x2 o; o.x = pack_i8x4(v[j][0], v[j][1], v[j][2], v[j][3], inv); o.y = pack_i8x4(v[j][4], v[j][5], v[j][6], v[j][7], inv); *(u32x2*)(dst + 512 * j) = o; }
        if (F.lane == 0) F.so[R] = am * (1.f / 127.f);
    }
}

__device__ __forceinline__ void phase_hidq(const Params& p, const Ctx& F, const int l) {
    const int nrows = 16 * (l == 0 ? 4352 : 4096);
    for (int R = F.gw; R < nrows; R += F.NGW) {
        const bf16_t* src = F.hid + (size_t)R * DEXP + 8 * F.lane;
        u32x4 w[3]; float v[3][8]; float am = 0.f;
#pragma unroll
        for (int j = 0; j < 3; ++j) w[j] = __builtin_nontemporal_load((const u32x4*)(src + 512 * j));
#pragma unroll
        for (int j = 0; j < 3; ++j) { v[j][0] = bflo(w[j].x); v[j][1] = bfhi(w[j].x); v[j][2] = bflo(w[j].y); v[j][3] = bfhi(w[j].y); v[j][4] = bflo(w[j].z); v[j][5] = bfhi(w[j].z); v[j][6] = bflo(w[j].w); v[j][7] = bfhi(w[j].w);
#pragma unroll
            for (int q = 0; q < 8; ++q) am = fmaxf(am, fabsf(v[j][q])); }
        am = fmaxf(wave_max(am), 1e-20f); const float inv = 127.f / am;
        signed char* dst = F.hid8 + (size_t)R * DEXP + 8 * F.lane;
#pragma unroll
        for (int j = 0; j < 3; ++j) { u32x2 o; o.x = pack_i8x4(v[j][0], v[j][1], v[j][2], v[j][3], inv); o.y = pack_i8x4(v[j][4], v[j][5], v[j][6], v[j][7], inv); *(u32x2*)(dst + 512 * j) = o; }
        if (F.lane == 0) F.shd[R] = am * (1.f / 127.f);
    }
}

__device__ __forceinline__ void phase_topk(const Params& p, const Ctx& F, const int l) {
    LAS unsigned* cnt = (LAS unsigned*)F.lds;
    const int nunits = l == 0 ? 256 : 128, mexp = l == 0 ? 4352 : 4096;
    for (int ui = F.bid; ui < nunits; ui += F.G) {
        const bool lat = ui < 128; const int uu = ui & 127, b = uu >> 4, e = uu & 15;
        const int ntok = lat ? SEQ : CTXL, cap = lat ? 512 : 32;
        const float* aff = lat ? F.affl + (size_t)(b * 16 + e) * SEQ : F.affc + (size_t)(b * 16 + e) * CTXL;
        const int rowbase = l == 0 ? (lat ? 256 + b * 512 : b * 32) : b * 512;
        if (F.tid < 64) cnt[F.tid] = 0u;
        unsigned key[8];
#pragma unroll
        for (int i = 0; i < 8; ++i) { const int n = i * NTHR + F.tid; key[i] = n < ntok ? __float_as_uint(aff[n]) : 0u; }
        __syncthreads();
        unsigned prefix = 0u;
        for (int bit = 30; bit >= 0; --bit) {
            const unsigned cand = prefix | (1u << bit); unsigned c = 0u;
#pragma unroll
            for (int i = 0; i < 8; ++i) c += (unsigned)__popcll(__ballot(key[i] >= cand));
            if (F.lane == 0) __hip_atomic_fetch_add(&cnt[bit], c, __ATOMIC_RELAXED, __HIP_MEMORY_SCOPE_WORKGROUP);
            __syncthreads();
            if (cnt[bit] >= (unsigned)cap) prefix = cand;
        }
#pragma unroll
        for (int i = 0; i < 8; ++i) { const int n = i * NTHR + F.tid;
            if (n < ntok) { int slot = -1;
                if (key[i] > prefix) slot = (int)__hip_atomic_fetch_add(&cnt[32], 1u, __ATOMIC_RELAXED, __HIP_MEMORY_SCOPE_WORKGROUP);
                key[i] = (key[i] > prefix) ? (0x80000000u | (unsigned)slot) : (key[i] == prefix ? 0x40000000u : 0u); } else key[i] = 0u; }
        __syncthreads();
        const unsigned cgt = cnt[32];
#pragma unroll
        for (int i = 0; i < 8; ++i) { const int n = i * NTHR + F.tid;
            if (n < ntok) { int slot = -1;
                if (key[i] & 0x80000000u) slot = (int)(key[i] & 0xffffu);
                else if (key[i] & 0x40000000u) { const unsigned s2 = cgt + __hip_atomic_fetch_add(&cnt[33], 1u, __ATOMIC_RELAXED, __HIP_MEMORY_SCOPE_WORKGROUP); if (s2 < (unsigned)cap) slot = (int)s2; }
                const int t = lat ? CTXL + n : n;
                int yrow = -1;
                if (slot >= 0) { const int rr = rowbase + slot; yrow = e * mexp + rr; F.rows[e * MEXP_MAX + rr] = b * TPB + t; F.gate[e * mexp + rr] = aff[n]; F.sas[e * mexp + rr] = F.sah[b * TPB + t]; }
                F.slot[((size_t)(b * 16 + e)) * TPB + t] = yrow; } }
        __syncthreads();
    }
}

__global__ void __launch_bounds__(NTHR, 2) fwd_kernel(Params p) {
    extern __shared__ __attribute__((aligned(16))) unsigned char lds_raw[];
    unsigned char* ws = p.ws;
    LAS unsigned char* const lds0 = (LAS unsigned char*)lds_raw;
    volatile LAS unsigned* lctl = (volatile LAS unsigned*)(lds0 + LCTL_OFF);
    if (threadIdx.x < 128) lctl[threadIdx.x] = 0u;
    __syncthreads();
#if MK_MULTI
#define GRID_BAR() do { } while (0)
#else
    XcdBarrier bar = xcd_barrier_post((unsigned*)(ws + WS_CTL) + 4096, lctl + 8);
#define GRID_BAR() xcd_barrier(bar)
#endif
    const int lo = p.ph_lo, hi = p.ph_hi;
#define IN(k) (lo <= (k) && (k) < hi)
#define SEAM(k) do { if (IN((k) + 1)) GRID_BAR(); } while (0)
#ifndef PHMASK
#define PHMASK 0xfff
#endif
#define EN(s) (((PHMASK) >> (s)) & 1)
#ifndef REP_PRO
#define REP_PRO 1
#endif
#ifndef REP_HEAVY
#define REP_HEAVY 1
#endif
#ifndef REP_THIN
#define REP_THIN 1
#endif
#ifndef REP_ATT
#define REP_ATT 1
#endif

    if (EN(0) && IN(0)) { for (int rep = 0; rep < REP_PRO; ++rep) { const Ctx F = make_ctx(p, lds0); phase_prologue(p, F); __syncthreads(); } SEAM(0); }

    for (int l = 0; l < 2; ++l) {
        const int pb = 1 + l * 11;
        const int mexp = l == 0 ? 4352 : 4096;
        if (EN(1) && IN(pb + 0)) { for (int rep = 0; rep < (l == 0 ? REP_THIN : 1); ++rep) { const Ctx F = make_ctx(p, lds0); phase_norm1(p, F, l); } SEAM(pb + 0); }
        if (EN(2) && IN(pb + 1)) {
            const Ctx F = make_ctx(p, lds0);
            pg8::DenseOrder S{NROWS / 256, INW / 256, F.G, F.bid, 0, (const char*)F.r1, (const char*)F.win + (size_t)l * INW * DM, (size_t)256 * DM};
            pg8::EpiP E{(unsigned char*)F.k8 - WS_K8, l == 0 ? 1 : 0, F.wsc[l]};
            for (int rep = 0; rep < REP_HEAVY; ++rep) pg8::gemm_phase<pg8::EpiP, pg8::DenseOrder, false, true>(F.tid, F.lds, nullptr, DM, S, E);
            SEAM(pb + 1);
        }
        if (EN(3) && IN(pb + 2) && l == 1) { const Ctx F = make_ctx(p, lds0); phase_qkfix(p, F, l); SEAM(pb + 2); }
        if (EN(4) && IN(pb + 3)) { for (int rep = 0; rep < REP_ATT; ++rep) { const Ctx F = make_ctx(p, lds0); phase_attn(p, F, l); } SEAM(pb + 3); }
        if (EN(6) && IN(pb + 4) && l == 0) { const Ctx F = make_ctx(p, lds0); phase_oq(p, F, l); SEAM(pb + 4); }
        if (EN(6) && IN(pb + 5)) {
            const Ctx F = make_ctx(p, lds0);
            pg8::DenseOrder S{l == 0 ? NROWS / 256 : NB * 16, DM / 256, F.G, F.bid, l, (const char*)F.o8, (const char*)F.wout + (size_t)l * DM * DM, (size_t)256 * DM};
            if (l == 0) { pg8::EpiDelta E{F.dlt, F.mod + (size_t)l * 9 * MODW, F.so, F.wsc[98 + l]};
                pg8::gemm_phase<pg8::EpiDelta, pg8::DenseOrder, false, true>(F.tid, F.lds, nullptr, DM, S, E); }
            else { pg8::EpiDelta E{F.dlt, F.mod + (size_t)l * 9 * MODW, nullptr, F.wsc[98 + l] * (1.f / O8_SCALE)};
                pg8::gemm_phase<pg8::EpiDelta, pg8::DenseOrder, false, true, true>(F.tid, F.lds, nullptr, DM, S, E); }
            SEAM(pb + 5);
        }
        if (EN(7) && IN(pb + 6)) { for (int rep = 0; rep < REP_THIN; ++rep) { const Ctx F = make_ctx(p, lds0); phase_norm2(p, F, l); __syncthreads(); } SEAM(pb + 6); }
        if (EN(8) && IN(pb + 7)) { for (int rep = 0; rep < REP_THIN; ++rep) { const Ctx F = make_ctx(p, lds0); phase_topk(p, F, l); } SEAM(pb + 7); }
        if (EN(9) && IN(pb + 8)) {
            const Ctx F = make_ctx(p, lds0);
            pg8::MoeOrder S{mexp / 256, 3072 / 256, F.G, F.bid, (const char*)F.r1, 0, (const char*)F.wgu + (size_t)l * NEXP * 3072 * DM, (size_t)3072 * DM, (size_t)256 * DM};
            LAS unsigned* tab = (LAS unsigned*)(F.lds + TAB_OFF);
            { unsigned rv[14];
#pragma unroll
              for (int i = 0; i < 14; ++i) { pg8::Unit u; rv[i] = 0u; if (S.next(i, u) && F.tid < 256) rv[i] = (unsigned)F.rows[u.e * MEXP_MAX + u.pm * 256 + F.tid]; }
#pragma unroll
              for (int i = 0; i < 14; ++i) if (F.tid < 256) tab[i * 256 + F.tid] = rv[i] * (unsigned)DM; }
            __syncthreads();
            pg8::EpiSwiglu E{(unsigned char*)F.hid8, mexp, F.sas, F.wsc + 2 + 32 * l};
            for (int rep = 0; rep < REP_HEAVY; ++rep) pg8::gemm_phase<pg8::EpiSwiglu, pg8::MoeOrder, true, true>(F.tid, F.lds, tab, DM, S, E);
            SEAM(pb + 8);
        }
        if (EN(10) && IN(pb + 10)) {
            const Ctx F = make_ctx(p, lds0);
            pg8::MoeOrder S{mexp / 256, DM / 256, F.G, F.bid, (const char*)F.hid8, (size_t)mexp * DEXP, (const char*)F.wdn + (size_t)l * NEXP * DM * DEXP, (size_t)DM * DEXP, (size_t)256 * DEXP};
            pg8::EpiDown E{F.y8, F.gate, mexp, F.wsc + 66 + 16 * l};
            pg8::gemm_phase<pg8::EpiDown, pg8::MoeOrder, false, true, true>(F.tid, F.lds, nullptr, DEXP, S, E);
            SEAM(pb + 10);
        }
    }
    if (EN(11) && IN(23)) { const Ctx F = make_ctx(p, lds0); phase_norm1(p, F, 2); }
#undef IN
#undef SEAM
}

extern "C" void kernel_launch(void* const* d_in, const int* in_sizes, int n_in, void* d_out, int out_size, void* d_ws, size_t ws_size, hipStream_t stream) {
    static int grid = 0;
    if (grid == 0) {
        if (n_in != 24 || out_size != NB * SEQ * DM || ws_size < WS_END) { fprintf(stderr, "kernel_launch: unexpected shapes: n_in %d out %d ws %zu (need %zu)\n", n_in, out_size, ws_size, (size_t)WS_END); grid = -1; return; }
        int dev = 0, cus = 0, per_cu = 0;
        if (hipGetDevice(&dev) != hipSuccess || hipDeviceGetAttribute(&cus, hipDeviceAttributeMultiprocessorCount, dev) != hipSuccess) { fprintf(stderr, "kernel_launch: device query failed\n"); grid = -1; return; }
        if (hipFuncSetAttribute((const void*)fwd_kernel, hipFuncAttributeMaxDynamicSharedMemorySize, LDS_BYTES) != hipSuccess) { fprintf(stderr, "kernel_launch: hipFuncSetAttribute failed\n"); grid = -1; return; }
        if (hipOccupancyMaxActiveBlocksPerMultiprocessor(&per_cu, (const void*)fwd_kernel, NTHR, LDS_BYTES) != hipSuccess || per_cu < 1) fprintf(stderr, "kernel_launch: note: occupancy query reports %d\n", per_cu);
        (void)hipGetLastError();
        grid = cus;
    }
    if (grid < 0) return;
    if (hipMemsetAsync((char*)d_ws + WS_CTL, 0, CTL_ZERO_BYTES, stream) != hipSuccess) { fprintf(stderr, "kernel_launch: memset failed\n"); return; }
    Params p{};
    const float** pp = (const float**)&p;
    for (int i = 0; i < 24; ++i) pp[i] = (const float*)d_in[i];
    p.out = (float*)d_out; p.ws = (unsigned char*)d_ws;
#if MK_MULTI
    for (int ph = 0; ph < 24; ++ph) { p.ph_lo = ph; p.ph_hi = ph + 1;
        hipLaunchKernelGGL(fwd_kernel, dim3(grid), dim3(NTHR), LDS_BYTES, stream, p); }
#elif defined(PROBE_K)
    p.ph_lo = 0; p.ph_hi = PROBE_K + 1;
    hipLaunchKernelGGL(fwd_kernel, dim3(grid), dim3(NTHR), LDS_BYTES, stream, p);
    (void)hipMemsetAsync((char*)d_ws + WS_CTL, 0, CTL_ZERO_BYTES, stream);
    p.ph_lo = PROBE_K2; p.ph_hi = 24;
    hipLaunchKernelGGL(fwd_kernel, dim3(grid), dim3(NTHR), LDS_BYTES, stream, p);
#else
    p.ph_lo = 0; p.ph_hi = 24;
    hipLaunchKernelGGL(fwd_kernel, dim3(grid), dim3(NTHR), LDS_BYTES, stream, p);
#endif
    const hipError_t le = hipPeekAtLastError();
    if (le != hipSuccess) fprintf(stderr, "kernel_launch: launch failed: %s\n", hipGetErrorName(le));
}
```

```cpp
#include <hip/hip_runtime.h>
#include <cstdio>
#include <cstdint>
#include <type_traits>

#ifndef MK_MULTI
#define MK_MULTI 0
#endif

#define LAS __attribute__((address_space(3)))
typedef unsigned short bf16_t;
typedef short bf16x8 __attribute__((ext_vector_type(8)));
typedef short s16x4 __attribute__((ext_vector_type(4)));
typedef float f32x4 __attribute__((ext_vector_type(4)));
typedef float f32x2 __attribute__((ext_vector_type(2)));
typedef float f32x16 __attribute__((ext_vector_type(16)));
typedef unsigned u32x4 __attribute__((ext_vector_type(4)));
typedef unsigned u32x2 __attribute__((ext_vector_type(2)));
typedef int i32x4 __attribute__((ext_vector_type(4)));
typedef int i32x8 __attribute__((ext_vector_type(8)));

constexpr int DM = 2048, NB = 8, SEQ = 4096, CTXL = 256, TPB = SEQ + CTXL, NROWS = NB * TPB;
constexpr int INW = 4608, NEXP = 16, DEXP = 1536, MODW = 6 * DM;
constexpr int MEXP_MAX = 4352;
constexpr float EPS = 1e-6f;
constexpr int NWAVES = 8, NTHR = 512;

constexpr size_t MiB = 1u << 20;
constexpr size_t WS_CTL = 0, CTL_ZERO_BYTES = 1 * MiB;
constexpr size_t WS_MOD = 1 * MiB;
constexpr size_t WS_AFFL = 2 * MiB;
constexpr size_t WS_AFFC = 4 * MiB;
constexpr size_t WS_SHD = 4 * MiB + 256 * 1024;
constexpr size_t WS_SO = 4 * MiB + 640 * 1024;
constexpr size_t WS_ROWS = 5 * MiB;
constexpr size_t WS_GATE = 5 * MiB + 512 * 1024;
constexpr size_t WS_SLOT = 6 * MiB;
constexpr size_t WS_SAX = 9 * MiB;
constexpr size_t WS_SAH = 9 * MiB + 256 * 1024;
constexpr size_t WS_SAS = 9 * MiB + 512 * 1024;
constexpr size_t WS_WSC = 9 * MiB + 896 * 1024;
constexpr size_t WS_XC = 10 * MiB;
constexpr size_t WS_WIN = 26 * MiB;
constexpr size_t WS_WOUT = 62 * MiB;
constexpr size_t WS_WGU = 78 * MiB;
constexpr size_t WS_K8 = 272 * MiB;
constexpr size_t WS_V8 = 288 * MiB;
constexpr size_t WS_K8D = 306 * MiB;
constexpr size_t WS_V8D = 342 * MiB;
constexpr size_t WS_WDN = 462 * MiB;
constexpr size_t WS_R1 = 654 * MiB;
constexpr size_t WS_R2 = 790 * MiB;
constexpr size_t WS_R3 = 1096 * MiB;
constexpr size_t WS_DLT = 1368 * MiB;
constexpr size_t WS_END = 1504 * MiB;

constexpr int RING_BYTES = 131072;
constexpr int TAB_OFF = 131072;
constexpr int LCTL_OFF = 146944;
constexpr int LDS_BYTES = 147456;

__device__ __forceinline__ unsigned cvtpk(float lo, float hi) { unsigned r; asm volatile("v_cvt_pk_bf16_f32 %0, %1, %2" : "=v"(r) : "v"(lo), "v"(hi)); return r; }
__device__ __forceinline__ float bflo(unsigned w) { return __uint_as_float(w << 16); }
__device__ __forceinline__ float bfhi(unsigned w) { return __uint_as_float(w & 0xffff0000u); }
__device__ __forceinline__ float wave_sum(float v) {
#pragma unroll
    for (int o = 1; o < 64; o <<= 1) v += __shfl_xor(v, o);
    return v;
}
__device__ __forceinline__ float wave_max(float v) {
#pragma unroll
    for (int o = 1; o < 64; o <<= 1) v = fmaxf(v, __shfl_xor(v, o));
    return v;
}
__device__ __forceinline__ f32x4 tof(const f32x4& a) { return a; }
__device__ __forceinline__ f32x4 tof(const i32x4& a) { return (f32x4){(float)a.x, (float)a.y, (float)a.z, (float)a.w}; }
__device__ __forceinline__ unsigned q8u(float x, float inv) { int q = __float2int_rn(x * inv); q = min(max(q, -127), 127); return (unsigned)q & 0xffu; }
__device__ __forceinline__ unsigned pack_i8x4(float a, float b, float c, float d, float inv) { return q8u(a, inv) | (q8u(b, inv) << 8) | (q8u(c, inv) << 16) | (q8u(d, inv) << 24); }
__device__ __forceinline__ float clamp_f8(float x) { return __builtin_amdgcn_fmed3f(x, -448.f, 448.f); }
__device__ __forceinline__ unsigned pack_f8x4(float a, float b, float c, float d, float inv) {
    int w = 0; w = __builtin_amdgcn_cvt_pk_fp8_f32(clamp_f8(a * inv), clamp_f8(b * inv), w, false); w = __builtin_amdgcn_cvt_pk_fp8_f32(clamp_f8(c * inv), clamp_f8(d * inv), w, true); return (unsigned)w; }
__device__ __forceinline__ unsigned pack_q4(float a, float b, float c, float d, float inv, bool f8) { const unsigned i = pack_i8x4(a, b, c, d, inv), f = pack_f8x4(a, b, c, d, inv); return f8 ? f : i; }
constexpr float HID_SCALE = 8.f;
constexpr float O8_SCALE = 64.f;
constexpr float Y_SCALE = 32.f;
__device__ __forceinline__ f32x4 unpack_f8x4(unsigned w) { const auto lo = __builtin_amdgcn_cvt_pk_f32_fp8((int)w, false), hi = __builtin_amdgcn_cvt_pk_f32_fp8((int)w, true); return (f32x4){lo[0], lo[1], hi[0], hi[1]}; }
__device__ __forceinline__ float amax4(const f32x4& v) { return fmaxf(fmaxf(fabsf(v.x), fabsf(v.y)), fmaxf(fabsf(v.z), fabsf(v.w))); }
__device__ __forceinline__ float silu_f(float x) { return x / (1.f + __expf(-x)); }
#define LDS_WAIT() asm volatile("s_waitcnt lgkmcnt(0)" ::: "memory")
#define VM_WAIT() asm volatile("s_waitcnt vmcnt(0)" ::: "memory")

struct Params {
    const float *x, *c, *ctx, *c_ctx, *w_ada, *b_ada, *g_mix, *g_ffn, *w_in, *w_out, *a_sink, *lq1, *lk1, *lq2, *lk2, *subln, *qn, *kn, *rpb, *w_router, *w_gate, *w_up, *w_down, *g_final;
    float* out; unsigned char* ws; int ph_lo, ph_hi;
};

#define XB_TMO      128
#define XB_XCNT(j)  (256  + 64 * (j))
#define XB_XSUB(j)  (1280 + 64 * (j))
#define XB_XGEN(j)  (2304 + 64 * (j))
#define XB_TOP      3328
#define XB_TOPGEN   3392
#define XCD_BAR_WORDS 3456
#define XB_SPIN_CAP (1u << 18)

__device__ __forceinline__ unsigned xb_ld(unsigned* p)              { return __hip_atomic_load(p, __ATOMIC_RELAXED, __HIP_MEMORY_SCOPE_AGENT); }
__device__ __forceinline__ unsigned xb_add(unsigned* p, unsigned v) { return __hip_atomic_fetch_add(p, v, __ATOMIC_RELAXED, __HIP_MEMORY_SCOPE_AGENT); }
__device__ __forceinline__ unsigned xb_xcc_id() { return (unsigned)__builtin_amdgcn_s_getreg((3 << 11) | 20) & 0xFu; }
#define XB_SPIN(cond, bar) do { unsigned _sp = 0; while (cond) { __builtin_amdgcn_s_sleep(1); \
    if ((++_sp & 255u) == 0u) { if (xb_ld(&(bar)[XB_TMO])) break; if (_sp > XB_SPIN_CAP) { atomicAdd(&(bar)[XB_TMO], 1u); break; } } } } while (0)

struct XcdBarrier { unsigned* bar; unsigned x; volatile LAS unsigned* st; };

__device__ __forceinline__ XcdBarrier xcd_barrier_post(unsigned* bar, volatile LAS unsigned* st) {
    XcdBarrier b; b.bar = bar; b.x = xb_xcc_id(); b.st = st;
    if (threadIdx.x == 0) (void)xb_add(&bar[XB_XCNT(b.x)], 1u);
    return b;
}
__device__ __forceinline__ void xcd_barrier_complete(unsigned* bar, unsigned x, unsigned& nloc, unsigned& nx) {
    const unsigned G = gridDim.x * gridDim.y * gridDim.z;
    unsigned sum, cnt, mine, sp = 0u;
    for (;;) {
        sum = 0u; cnt = 0u; mine = 0u;
#pragma unroll
        for (unsigned j = 0; j < 16; ++j) { const unsigned c = xb_ld(&bar[XB_XCNT(j)]); sum += c; cnt += (c > 0u) ? 1u : 0u; mine = (j == x) ? c : mine; }
        if (sum == G) break;
        __builtin_amdgcn_s_sleep(1);
        if ((++sp & 255u) == 0u) { if (xb_ld(&bar[XB_TMO])) break; if (sp > XB_SPIN_CAP) { atomicAdd(&bar[XB_TMO], 1u); break; } }
    }
    nloc = mine > 0u ? mine : 1u; nx = cnt > 0u ? cnt : 1u;
}
__device__ __forceinline__ void xcd_barrier(const XcdBarrier& b) {
    asm volatile("s_waitcnt vmcnt(0)" ::: "memory");
    __syncthreads();
    if (threadIdx.x == 0) {
        unsigned* bar = b.bar;
        __builtin_amdgcn_s_waitcnt(0);
        unsigned nloc = b.st[0], nx = b.st[1];
        if (nloc == 0u) { xcd_barrier_complete(bar, b.x, nloc, nx); b.st[0] = nloc; b.st[1] = nx; }
        const unsigned old = xb_add(&bar[XB_XSUB(b.x)], 1u);
        const unsigned gen = old / nloc;
        if (old + 1u == (gen + 1u) * nloc) {
            __builtin_amdgcn_fence(__ATOMIC_RELEASE, "agent");
            asm volatile("s_waitcnt vmcnt(0)" ::: "memory");
            const unsigned og = xb_add(&bar[XB_TOP], 1u);
            const unsigned tg = og / nx;
            if (og + 1u == (tg + 1u) * nx) xb_add(&bar[XB_TOPGEN], 1u);
            else XB_SPIN(xb_ld(&bar[XB_TOPGEN]) == tg, bar);
            __builtin_amdgcn_fence(__ATOMIC_ACQUIRE, "agent");
            xb_add(&bar[XB_XGEN(b.x)], 1u);
            asm volatile("s_waitcnt vmcnt(0)" ::: "memory");
        } else {
            XB_SPIN(xb_ld(&bar[XB_XGEN(b.x)]) == gen, bar);
            __builtin_amdgcn_fence(__ATOMIC_ACQUIRE, "agent");
            asm volatile("s_waitcnt vmcnt(0)" ::: "memory");
        }
    }
    __syncthreads();
}

namespace pg8 {
constexpr int BM = 256, BK = 64, HALF = 128, HTB = HALF * BK * 2, STAGE_BYTES = 8 * HTB, NXCD = 8, WGM = 8;
__device__ __forceinline__ int lds_byte(int r, int c) { const int st = (r >> 4) * 2 + (c >> 5), rr = r & 15, cc = c & 31, ob = rr * 64 + cc * 2; return st * 1024 + (ob ^ (((ob >> 9) & 1) << 5)); }
__device__ __forceinline__ void stage_rc(int b, int& R, int& C) { const int st = b / 1024, sb = b % 1024, swz = sb ^ (((sb >> 9) & 1) << 5); R = (st >> 1) * 16 + swz / 64; C = (st & 1) * 32 + (swz % 64) / 2; }
__device__ __forceinline__ int perm32(int rho) { const int n = rho >> 4, i = rho & 15; return 8 * (i >> 2) + 4 * n + (i & 3); }

struct Unit { int pm, pn, e; };

__device__ __forceinline__ bool static_tile(long L, int nM, int nN, int& pm, int& pn) {
    const int nwg = nM * nN; if (L >= nwg) return false;
    int wgid = (int)L; { const int q = nwg / NXCD, r = nwg % NXCD, xcd = wgid % NXCD, off = wgid / NXCD; wgid = (xcd < r ? xcd * (q + 1) : r * (q + 1) + (xcd - r) * q) + off; }
    const int nig = WGM * nN, gid = wgid / nig, fm = gid * WGM, gsz = (nM - fm) < WGM ? (nM - fm) : WGM;
    pm = fm + ((wgid % nig) % gsz); pn = (wgid % nig) / gsz; return true;
}
struct DenseOrder {
    int nM, nN, G, c, skipctx; const char* A; const char* Bt; size_t tstep;
    __device__ __forceinline__ bool next(int i, Unit& u) const {
        int pm, pn; if (!static_tile((long)i * G + c, nM, nN, pm, pn)) return false;
        u.pm = skipctx ? (pm >> 4) * 17 + 1 + (pm & 15) : pm; u.pn = pn; u.e = 0; return true; }
    __device__ __forceinline__ const char* a_base(const Unit& u) const { return A + (size_t)u.pm * tstep; }
    __device__ __forceinline__ const char* b_base(const Unit& u) const { return Bt + (size_t)u.pn * tstep; }
};
struct MoeOrder {
    int nMe, nN, G, c; const char* A; size_t a_estride; const char* Bt; size_t b_estride; size_t tstep;
    __device__ __forceinline__ bool next(int i, Unit& u) const {
        const int per_e = nMe * nN, nwg = per_e * NEXP; const long L = (long)i * G + c; if (L >= nwg) return false;
        int wgid = (int)L; { const int q = nwg / NXCD, r = nwg % NXCD, xcd = wgid % NXCD, off = wgid / NXCD; wgid = (xcd < r ? xcd * (q + 1) : r * (q + 1) + (xcd - r) * q) + off; }
        u.e = wgid / per_e; const int loc = wgid % per_e;
        const int nig = WGM * nN, gid = loc / nig, fm = gid * WGM, gsz = (nMe - fm) < WGM ? (nMe - fm) : WGM;
        u.pm = fm + ((loc % nig) % gsz); u.pn = (loc % nig) / gsz; return true; }
    __device__ __forceinline__ const char* a_base(const Unit& u) const { return A + (size_t)u.e * a_estride + (a_estride ? (size_t)u.pm * tstep : 0); }
    __device__ __forceinline__ const char* b_base(const Unit& u) const { return Bt + (size_t)u.e * b_estride + (size_t)u.pn * tstep; }
};

struct EpiP {
    static constexpr bool PERM = true; unsigned char* wsb; int rope; float sw;
    template <class AT> __device__ __forceinline__ void operator()(const AT (&acc)[2][2][4][2], const Unit& u, int wr, int wc, int fr, int fq) const {
        const int row0 = u.pm * BM + wr * 64 + fr, col0 = u.pn * BM + wc * 32 + 8 * fq;
        const int pt = u.pm % 17;
        bf16_t* const O = (bf16_t*)(wsb + WS_R2); const float* const sa = (const float*)(wsb + WS_SAX);
        unsigned char* const k8a = wsb + WS_K8; unsigned char* const k8b = wsb + WS_K8D; unsigned char* const v8a = wsb + WS_V8; unsigned char* const v8b = wsb + WS_V8D;
        int frl = fr, fql = fq; asm volatile("" : "+v"(frl), "+v"(fql));
        unsigned char* kq = nullptr;
        if (rope) { if (u.pn == 4) kq = k8a; else if (u.pn >= 10 && u.pn <= 13) kq = k8b + (size_t)(u.pn - 10) * 2 * NROWS * 128; }
        if (u.pn == 5 || (rope && u.pn >= 14)) {
            const int b = u.pm / 17, qi = frl & 3, a4 = frl >> 2, nhv = u.pn == 5 ? 2 : 8, hv0 = u.pn == 5 ? 0 : (u.pn - 14) * 2; unsigned char* vq = u.pn == 5 ? v8a : v8b;
            const unsigned sel = (unsigned)qi | ((unsigned)(4 + qi) << 8) | 0x0c0c0000u;
#pragma unroll
            for (int ai = 0; ai < 2; ++ai)
#pragma unroll
                for (int m = 0; m < 4; ++m) { const float rsc = sa[row0 + ai * HALF + m * 16] * sw;
                    const int tile = (u.pm % 17) * 4 + wr + 2 * ai, pos0 = 32 * (a4 & 1) + 16 * (m >> 1) + 4 * ((2 * m + (a4 >> 1)) & 3);
#pragma unroll
                    for (int bj = 0; bj < 2; ++bj) { const f32x4 v0 = tof(acc[ai][bj][m][0]) * rsc, v1 = tof(acc[ai][bj][m][1]) * rsc;
                        unsigned char* tb_ = vq + ((size_t)((b * nhv + hv0 + bj) * 68 + tile)) * 8192 + (size_t)(wc * 32 + 8 * fql) * 64 + pos0;
#pragma unroll
                        for (int hh = 0; hh < 2; ++hh) { const f32x4 vv = hh ? v1 : v0; const int w = (int)pack_f8x4(vv[0], vv[1], vv[2], vv[3], 1.f);
                            const unsigned p0 = (unsigned)__builtin_amdgcn_update_dpp(0, w, 0x00, 0xf, 0xf, false), p1 = (unsigned)__builtin_amdgcn_update_dpp(0, w, 0x55, 0xf, 0xf, false);
                            const unsigned p2 = (unsigned)__builtin_amdgcn_update_dpp(0, w, 0xaa, 0xf, 0xf, false), p3 = (unsigned)__builtin_amdgcn_update_dpp(0, w, 0xff, 0xf, 0xf, false);
                            const unsigned t01 = __builtin_amdgcn_perm(p1, p0, sel), t23 = __builtin_amdgcn_perm(p3, p2, sel);
                            *(unsigned*)(tb_ + (hh * 4 + qi) * 64) = t01 | (t23 << 16); } } }
            return;
        }
        const bool dorope = rope && pt != 0 && (u.pn <= 4 || (u.pn >= 6 && u.pn <= 13));
        const int jf = ((wc & 1) * 4 + fq) * 4;
        float inv[4];
#pragma unroll
        for (int i = 0; i < 4; ++i) inv[i] = exp2f(-(float)(jf + i) * (13.287712379549449f / 32.f));
#pragma unroll
        for (int ai = 0; ai < 2; ++ai)
#pragma unroll
            for (int m = 0; m < 4; ++m) { bf16_t* rowp = O + (size_t)(row0 + ai * HALF + m * 16) * INW + col0; const float rsc = sa[row0 + ai * HALF + m * 16] * sw;
                float cs[4], sn[4];
                if (dorope) { const int pos = (pt - 1) * 256 + wr * 64 + ai * HALF + m * 16 + fr; const float pp = (float)((wc >> 1) == 0 ? (pos >> 6) : (pos & 63));
#pragma unroll
                    for (int i = 0; i < 4; ++i) { const float ang = pp * inv[i]; cs[i] = __cosf(ang); sn[i] = __sinf(ang); } }
#pragma unroll
                for (int bj = 0; bj < 2; ++bj) { f32x4 v0 = tof(acc[ai][bj][m][0]) * rsc, v1 = tof(acc[ai][bj][m][1]) * rsc;
                    if (dorope) {
#pragma unroll
                        for (int i = 0; i < 4; ++i) { const float a = v0[i], b = v1[i]; v0[i] = a * cs[i] - b * sn[i]; v1[i] = b * cs[i] + a * sn[i]; } }
                    u32x4 w; w.x = cvtpk(v0[0], v0[1]); w.y = cvtpk(v0[2], v0[3]); w.z = cvtpk(v1[0], v1[1]); w.w = cvtpk(v1[2], v1[3]);
                    if (kq == nullptr) *(u32x4*)(rowp + bj * HALF) = w;
                    if (kq != nullptr) { u32x2 w8; w8.x = pack_f8x4(v0[0], v0[1], v0[2], v0[3], 1.f); w8.y = pack_f8x4(v1[0], v1[1], v1[2], v1[3], 1.f);
                        *(u32x2*)(kq + ((size_t)bj * NROWS + (u.pm * BM + wr * 64 + frl + ai * HALF + m * 16)) * 128 + wc * 32 + 8 * fql) = w8; } } }
    }
};
struct EpiDelta {
    static constexpr bool PERM = true; bf16_t* D; const float* modl; const float* so; float sw;
    template <class AT> __device__ __forceinline__ void operator()(const AT (&acc)[2][2][4][2], const Unit& u, int wr, int wc, int fr, int fq) const {
        const int b = u.pm / 17, pt = u.pm % 17;
        const float* gt = modl + (size_t)(pt == 0 ? 8 : b) * MODW + 2 * DM;
        const int row0 = u.pm * BM + wr * 64 + fr, col0 = u.pn * BM + wc * 32 + 8 * fq;
        f32x4 g[2][2];
#pragma unroll
        for (int bj = 0; bj < 2; ++bj)
#pragma unroll
            for (int n = 0; n < 2; ++n) g[bj][n] = *(const f32x4*)(gt + col0 + bj * HALF + 4 * n) * sw;
#pragma unroll
        for (int ai = 0; ai < 2; ++ai)
#pragma unroll
            for (int m = 0; m < 4; ++m) { const int row = row0 + ai * HALF + m * 16; const float rs = so ? so[row] : 1.f; bf16_t* rowp = D + (size_t)row * DM + col0;
#pragma unroll
                for (int bj = 0; bj < 2; ++bj) { const f32x4 v0 = tof(acc[ai][bj][m][0]) * g[bj][0] * rs, v1 = tof(acc[ai][bj][m][1]) * g[bj][1] * rs;
                    u32x4 w; w.x = cvtpk(v0[0], v0[1]); w.y = cvtpk(v0[2], v0[3]); w.z = cvtpk(v1[0], v1[1]); w.w = cvtpk(v1[2], v1[3]);
                    *(u32x4*)(rowp + bj * HALF) = w; } }
    }
};
struct EpiSwiglu {
    static constexpr bool PERM = true; unsigned char* H; int mexp; const float* sas; const float* wsc;
    template <class AT> __device__ __forceinline__ void operator()(const AT (&acc)[2][2][4][2], const Unit& u, int wr, int wc, int fr, int fq) const {
        const int row0 = u.e * mexp + u.pm * BM + wr * 64 + fr, col0 = u.pn * 128 + wc * 16 + 4 * fq;
        const float sg = wsc[2 * u.e], su = wsc[2 * u.e + 1];
#pragma unroll
        for (int ai = 0; ai < 2; ++ai)
#pragma unroll
            for (int m = 0; m < 4; ++m) { unsigned char* rowp = H + (size_t)(row0 + ai * HALF + m * 16) * DEXP + col0; const float rs_ = sas[row0 + ai * HALF + m * 16];
#pragma unroll
                for (int bj = 0; bj < 2; ++bj) { const f32x4 g = tof(acc[ai][bj][m][0]) * (rs_ * sg), up = tof(acc[ai][bj][m][1]) * (rs_ * su); f32x4 h;
#pragma unroll
                    for (int q = 0; q < 4; ++q) h[q] = g[q] * __builtin_amdgcn_rcpf(1.f + __expf(-g[q])) * up[q];
                    *(unsigned*)(rowp + bj * 64) = pack_f8x4(h[0], h[1], h[2], h[3], HID_SCALE); } }
    }
};
struct EpiDown {
    static constexpr bool PERM = true; unsigned char* Y; const float* gate; int mexp; const float* wsc;
    template <class AT> __device__ __forceinline__ void operator()(const AT (&acc)[2][2][4][2], const Unit& u, int wr, int wc, int fr, int fq) const {
        const int row0 = u.e * mexp + u.pm * BM + wr * 64 + fr, col0 = u.pn * BM + wc * 32 + 8 * fq;
#pragma unroll
        for (int ai = 0; ai < 2; ++ai)
#pragma unroll
            for (int m = 0; m < 4; ++m) { const int row = row0 + ai * HALF + m * 16; const float gv = gate[row] * (wsc[u.e] * (Y_SCALE / HID_SCALE)); unsigned char* rowp = Y + (size_t)row * DM + col0;
#pragma unroll
                for (int bj = 0; bj < 2; ++bj) { const f32x4 v0 = tof(acc[ai][bj][m][0]) * gv, v1 = tof(acc[ai][bj][m][1]) * gv;
                    u32x2 w; w.x = pack_f8x4(v0[0], v0[1], v0[2], v0[3], 1.f); w.y = pack_f8x4(v1[0], v1[1], v1[2], v1[3], 1.f);
                    *(u32x2*)(rowp + bj * HALF) = w; } }
    }
};

__device__ __forceinline__ void mfma_f8(f32x4& acc, const i32x8 a, const i32x8 b) { asm volatile("v_mfma_f32_16x16x128_f8f6f4 %0, %1, %2, %0" : "+v"(acc) : "v"(a), "v"(b)); }
__device__ __forceinline__ void mfma_f8(i32x4& acc, const i32x8 a, const i32x8 b) { }
template <class Epi, class Sched, bool GATHER, bool I8, bool F8 = false>
__device__ __forceinline__ void gemm_phase(const int tid, LAS unsigned char* lds, const LAS unsigned* rowtab, const int KB, const Sched& S, const Epi& E) {
    const int wid = __builtin_amdgcn_readfirstlane(tid >> 6), lane = tid & 63, wr = wid >> 2, wc = wid & 3, fr = lane & 15, fq = lane >> 4;
    const int nt = KB / (BK * 2);
    const unsigned hstep = (unsigned)HALF * KB;
    const size_t kstep = (size_t)(BK * 2);
    unsigned voffB[2], vAc[2][2];
#pragma unroll
    for (int i = 0; i < 2; ++i) { int R, C; stage_rc(tid * 16 + i * 8192, R, C); const int Rb = Epi::PERM ? ((R & ~31) + perm32(R & 31)) : R;
        voffB[i] = (unsigned)(Rb * KB) + (unsigned)C * 2u; }
    const unsigned ldsw = (unsigned)wid * 1024u;
    const int aoff = lds_byte(wr * 64 + fr, fq * 8), boff = lds_byte(wc * 32 + fr, fq * 8);
#define PG8_SA(b, h) (((b) * 2 + (h)) * HTB)
#define PG8_SB(b, h) ((4 + (b) * 2 + (h)) * HTB)
#define PG8_STAGE(bufoff, gbase, voff) do { _Pragma("unroll") for (int _i = 0; _i < 2; ++_i) \
        __builtin_amdgcn_global_load_lds((const unsigned*)((const char*)(gbase) + (voff)[_i]), (LAS unsigned*)(lds + (bufoff) + ldsw + _i * 8192), 16, 0, 0); } while (0)
#define PG8_LDA(dst, b, h) do { _Pragma("unroll") for (int m = 0; m < 4; ++m) _Pragma("unroll") for (int k = 0; k < 2; ++k) dst[m][k] = *(const LAS bf16x8*)(lds + PG8_SA(b, h) + aoff + m * 2048 + k * 1024); } while (0)
#define PG8_LDB(dst, b, h) do { _Pragma("unroll") for (int n = 0; n < 2; ++n) _Pragma("unroll") for (int k = 0; k < 2; ++k) dst[n][k] = *(const LAS bf16x8*)(lds + PG8_SB(b, h) + boff + n * 2048 + k * 1024); } while (0)
#define PG8_MMA(ai, bj, At, Bt) do { __builtin_amdgcn_s_setprio(1); _Pragma("unroll") for (int m = 0; m < 4; ++m) _Pragma("unroll") for (int n = 0; n < 2; ++n) \
        if constexpr (F8) mfma_f8(acc[ai][bj][m][n], __builtin_shufflevector(__builtin_bit_cast(i32x4, Bt[n][0]), __builtin_bit_cast(i32x4, Bt[n][1]), 0, 1, 2, 3, 4, 5, 6, 7), \
            __builtin_shufflevector(__builtin_bit_cast(i32x4, At[m][0]), __builtin_bit_cast(i32x4, At[m][1]), 0, 1, 2, 3, 4, 5, 6, 7)); \
        else _Pragma("unroll") for (int k = 0; k < 2; ++k) \
        { if constexpr (I8) acc[ai][bj][m][n] = __builtin_amdgcn_mfma_i32_16x16x64_i8(__builtin_bit_cast(i32x4, Bt[n][k]), __builtin_bit_cast(i32x4, At[m][k]), acc[ai][bj][m][n], 0, 0, 0); \
          else acc[ai][bj][m][n] = __builtin_amdgcn_mfma_f32_16x16x32_bf16(Bt[n][k], At[m][k], acc[ai][bj][m][n], 0, 0, 0); } __builtin_amdgcn_s_setprio(0); } while (0)
#define PG8_WAIT_V(n) asm volatile("s_waitcnt vmcnt(" #n ")" ::: "memory")
#define PG8_WAIT_L(n) asm volatile("s_waitcnt lgkmcnt(" #n ")" ::: "memory")
#define PG8_BAR __builtin_amdgcn_s_barrier()
#define PG8_SCHED __builtin_amdgcn_sched_barrier(0)
#define PG8_LOADTAB(dst, ui_) do { _Pragma("unroll") for (int _i = 0; _i < 2; ++_i) { int _R, _C; stage_rc(tid * 16 + _i * 8192, _R, _C); _Pragma("unroll") for (int _h = 0; _h < 2; ++_h) \
        dst[_h][_i] = GATHER ? rowtab[(ui_) * 256 + _h * HALF + _R] + (unsigned)_C * 2u : (unsigned)((_h * HALF + _R) * KB) + (unsigned)_C * 2u; } } while (0)
    Unit cur, nxt; int ui = 0;
    if (!S.next(0, cur)) return;
    typedef typename std::conditional<I8 && !F8, i32x4, f32x4>::type acc_t;
    acc_t acc[2][2][4][2];
#pragma unroll
    for (int a = 0; a < 2; ++a)
#pragma unroll
        for (int b = 0; b < 2; ++b)
#pragma unroll
            for (int m = 0; m < 4; ++m)
#pragma unroll
                for (int n = 0; n < 2; ++n) acc[a][b][m][n] = acc_t{};
    bf16x8 At[4][2], B0[2][2], B1[2][2];
    const char* cA = S.a_base(cur); const char* cB = S.b_base(cur);
    PG8_LOADTAB(vAc, 0);
    PG8_STAGE(PG8_SB(0, 0), cB, voffB); PG8_STAGE(PG8_SB(0, 1), cB + hstep, voffB); PG8_STAGE(PG8_SA(0, 0), cA, vAc[0]); PG8_STAGE(PG8_SA(0, 1), cA, vAc[1]);
    if (wr == 1) PG8_BAR;
    PG8_WAIT_V(2); PG8_BAR;
    PG8_STAGE(PG8_SB(1, 0), cB + kstep, voffB); PG8_STAGE(PG8_SA(1, 0), cA + kstep, vAc[0]); PG8_STAGE(PG8_SB(1, 1), cB + hstep + kstep, voffB);
    PG8_WAIT_V(6); PG8_BAR;
    for (;;) {
        const bool has_next = S.next(ui + 1, nxt);
        const char* nA = has_next ? S.a_base(nxt) : cA; const char* nB = has_next ? S.b_base(nxt) : cB;
        for (int t = 0; t < nt; t += 2) {
            const bool last = (t == nt - 2);
            const char* a1 = cA + (size_t)(t + 1) * kstep;
            const char* a2 = last ? nA : cA + (size_t)(t + 2) * kstep; const char* b2 = last ? nB : cB + (size_t)(t + 2) * kstep;
            const char* a3 = a2 + kstep; const char* b3 = b2 + kstep;
            PG8_LDB(B0, 0, 0); PG8_LDB(B1, 0, 1); PG8_SCHED; PG8_LDA(At, 0, 0); PG8_STAGE(PG8_SA(1, 1), a1, vAc[1]);
            if (GATHER) { if (last && has_next) { PG8_LOADTAB(vAc, ui + 1); } }
            PG8_WAIT_V(8); PG8_WAIT_L(0); PG8_BAR; PG8_MMA(0, 0, At, B0); PG8_MMA(0, 1, At, B1); PG8_BAR; PG8_SCHED;
            PG8_LDA(At, 0, 1); PG8_STAGE(PG8_SB(0, 0), b2, voffB); PG8_STAGE(PG8_SB(0, 1), b2 + hstep, voffB); PG8_STAGE(PG8_SA(0, 0), a2, vAc[0]);
            PG8_WAIT_V(8); PG8_WAIT_L(0); PG8_BAR; PG8_MMA(1, 0, At, B0); PG8_MMA(1, 1, At, B1); PG8_BAR; PG8_SCHED;
            PG8_LDB(B0, 1, 0); PG8_LDB(B1, 1, 1); PG8_SCHED; PG8_LDA(At, 1, 0); PG8_STAGE(PG8_SA(0, 1), a2, vAc[1]);
            PG8_WAIT_V(8); PG8_WAIT_L(0); PG8_BAR; PG8_MMA(0, 0, At, B0); PG8_MMA(0, 1, At, B1); PG8_BAR; PG8_SCHED;
            PG8_LDA(At, 1, 1); PG8_STAGE(PG8_SB(1, 0), b3, voffB); PG8_STAGE(PG8_SB(1, 1), b3 + hstep, voffB); PG8_STAGE(PG8_SA(1, 0), a3, vAc[0]);
            PG8_WAIT_V(8); PG8_WAIT_L(0); PG8_BAR; PG8_MMA(1, 0, At, B0); PG8_MMA(1, 1, At, B1); PG8_BAR; PG8_SCHED;
        }
        if (wr == 0) PG8_BAR;
        E(acc, cur, wr, wc, fr, fq);
        if (!has_next) break;
#pragma unroll
        for (int a = 0; a < 2; ++a)
#pragma unroll
            for (int b = 0; b < 2; ++b)
#pragma unroll
                for (int m = 0; m < 4; ++m)
#pragma unroll
                    for (int n = 0; n < 2; ++n) acc[a][b][m][n] = acc_t{};
        cur = nxt; cA = nA; cB = nB; ++ui;
        if (wr == 1) PG8_BAR;
    }
    PG8_WAIT_V(0);
    PG8_BAR;
#undef PG8_SA
#undef PG8_SB
#undef PG8_STAGE
#undef PG8_LDA
#undef PG8_LDB
#undef PG8_MMA
#undef PG8_WAIT_V
#undef PG8_WAIT_L
#undef PG8_BAR
#undef PG8_SCHED
#undef PG8_LOADTAB
}
}

namespace att {
constexpr int D = 128, NW = 8, QBLK = 32, KVBLK = 64, LDP = INW;
constexpr float SCALE = 0.088388347648318440f;
constexpr float THR = 8.f;
constexpr int NBUF = 3;
constexpr int SHM_V = KVBLK * D * 2, SHM_K = KVBLK * D * 2, SHM_ATTN = NBUF * SHM_V + NBUF * SHM_K + NW * 64 * 4;
constexpr int BIAS_OFF = 100352;
#define KSWZ(row, colB) ((row) * 256 + ((colB) ^ (((row) & 7) << 4)))
#define SBAR() __builtin_amdgcn_sched_barrier(0)
__device__ __forceinline__ int crow(int r, int hi) { return (r & 3) + 8 * (r >> 2) + 4 * hi; }

struct AUnit { int qrow0, qcol, kcol, vcol, kbase, NT, seg2row, mode, pa, pb, head, ocol, outf32, has_sink; float sink; };

template <bool FIXREF = false> __device__ __forceinline__ void partialSM(f32x16& p0, f32x16& p1, float& m_reg, float& mn, float& alpha) {
  constexpr float C = SCALE * 1.4426950408889634f;
  if constexpr (FIXREF) { mn = m_reg; alpha = 1.f;
#pragma unroll
    for (int r = 0; r < 16; ++r) p0[r] = __builtin_amdgcn_exp2f(p0[r]);
    return; }
  float pmax = p0[0];
#pragma unroll
  for (int r = 1; r < 16; ++r) pmax = fmaxf(pmax, p0[r]);
#pragma unroll
  for (int r = 0; r < 16; ++r) pmax = fmaxf(pmax, p1[r]);
  { auto rr = __builtin_amdgcn_permlane32_swap(__float_as_uint(pmax), __float_as_uint(pmax), false, false);
    pmax = fmaxf(__uint_as_float(rr[0]), __uint_as_float(rr[1])); }
  if (__builtin_expect(__all(pmax - m_reg <= THR / SCALE), 1)) { mn = m_reg; alpha = 1.f; }
  else { mn = fmaxf(m_reg, pmax); alpha = __builtin_amdgcn_exp2f((m_reg - mn) * C); m_reg = mn; }
  float mnC = -mn * C;
#pragma unroll
  for (int r = 0; r < 16; ++r) p0[r] = fmaf(p0[r], C, mnC);
#pragma unroll
  for (int r = 0; r < 16; ++r) p1[r] = fmaf(p1[r], C, mnC);
#pragma unroll
  for (int r = 0; r < 16; ++r) p0[r] = __builtin_amdgcn_exp2f(p0[r]);
}
__device__ __forceinline__ void firstSM(f32x16& p0, f32x16& p1, float& m_reg) {
  float pmax = p0[0];
#pragma unroll
  for (int r = 1; r < 16; ++r) pmax = fmaxf(pmax, p0[r]);
#pragma unroll
  for (int r = 0; r < 16; ++r) pmax = fmaxf(pmax, p1[r]);
  { auto rr = __builtin_amdgcn_permlane32_swap(__float_as_uint(pmax), __float_as_uint(pmax), false, false);
    pmax = fmaxf(__uint_as_float(rr[0]), __uint_as_float(rr[1])); }
  m_reg = pmax;
#pragma unroll
  for (int r = 0; r < 16; ++r) p0[r] = __builtin_amdgcn_exp2f(p0[r] - pmax);
#pragma unroll
  for (int r = 0; r < 16; ++r) p1[r] -= pmax;
}
__device__ __forceinline__ void finishSM(f32x16& p0, f32x16& p1, float alpha, float& l_reg, bf16x8& pa0, bf16x8& pa1, bf16x8& pa2, bf16x8& pa3) {
#pragma unroll
  for (int r = 0; r < 16; ++r) p1[r] = __builtin_amdgcn_exp2f(p1[r]);
  float ps = 0;
#pragma unroll
  for (int r = 0; r < 16; ++r) ps += p0[r];
#pragma unroll
  for (int r = 0; r < 16; ++r) ps += p1[r];
  { auto rr = __builtin_amdgcn_permlane32_swap(__float_as_uint(ps), __float_as_uint(ps), false, false);
    ps = __uint_as_float(rr[0]) + __uint_as_float(rr[1]); }
  l_reg = l_reg * alpha + ps;
#define PK4(P, BASE, OUT) do { unsigned a0 = cvtpk(P[BASE + 0], P[BASE + 1]), a1 = cvtpk(P[BASE + 2], P[BASE + 3]);   \
    unsigned b0 = cvtpk(P[BASE + 4], P[BASE + 5]), b1 = cvtpk(P[BASE + 6], P[BASE + 7]);                              \
    auto r0 = __builtin_amdgcn_permlane32_swap(a0, b0, false, false); auto r1 = __builtin_amdgcn_permlane32_swap(a1, b1, false, false); \
    u32x4 w = {r0[0], r1[0], r0[1], r1[1]}; OUT = *reinterpret_cast<bf16x8*>(&w); } while (0)
  PK4(p0, 0, pa0); PK4(p0, 8, pa1); PK4(p1, 0, pa2); PK4(p1, 8, pa3);
#undef PK4
}
__device__ __forceinline__ void qkt(f32x16& p0, f32x16& p1, const LAS char* Ks, const bf16x8* qr, int r32, int hi, const f32x16& init) {
  p0 = init; p1 = init;
#pragma unroll
  for (int d0 = 0; d0 < 8; ++d0) { int cb = (d0 * 16 + hi * 8) * 2;
    bf16x8 b0 = *reinterpret_cast<const LAS bf16x8*>(Ks + KSWZ(r32, cb));
    bf16x8 b1 = *reinterpret_cast<const LAS bf16x8*>(Ks + KSWZ(32 + r32, cb));
    p0 = __builtin_amdgcn_mfma_f32_32x32x16_bf16(b0, qr[d0], p0, 0, 0, 0);
    p1 = __builtin_amdgcn_mfma_f32_32x32x16_bf16(b1, qr[d0], p1, 0, 0, 0); }
}
__device__ __forceinline__ int v_st(int k, int c) { const int kk = (k & ~0xC) | ((k & 4) << 1) | ((k & 8) >> 1); return ((kk >> 3) * 4 + (c >> 5)) * 512 + ((kk & 7) * 32 + (c & 31)) * 2; }
__device__ __forceinline__ int v_rd_base(int lane) { return ((lane & 3) << 3) | (((lane >> 2) & 3) << 6) | (((lane >> 4) & 1) << 5) | (((lane >> 5) & 1) << 8); }
constexpr int v_rd_off(int d0, int ks, int half) { return d0 * 512 + ks * 4096 + half * 2048; }
template <int OFF> __device__ __forceinline__ s16x4 tr_read(int vb) {
  s16x4 r; asm volatile("ds_read_b64_tr_b16 %0, %1 offset:%2" : "=&v"(r) : "v"(vb), "i"(OFF) : "memory"); return r;
}
template <int D0> __device__ __forceinline__ void pv_one(f32x16& od, int vb, bf16x8 pa0, bf16x8 pa1, bf16x8 pa2, bf16x8 pa3) {
  const s16x4 l0 = tr_read<v_rd_off(D0, 0, 0)>(vb), h0 = tr_read<v_rd_off(D0, 0, 1)>(vb), l1 = tr_read<v_rd_off(D0, 1, 0)>(vb), h1 = tr_read<v_rd_off(D0, 1, 1)>(vb);
  const s16x4 l2 = tr_read<v_rd_off(D0, 2, 0)>(vb), h2 = tr_read<v_rd_off(D0, 2, 1)>(vb), l3 = tr_read<v_rd_off(D0, 3, 0)>(vb), h3 = tr_read<v_rd_off(D0, 3, 1)>(vb);
  asm volatile("s_waitcnt lgkmcnt(0)" ::: "memory"); SBAR();
#define PK(L, H) (bf16x8){L[0], L[1], L[2], L[3], H[0], H[1], H[2], H[3]}
  od = __builtin_amdgcn_mfma_f32_32x32x16_bf16(pa0, PK(l0, h0), od, 0, 0, 0);
  od = __builtin_amdgcn_mfma_f32_32x32x16_bf16(pa1, PK(l1, h1), od, 0, 0, 0);
  od = __builtin_amdgcn_mfma_f32_32x32x16_bf16(pa2, PK(l2, h2), od, 0, 0, 0);
  od = __builtin_amdgcn_mfma_f32_32x32x16_bf16(pa3, PK(l3, h3), od, 0, 0, 0);
#undef PK
}
__device__ __forceinline__ void pv_d0(f32x16* o, int vb, bf16x8 pa0, bf16x8 pa1, bf16x8 pa2, bf16x8 pa3) {
  pv_one<0>(o[0], vb, pa0, pa1, pa2, pa3); pv_one<1>(o[1], vb, pa0, pa1, pa2, pa3); pv_one<2>(o[2], vb, pa0, pa1, pa2, pa3); pv_one<3>(o[3], vb, pa0, pa1, pa2, pa3);
}
template <int MODE> __device__ __forceinline__ void mask_tile(f32x16& p0, f32x16& p1, const AUnit& u, int j, int wid, int r32, int hi, const LAS float* btab) {
  if (MODE == 0 || j < 4) return;
  if (MODE == 1) {
    const int qpos = u.pa + wid * 32 + r32, k0 = u.pb + (j - 4) * 64 + 4 * hi;
#pragma unroll
    for (int r = 0; r < 16; ++r) { const int d = qpos - (k0 + (r & 3) + 8 * (r >> 2));
      p0[r] = (d <= 128 && d >= -128) ? p0[r] : -1e30f; const int d1 = d - 32; p1[r] = (d1 <= 128 && d1 >= -128) ? p1[r] : -1e30f; }
  } else {
    const int qr = u.pa + (wid >> 1), qc = (wid & 1) * 32 + r32, kr = u.pb + (j - 4);
    const int rs = min(max(qr - 4, 0), 56), cs = min(max(qc - 8, 0), 48);
    const bool rowok = (kr >= rs) && (kr < rs + 8);
    const LAS float* tb = btab + u.head * 480 + (kr - qr + 7) * 32 + (15 - qc) + 4 * hi;
#pragma unroll
    for (int r = 0; r < 16; ++r) { const int kc = (r & 3) + 8 * (r >> 2), kf = kc + 4 * hi;
      const float b0 = tb[kc], b1 = tb[kc + 32];
      p0[r] = (rowok && kf >= cs && kf < cs + 16) ? p0[r] + b0 : -1e30f;
      p1[r] = (rowok && kf + 32 >= cs && kf + 32 < cs + 16) ? p1[r] + b1 : -1e30f; }
  }
}

__device__ __forceinline__ void store_o8(unsigned char* Ow, const f32x16 (&o)[4], const float (&rli)[16], const int r32, const int hi) {
  const int qi = r32 & 3; const unsigned sel = (unsigned)qi | ((unsigned)(4 + qi) << 8) | 0x0c0c0000u;
  unsigned char* base = Ow + qi * 32 + (r32 & ~3);
#pragma unroll
  for (int r = 0; r < 16; ++r) { const float sc = rli[r] * O8_SCALE;
    int w = 0; w = __builtin_amdgcn_cvt_pk_fp8_f32(clamp_f8(o[0][r] * sc), clamp_f8(o[1][r] * sc), w, false); w = __builtin_amdgcn_cvt_pk_fp8_f32(clamp_f8(o[2][r] * sc), clamp_f8(o[3][r] * sc), w, true);
    const unsigned p0 = (unsigned)__builtin_amdgcn_update_dpp(0, w, 0x00, 0xf, 0xf, false), p1 = (unsigned)__builtin_amdgcn_update_dpp(0, w, 0x55, 0xf, 0xf, false);
    const unsigned p2 = (unsigned)__builtin_amdgcn_update_dpp(0, w, 0xaa, 0xf, 0xf, false), p3 = (unsigned)__builtin_amdgcn_update_dpp(0, w, 0xff, 0xf, 0xf, false);
    const unsigned t01 = __builtin_amdgcn_perm(p1, p0, sel), t23 = __builtin_amdgcn_perm(p3, p2, sel);
    *reinterpret_cast<unsigned*>(base + (size_t)crow(r, hi) * DM) = t01 | (t23 << 16); }
}
template <int MODE, int SDEPTH> __device__ __forceinline__ void attn_unit(const AUnit& u, const bf16_t* __restrict__ P, bf16_t* __restrict__ O, float* __restrict__ OB, LAS char* lds) {
  int tid = threadIdx.x; asm volatile("" : "+v"(tid));
  const int wid = tid >> 6, lane = tid & 63, r32 = lane & 31, hi = lane >> 5;
  LAS char* V_lds = lds; LAS char* K_lds = lds + NBUF * SHM_V;
  LAS float* ws = (LAS float*)(lds + NBUF * SHM_V + NBUF * SHM_K) + wid * 64; LAS float* li_l = ws; LAS float* al_l = ws + 32;
  const LAS float* btab = (const LAS float*)(lds + BIAS_OFF);
  float m_reg = -1e30f, l_reg = 0; f32x16 o[4] = {}; bf16x8 qr[8];
  const bf16_t* Qw = P + (size_t)(u.qrow0 + wid * QBLK + r32) * LDP + u.qcol + hi * 8;
#pragma unroll
  for (int d0 = 0; d0 < 8; ++d0) qr[d0] = *reinterpret_cast<const bf16x8*>(Qw + d0 * 16);
  f32x16 acc0 = {};
  {
    constexpr float C = SCALE * 1.4426950408889634f;
#pragma unroll
    for (int d0 = 0; d0 < 8; ++d0) { const u32x4 w = __builtin_bit_cast(u32x4, qr[d0]); u32x4 o_;
      o_.x = cvtpk(bflo(w.x) * C, bfhi(w.x) * C); o_.y = cvtpk(bflo(w.y) * C, bfhi(w.y) * C); o_.z = cvtpk(bflo(w.z) * C, bfhi(w.z) * C); o_.w = cvtpk(bflo(w.w) * C, bfhi(w.w) * C);
      qr[d0] = __builtin_bit_cast(bf16x8, o_); } }
  const char* Kh = (const char*)(P + (size_t)u.kbase * LDP + u.kcol); const char* Vh = (const char*)(P + (size_t)u.kbase * LDP + u.vcol);
  const int wv = __builtin_amdgcn_readfirstlane(tid >> 6);
  const unsigned koff0 = (unsigned)((tid >> 4) * (LDP * 2)) + (unsigned)(((tid & 15) * 16) ^ (((tid >> 4) & 7) << 4));
  const int vs_ = tid >> 5, vkk = (vs_ >> 2) * 8 + ((tid & 31) >> 2), vk0 = (vkk & ~0xC) | ((vkk & 4) << 1) | ((vkk & 8) >> 1), vc0 = (vs_ & 3) * 32 + (tid & 3) * 8;
  const unsigned voff0 = (unsigned)(vk0 * (LDP * 2)) + (unsigned)(vc0 * 2);
  constexpr unsigned RS32 = 32u * LDP * 2u;
  const int vb0 = (int)(unsigned)(uintptr_t)V_lds + v_rd_base(lane);
#define KROW(j) ((j) < 4 ? (j) * 64 : u.seg2row + ((j) - 4) * 64)
#define GLDS(gp, lp) __builtin_amdgcn_global_load_lds((const unsigned*)(gp), (LAS unsigned*)(lp), 16, 0, 0)
#define DMA(slot, k0) do { const size_t _kb = (size_t)(k0) * (LDP * 2); LAS char* _kd = K_lds + (slot) * SHM_K + wv * 1024; LAS char* _vd = V_lds + (slot) * SHM_V + wv * 1024; \
    GLDS(Kh + _kb + koff0, _kd); GLDS(Kh + _kb + koff0 + RS32, _kd + 8192); GLDS(Vh + _kb + voff0, _vd); GLDS(Vh + _kb + voff0 + RS32, _vd + 8192); } while (0)
#define DWAIT() asm volatile("s_waitcnt vmcnt(0)" ::: "memory")
#define RESC(a) do { if (__any((a) < 1.f)) { if (hi == 0) al_l[r32] = (a); asm volatile("s_waitcnt lgkmcnt(0)" ::: "memory"); \
    _Pragma("unroll") for (int d = 0; d < 4; ++d) _Pragma("unroll") for (int r = 0; r < 16; ++r) o[d][r] *= al_l[crow(r, hi)]; } } while (0)
  f32x16 pA0, pA1, pB0, pB1; float mnA, mnB, alA, alB; bf16x8 pa0, pa1, pa2, pa3; const int NT = u.NT;
  int bp = 0, bc = 1, bn = 2;
  DMA(0, 0); DWAIT(); __syncthreads();
  qkt(pA0, pA1, K_lds, qr, r32, hi, acc0);
  { firstSM(pA0, pA1, m_reg); mnA = m_reg; alA = 1.f;
#pragma unroll
    for (int r = 0; r < 16; ++r) acc0[r] = -m_reg; }
  DMA(1, KROW(1)); DWAIT(); __syncthreads();
#define TILE_OK(j_) (MODE != 2 || (j_) < 4 || (u.pb + (j_) - 4 >= nb_rs && u.pb + (j_) - 4 < nb_rs + 8))
  const int nb_rs = min(max(u.pa + (wv >> 1) - 4, 0), 56);
  bool okA = true, okB = true;
  for (int j = 1; j + 1 < NT; j += 2) {
    DMA(bn, KROW(j + 1));
    okB = TILE_OK(j);
    SBAR(); if (okB) qkt(pB0, pB1, K_lds + bc * SHM_K, qr, r32, hi, acc0);
    if (okA) { finishSM(pA0, pA1, alA, l_reg, pa0, pa1, pa2, pa3); SBAR();
      pv_d0(o, vb0 + bp * (int)SHM_V, pa0, pa1, pa2, pa3); }
    if (okB) { mask_tile<MODE>(pB0, pB1, u, j, wid, r32, hi, btab); partialSM<true>(pB0, pB1, m_reg, mnB, alB); }
    DWAIT(); __syncthreads();
    bp = bc; bc = bn; bn = (bn == NBUF - 1) ? 0 : bn + 1;
    if (j + 2 < NT) DMA(bn, KROW(j + 2));
    okA = TILE_OK(j + 1);
    SBAR(); if (okA) qkt(pA0, pA1, K_lds + bc * SHM_K, qr, r32, hi, acc0);
    if (okB) { finishSM(pB0, pB1, alB, l_reg, pa0, pa1, pa2, pa3); SBAR();
      pv_d0(o, vb0 + bp * (int)SHM_V, pa0, pa1, pa2, pa3); }
    if (okA) { mask_tile<MODE>(pA0, pA1, u, j + 1, wid, r32, hi, btab); partialSM<true>(pA0, pA1, m_reg, mnA, alA); }
    DWAIT(); __syncthreads();
    bp = bc; bc = bn; bn = (bn == NBUF - 1) ? 0 : bn + 1;
  }
  okB = TILE_OK(NT - 1);
  SBAR(); if (okB) qkt(pB0, pB1, K_lds + bc * SHM_K, qr, r32, hi, acc0);
  if (okA) { finishSM(pA0, pA1, alA, l_reg, pa0, pa1, pa2, pa3); SBAR();
    pv_d0(o, vb0 + bp * (int)SHM_V, pa0, pa1, pa2, pa3); }
  if (okB) { mask_tile<MODE>(pB0, pB1, u, NT - 1, wid, r32, hi, btab); partialSM<true>(pB0, pB1, m_reg, mnB, alB);
    finishSM(pB0, pB1, alB, l_reg, pa0, pa1, pa2, pa3); SBAR();
    pv_d0(o, vb0 + bc * (int)SHM_V, pa0, pa1, pa2, pa3); }
#undef TILE_OK
  if (u.has_sink) l_reg += __builtin_amdgcn_exp2f(u.sink * 1.4426950408889634f - m_reg);
  if (hi == 0) li_l[r32] = l_reg; asm volatile("s_waitcnt lgkmcnt(0)" ::: "memory");
  float rli[16];
#pragma unroll
  for (int r = 0; r < 16; ++r) rli[r] = __builtin_amdgcn_rcpf(li_l[crow(r, hi)]);
  if (u.outf32) {
    float* Ow = OB + (size_t)(u.qrow0 + wid * QBLK) * DM + u.ocol;
#pragma unroll
    for (int r = 0; r < 16; ++r) { const int orow = crow(r, hi);
#pragma unroll
      for (int d0 = 0; d0 < 4; ++d0) Ow[(size_t)orow * DM + d0 * 32 + r32] = o[d0][r] * rli[r]; }
  } else {
    if constexpr (MODE == 2) {
      store_o8(reinterpret_cast<unsigned char*>(O) + (size_t)(u.qrow0 + wid * QBLK) * DM + u.ocol, o, rli, r32, hi);
    } else {
    bf16_t* Ow = O + (size_t)(u.qrow0 + wid * QBLK) * DM + u.ocol;
#pragma unroll
    for (int r = 0; r < 16; ++r) { const int orow = crow(r, hi);
#pragma unroll
      for (int d0 = 0; d0 < 4; ++d0) { const float v = o[d0][r] * rli[r]; Ow[(size_t)orow * DM + d0 * 32 + r32] = (bf16_t)(cvtpk(v, v) & 0xffffu); } }
    }
  }
  __syncthreads();
#undef KROW
#undef GLDS
#undef DMA
#undef DWAIT
#undef RESC
}
constexpr int SHM8 = 8192;
__device__ __forceinline__ void mfma8_32(f32x16& acc, const i32x8 a, const i32x8 b) { asm volatile("v_mfma_f32_32x32x64_f8f6f4 %0, %1, %2, %0" : "+v"(acc) : "v"(a), "v"(b)); }
__device__ __forceinline__ i32x8 cat8(const i32x4 a, const i32x4 b) { return __builtin_shufflevector(a, b, 0, 1, 2, 3, 4, 5, 6, 7); }
__device__ __forceinline__ int cvt4_f8(float a, float b, float c, float d) { int w = 0; w = __builtin_amdgcn_cvt_pk_fp8_f32(a, b, w, false); w = __builtin_amdgcn_cvt_pk_fp8_f32(c, d, w, true); return w; }
__device__ __forceinline__ void mfma8_32c(f32x16& d, const i32x8 a, const i32x8 b, const f32x16& c) { asm volatile("v_mfma_f32_32x32x64_f8f6f4 %0, %1, %2, %3" : "=&v"(d) : "v"(a), "v"(b), "v"(c)); }
__device__ __forceinline__ void kfrag8(i32x8 (&kf)[4], const LAS char* Ks, int r32, int hi) {
  const int x0 = r32 & 7; const LAS char* k0 = Ks + r32 * 128; const LAS char* k1 = k0 + 32 * 128;
#define KF8(kp, s) cat8(*reinterpret_cast<const LAS i32x4*>((kp) + (((4 * (s) + 2 * hi) ^ x0) << 4)), *reinterpret_cast<const LAS i32x4*>((kp) + (((4 * (s) + 2 * hi + 1) ^ x0) << 4)))
  kf[0] = KF8(k0, 0); kf[1] = KF8(k1, 0); kf[2] = KF8(k0, 1); kf[3] = KF8(k1, 1);
#undef KF8
}
__device__ __forceinline__ void qkmma8(f32x16& p0, f32x16& p1, const i32x8 (&kf)[4], const i32x8 (&q8)[2], const f32x16& init) {
  __builtin_amdgcn_s_setprio(1);
  mfma8_32c(p0, kf[0], q8[0], init); mfma8_32c(p1, kf[1], q8[0], init); mfma8_32(p0, kf[2], q8[1]); mfma8_32(p1, kf[3], q8[1]);
  __builtin_amdgcn_s_setprio(0);
}
__device__ __forceinline__ void qkt8(f32x16& p0, f32x16& p1, const LAS char* Ks, const i32x8 (&q8)[2], int r32, int hi, const f32x16& init) {
  i32x8 kf[4]; kfrag8(kf, Ks, r32, hi); qkmma8(p0, p1, kf, q8, init);
}
__device__ __forceinline__ void finishSM8(f32x16& p0, f32x16& p1, float& l_reg, i32x8& pf) {
#pragma unroll
  for (int r = 0; r < 16; ++r) p1[r] = __builtin_amdgcn_exp2f(p1[r]);
  float ps = 0;
#pragma unroll
  for (int r = 0; r < 16; ++r) ps += p0[r];
#pragma unroll
  for (int r = 0; r < 16; ++r) ps += p1[r];
  { auto rr = __builtin_amdgcn_permlane32_swap(__float_as_uint(ps), __float_as_uint(ps), false, false);
    ps = __uint_as_float(rr[0]) + __uint_as_float(rr[1]); }
  l_reg += ps;
#pragma unroll
  for (int i = 0; i < 4; ++i) { pf[i] = cvt4_f8(p0[4 * i], p0[4 * i + 1], p0[4 * i + 2], p0[4 * i + 3]); pf[4 + i] = cvt4_f8(p1[4 * i], p1[4 * i + 1], p1[4 * i + 2], p1[4 * i + 3]); }
}
__device__ __forceinline__ void vfrag8(i32x8 (&vf)[4], const LAS char* Vs, int r32, int hi) {
  const int xs = (r32 >> 1) & 3; const LAS char* vp = Vs + r32 * 64;
#pragma unroll
  for (int d0 = 0; d0 < 4; ++d0) vf[d0] = cat8(*reinterpret_cast<const LAS i32x4*>(vp + d0 * 2048 + (((2 * hi) ^ xs) << 4)), *reinterpret_cast<const LAS i32x4*>(vp + d0 * 2048 + (((2 * hi + 1) ^ xs) << 4)));
}
__device__ __forceinline__ void pvmma8(f32x16* o, const i32x8 (&vf)[4], const i32x8 pf) {
  __builtin_amdgcn_s_setprio(1);
#pragma unroll
  for (int d0 = 0; d0 < 4; ++d0) mfma8_32(o[d0], pf, vf[d0]);
  __builtin_amdgcn_s_setprio(0);
}
__device__ __forceinline__ void pv8(f32x16* o, const LAS char* Vs, const i32x8 pf, int r32, int hi) { i32x8 vf[4]; vfrag8(vf, Vs, r32, hi); pvmma8(o, vf, pf); }
template <int MODE> __device__ __forceinline__ void attn_unit_c8(const AUnit& u, const bf16_t* __restrict__ P, const unsigned char* __restrict__ Kh, const unsigned char* __restrict__ Vh, const float* __restrict__ qn, bf16_t* __restrict__ O, LAS char* lds) {
  int tid = threadIdx.x; asm volatile("" : "+v"(tid));
  const int wid = tid >> 6, lane = tid & 63, r32 = lane & 31, hi = lane >> 5;
  const int wv = __builtin_amdgcn_readfirstlane(tid >> 6);
  LAS char* V_lds = lds; LAS char* K_lds = lds + 6 * SHM8;
  LAS float* li_l = (LAS float*)(lds + 12 * SHM8) + wid * 64;
  float m_reg = -1e30f, l_reg = 0; f32x16 o[4] = {}; i32x8 q8[2];
  if constexpr (MODE != 0) {
    const bf16_t* Qw = P + (size_t)(u.qrow0 + wid * QBLK + r32) * LDP + u.qcol + hi * 32; constexpr float C = SCALE * 1.4426950408889634f;
#pragma unroll
    for (int s = 0; s < 2; ++s)
#pragma unroll
      for (int c = 0; c < 4; ++c) { const u32x4 w = *reinterpret_cast<const u32x4*>(Qw + s * 64 + c * 8);
        q8[s][2 * c] = cvt4_f8(bflo(w.x) * C, bfhi(w.x) * C, bflo(w.y) * C, bfhi(w.y) * C); q8[s][2 * c + 1] = cvt4_f8(bflo(w.z) * C, bfhi(w.z) * C, bflo(w.w) * C, bfhi(w.w) * C); }
  } else
  { const bf16_t* Qw = P + (size_t)(u.qrow0 + wid * QBLK + r32) * LDP + u.qcol + hi * 16; constexpr float C = SCALE * 1.4426950408889634f;
    float xa[2][16], xb[2][16]; float ss = 0.f;
#pragma unroll
    for (int s = 0; s < 2; ++s)
#pragma unroll
      for (int c = 0; c < 2; ++c) { const u32x4 wa = *reinterpret_cast<const u32x4*>(Qw + s * 64 + c * 8), wb = *reinterpret_cast<const u32x4*>(Qw + s * 64 + 32 + c * 8);
        xa[s][8 * c + 0] = bflo(wa.x); xa[s][8 * c + 1] = bfhi(wa.x); xa[s][8 * c + 2] = bflo(wa.y); xa[s][8 * c + 3] = bfhi(wa.y); xa[s][8 * c + 4] = bflo(wa.z); xa[s][8 * c + 5] = bfhi(wa.z); xa[s][8 * c + 6] = bflo(wa.w); xa[s][8 * c + 7] = bfhi(wa.w);
        xb[s][8 * c + 0] = bflo(wb.x); xb[s][8 * c + 1] = bfhi(wb.x); xb[s][8 * c + 2] = bflo(wb.y); xb[s][8 * c + 3] = bfhi(wb.y); xb[s][8 * c + 4] = bflo(wb.z); xb[s][8 * c + 5] = bfhi(wb.z); xb[s][8 * c + 6] = bflo(wb.w); xb[s][8 * c + 7] = bfhi(wb.w); }
#pragma unroll
    for (int s = 0; s < 2; ++s)
#pragma unroll
      for (int j = 0; j < 16; ++j) ss += xa[s][j] * xa[s][j] + xb[s][j] * xb[s][j];
    { auto rr = __builtin_amdgcn_permlane32_swap(__float_as_uint(ss), __float_as_uint(ss), false, false); ss = __uint_as_float(rr[0]) + __uint_as_float(rr[1]); }
    const float rq = rsqrtf(ss * (1.f / 128.f) + EPS) * C;
    const int pos = u.pa + wid * QBLK + r32;
#pragma unroll
    for (int s = 0; s < 2; ++s) { const float pp = (float)(s == 0 ? (pos >> 6) : (pos & 63));
#pragma unroll
      for (int j = 0; j < 16; ++j) { const float ga = qn[64 * s + 16 * hi + j], gb = qn[64 * s + 32 + 16 * hi + j];
        const float ang = pp * exp2f(-(float)(16 * hi + j) * (13.287712379549449f / 32.f)); const float cs_ = __cosf(ang), sn_ = __sinf(ang);
        const float a = xa[s][j] * rq * ga, b = xb[s][j] * rq * gb; xa[s][j] = a * cs_ - b * sn_; xb[s][j] = b * cs_ + a * sn_; }
#pragma unroll
      for (int i = 0; i < 4; ++i) { q8[s][i] = cvt4_f8(xa[s][4 * i], xa[s][4 * i + 1], xa[s][4 * i + 2], xa[s][4 * i + 3]); q8[s][4 + i] = cvt4_f8(xb[s][4 * i], xb[s][4 * i + 1], xb[s][4 * i + 2], xb[s][4 * i + 3]); } } }
  const unsigned koff = (unsigned)((tid >> 3) * 128 + (((tid & 7) ^ ((tid >> 3) & 7)) << 4));
  const unsigned voff = (unsigned)((tid >> 2) * 64 + (((tid & 3) ^ ((tid >> 3) & 3)) << 4));
#define GLDS(gp, lp) __builtin_amdgcn_global_load_lds((const unsigned*)(gp), (LAS unsigned*)(lp), 16, 0, 0)
  const int tb = MODE == 1 ? (u.seg2row >> 6) - 4 : 0;
#define DMA8(ss_, j_) do { _Pragma("unroll") for (int _h = 0; _h < 2; ++_h) { const int _j = (j_) + _h, _t = _j < 4 ? _j : _j + tb; \
    GLDS(Kh + (size_t)_t * 8192 + koff, K_lds + ((ss_) * 2 + _h) * SHM8 + wv * 1024); GLDS(Vh + (size_t)_t * 8192 + voff, V_lds + ((ss_) * 2 + _h) * SHM8 + wv * 1024); } } while (0)
#define MASK8(p0_, p1_, j_) do { if constexpr (MODE == 1) mask_tile<1>(p0_, p1_, u, (j_), wid, r32, hi, (const LAS float*)nullptr); } while (0)
#define DWAIT() asm volatile("s_waitcnt vmcnt(0)" ::: "memory")
#define EXP16(p_) do { _Pragma("unroll") for (int r = 0; r < 16; ++r) p_[r] = __builtin_amdgcn_exp2f(p_[r]); } while (0)
  f32x16 pA0, pA1, pB0, pB1, acc0 = {}; i32x8 pf; const int NT = u.NT;
  DMA8(0, 0); DMA8(1, 2); DWAIT(); __syncthreads();
  qkt8(pA0, pA1, K_lds, q8, r32, hi, acc0);
  asm volatile("s_nop 7\n\ts_nop 7\n\ts_nop 7\n\ts_nop 7\n\ts_nop 7\n\ts_nop 7" : "+v"(pA0), "+v"(pA1));
  firstSM(pA0, pA1, m_reg);
#pragma unroll
  for (int r = 0; r < 16; ++r) acc0[r] = -m_reg;
  int s0 = 0, s1 = 1, s2 = 2;
  for (int j = 1; j + 1 < NT; j += 2) {
    if (j + 3 < NT) DMA8(s2, j + 3);
    { i32x8 vf[4]; SBAR(); { i32x8 kf[4]; kfrag8(kf, K_lds + (s0 * 2 + 1) * SHM8, r32, hi); qkmma8(pB0, pB1, kf, q8, acc0); }
      vfrag8(vf, V_lds + (s0 * 2) * SHM8, r32, hi);
      finishSM8(pA0, pA1, l_reg, pf); SBAR();
      pvmma8(o, vf, pf); }
    MASK8(pB0, pB1, j); EXP16(pB0);
    { i32x8 vf[4]; SBAR(); { i32x8 kf[4]; kfrag8(kf, K_lds + (s1 * 2) * SHM8, r32, hi); qkmma8(pA0, pA1, kf, q8, acc0); }
      vfrag8(vf, V_lds + (s0 * 2 + 1) * SHM8, r32, hi);
      finishSM8(pB0, pB1, l_reg, pf); SBAR();
      pvmma8(o, vf, pf); }
    MASK8(pA0, pA1, j + 1); EXP16(pA0);
    DWAIT(); __syncthreads();
    { const int t_ = s0; s0 = s1; s1 = s2; s2 = t_; }
  }
  SBAR(); qkt8(pB0, pB1, K_lds + (s0 * 2 + 1) * SHM8, q8, r32, hi, acc0);
  finishSM8(pA0, pA1, l_reg, pf); SBAR();
  pv8(o, V_lds + (s0 * 2) * SHM8, pf, r32, hi);
  MASK8(pB0, pB1, NT - 1); EXP16(pB0);
  finishSM8(pB0, pB1, l_reg, pf); SBAR();
  pv8(o, V_lds + (s0 * 2 + 1) * SHM8, pf, r32, hi);
  asm volatile("s_nop 7\n\ts_nop 7\n\ts_nop 7\n\ts_nop 7\n\ts_nop 7\n\ts_nop 7" : "+v"(o[0]), "+v"(o[1]), "+v"(o[2]), "+v"(o[3]));
  if (MODE == 1 && u.has_sink) l_reg += __builtin_amdgcn_exp2f(u.sink * 1.4426950408889634f - m_reg);
  if (hi == 0) li_l[r32] = l_reg; asm volatile("s_waitcnt lgkmcnt(0)" ::: "memory");
  float rli[16];
#pragma unroll
  for (int r = 0; r < 16; ++r) rli[r] = __builtin_amdgcn_rcpf(li_l[crow(r, hi)]);
  if constexpr (MODE == 3) { bf16_t* Ow = O + (size_t)(u.qrow0 + wid * QBLK) * DM + u.ocol;
#pragma unroll
    for (int r = 0; r < 16; ++r) { const int orow = crow(r, hi);
#pragma unroll
      for (int d0 = 0; d0 < 4; ++d0) { const float v = o[d0][r] * rli[r]; Ow[(size_t)orow * DM + d0 * 32 + r32] = (bf16_t)(cvtpk(v, v) & 0xffffu); } }
  } else
  if constexpr (MODE == 1) { bf16_t* Ow = O + (size_t)(u.qrow0 + wid * QBLK) * DM + u.ocol;
#pragma unroll
    for (int r = 0; r < 16; ++r) { const int orow = crow(r, hi);
#pragma unroll
      for (int d0 = 0; d0 < 4; ++d0) { const float v = o[d0][r] * rli[r]; Ow[(size_t)orow * DM + d0 * 32 + r32] = (bf16_t)(cvtpk(v, v) & 0xffffu); } }
  } else
  store_o8(reinterpret_cast<unsigned char*>(O) + (size_t)(u.qrow0 + wid * QBLK) * DM + u.ocol, o, rli, r32, hi);
  __syncthreads();
#undef GLDS
#undef DMA8
#undef MASK8
#undef DWAIT
#undef EXP16
}
__device__ __forceinline__ void attn_unit_b(const AUnit& u, const bf16_t* __restrict__ P, float* __restrict__ OB, LAS char* lds) {
  int tid = threadIdx.x; asm volatile("" : "+v"(tid));
  const int lane = tid & 63, r32 = lane & 31, hi = lane >> 5;
  const int wv = __builtin_amdgcn_readfirstlane(tid >> 6), rg = wv & 3, kh = wv >> 2;
  LAS char* K_lds = lds; LAS char* V_lds = lds + 2 * SHM_K;
  LAS char* Pex = lds + 2 * SHM_K + 4 * SHM_V;
  LAS float* st = (LAS float*)(lds + 2 * SHM_K + 4 * SHM_V + 2 * 8 * 2048);
  f32x16 o[4] = {}; bf16x8 qr[8];
  { const bf16_t* Qw = P + (size_t)(u.qrow0 + rg * QBLK + r32) * LDP + u.qcol + hi * 8; constexpr float C = SCALE * 1.4426950408889634f;
#pragma unroll
    for (int d0 = 0; d0 < 8; ++d0) { const u32x4 w = __builtin_bit_cast(u32x4, *reinterpret_cast<const bf16x8*>(Qw + d0 * 16)); u32x4 o_;
      o_.x = cvtpk(bflo(w.x) * C, bfhi(w.x) * C); o_.y = cvtpk(bflo(w.y) * C, bfhi(w.y) * C); o_.z = cvtpk(bflo(w.z) * C, bfhi(w.z) * C); o_.w = cvtpk(bflo(w.w) * C, bfhi(w.w) * C);
      qr[d0] = __builtin_bit_cast(bf16x8, o_); } }
  const char* Kh = (const char*)(P + (size_t)u.kbase * LDP + u.kcol); const char* Vh = (const char*)(P + (size_t)u.kbase * LDP + u.vcol);
  const unsigned koff0 = (unsigned)((tid >> 4) * (LDP * 2)) + (unsigned)(((tid & 15) * 16) ^ (((tid >> 4) & 7) << 4));
  const int vs_ = tid >> 5, vkk = (vs_ >> 2) * 8 + ((tid & 31) >> 2), vk0 = (vkk & ~0xC) | ((vkk & 4) << 1) | ((vkk & 8) >> 1), vc0 = (vs_ & 3) * 32 + (tid & 3) * 8;
  const unsigned voff0 = (unsigned)(vk0 * (LDP * 2)) + (unsigned)(vc0 * 2);
  constexpr unsigned RS32 = 32u * LDP * 2u;
  const int vrd = (int)(unsigned)(uintptr_t)V_lds + kh * (int)SHM_V + v_rd_base(lane);
#define GLDS(gp, lp) __builtin_amdgcn_global_load_lds((const unsigned*)(gp), (LAS unsigned*)(lp), 16, 0, 0)
#define DMAK(slot, k0) do { const size_t _kb = (size_t)(k0) * (LDP * 2); LAS char* _kd = K_lds + (slot) * SHM_K + wv * 1024; GLDS(Kh + _kb + koff0, _kd); GLDS(Kh + _kb + koff0 + RS32, _kd + 8192); } while (0)
#define DMAV(slot, k0) do { const size_t _kb = (size_t)(k0) * (LDP * 2); LAS char* _vd = V_lds + (slot) * (2 * SHM_V) + wv * 1024; \
    GLDS(Vh + _kb + voff0, _vd); GLDS(Vh + _kb + voff0 + RS32, _vd + 8192); GLDS(Vh + _kb + voff0 + 256, _vd + SHM_V); GLDS(Vh + _kb + voff0 + RS32 + 256, _vd + SHM_V + 8192); } while (0)
#define DWAIT() asm volatile("s_waitcnt vmcnt(0)" ::: "memory")
#define LWAIT() asm volatile("s_waitcnt lgkmcnt(0)" ::: "memory")
#define QKH(s_, ks, init_) do { f32x16 _s1 = {}; s_ = init_; const LAS char* _K = K_lds + (ks) * SHM_K; bf16x8 _kf[8]; \
    _Pragma("unroll") for (int d0 = 0; d0 < 8; ++d0) _kf[d0] = *reinterpret_cast<const LAS bf16x8*>(_K + KSWZ(kh * 32 + r32, (d0 * 16 + hi * 8) * 2)); \
    _Pragma("unroll") for (int d0 = 0; d0 < 8; d0 += 2) { s_ = __builtin_amdgcn_mfma_f32_32x32x16_bf16(_kf[d0], qr[d0], s_, 0, 0, 0); _s1 = __builtin_amdgcn_mfma_f32_32x32x16_bf16(_kf[d0 + 1], qr[d0 + 1], _s1, 0, 0, 0); } \
    _Pragma("unroll") for (int r = 0; r < 16; ++r) s_[r] += _s1[r]; } while (0)
#define PK4(Pv, BASE, OUT) do { unsigned a0 = cvtpk(Pv[BASE + 0], Pv[BASE + 1]), a1 = cvtpk(Pv[BASE + 2], Pv[BASE + 3]);   \
    unsigned b0 = cvtpk(Pv[BASE + 4], Pv[BASE + 5]), b1 = cvtpk(Pv[BASE + 6], Pv[BASE + 7]);                              \
    auto r0 = __builtin_amdgcn_permlane32_swap(a0, b0, false, false); auto r1 = __builtin_amdgcn_permlane32_swap(a1, b1, false, false); \
    u32x4 w = {r0[0], r1[0], r0[1], r1[1]}; OUT = *reinterpret_cast<bf16x8*>(&w); } while (0)
#define SOFT_PUB(s_, f0_, f1_, par) do { _Pragma("unroll") for (int r = 0; r < 16; ++r) { s_[r] = __builtin_amdgcn_exp2f(s_[r]); lsum += s_[r]; } \
    PK4(s_, 0, f0_); PK4(s_, 8, f1_); LAS char* _px = Pex + (par) * 16384 + wv * 2048 + lane * 16; *(LAS bf16x8*)_px = f0_; *(LAS bf16x8*)(_px + 1024) = f1_; } while (0)
  const int NT = u.NT; float lsum = 0.f; bf16x8 own0, own1; f32x16 sc, acc0 = {};
  DMAK(0, 0); DMAV(0, 0); DMAK(1, 64); DWAIT(); __syncthreads();
  QKH(sc, 0, acc0);
  { float pmax = sc[0];
#pragma unroll
    for (int r = 1; r < 16; ++r) pmax = fmaxf(pmax, sc[r]);
    { auto rr = __builtin_amdgcn_permlane32_swap(__float_as_uint(pmax), __float_as_uint(pmax), false, false); pmax = fmaxf(__uint_as_float(rr[0]), __uint_as_float(rr[1])); }
    if (hi == 0) st[wv * 64 + r32] = pmax; LWAIT(); __syncthreads();
    const float mref = fmaxf(pmax, st[(wv ^ 4) * 64 + r32]); LWAIT();
#pragma unroll
    for (int r = 0; r < 16; ++r) { acc0[r] = -mref; sc[r] -= mref; } }
  SOFT_PUB(sc, own0, own1, 0);
  LWAIT(); __syncthreads();
  for (int j = 0; j < NT; ++j) {
    if (j + 2 < NT) DMAK(j & 1, (j + 2) * 64);
    if (j + 1 < NT) DMAV((j + 1) & 1, (j + 1) * 64);
    const LAS char* _pq = Pex + (j & 1) * 16384 + (wv ^ 4) * 2048 + lane * 16;
    const bf16x8 q0 = *(const LAS bf16x8*)_pq, q1 = *(const LAS bf16x8*)(_pq + 1024);
    const bf16x8 pa0 = kh ? q0 : own0, pa1 = kh ? q1 : own1, pa2 = kh ? own0 : q0, pa3 = kh ? own1 : q1;
    pv_d0(o, vrd + (j & 1) * (2 * (int)SHM_V), pa0, pa1, pa2, pa3);
    if (j + 1 < NT) { QKH(sc, (j + 1) & 1, acc0); SOFT_PUB(sc, own0, own1, (j + 1) & 1); }
    LWAIT(); DWAIT(); __syncthreads();
  }
  { auto rr = __builtin_amdgcn_permlane32_swap(__float_as_uint(lsum), __float_as_uint(lsum), false, false); lsum = __uint_as_float(rr[0]) + __uint_as_float(rr[1]); }
  if (hi == 0) st[wv * 64 + r32] = lsum; LWAIT(); __syncthreads();
  float rli[16];
#pragma unroll
  for (int r = 0; r < 16; ++r) rli[r] = __builtin_amdgcn_rcpf(st[wv * 64 + crow(r, hi)] + st[(wv ^ 4) * 64 + crow(r, hi)]);
  float* Ow = OB + (size_t)(u.qrow0 + rg * QBLK) * DM + u.ocol + kh * 128;
#pragma unroll
  for (int r = 0; r < 16; ++r) { const int orow = crow(r, hi);
#pragma unroll
    for (int d0 = 0; d0 < 4; ++d0) Ow[(size_t)orow * DM + d0 * 32 + r32] = o[d0][r] * rli[r]; }
  LWAIT(); __syncthreads();
#undef GLDS
#undef DMAK
#undef DMAV
#undef DWAIT
#undef LWAIT
#undef QKH
#undef PK4
#undef SOFT_PUB
}
}

struct Ctx {
    LAS unsigned char* lds; int tid, lane, wave, G, bid, gw, NGW;
    float* mod; float* affl; float* affc; int* rows; float* gate; int* slot; float* xc; float* sax; float* sah; float* sas; float* wsc; float* shd; signed char* hid8; float* so; signed char* o8; bf16_t* dlt;
    bf16_t *win, *wout, *wgu, *wdn, *r1, *r2, *hid, *y; float* ob; unsigned char* y8; unsigned char* k8; unsigned char* v8; unsigned char* k8d; unsigned char* v8d;
};

__device__ __forceinline__ Ctx make_ctx(const Params& p, LAS unsigned char* lds) {
    Ctx F; int tid = threadIdx.x; asm volatile("" : "+v"(tid));
    unsigned long long wsb = (unsigned long long)p.ws; asm volatile("" : "+s"(wsb)); __attribute__((address_space(1))) unsigned char* ws = (__attribute__((address_space(1))) unsigned char*)wsb;
    int bid = blockIdx.x; asm volatile("" : "+s"(bid));
    F.lds = lds; F.tid = tid; F.lane = tid & 63; F.wave = __builtin_amdgcn_readfirstlane(tid >> 6);
    F.G = gridDim.x; F.bid = bid; F.gw = bid * NWAVES + F.wave; F.NGW = F.G * NWAVES;
    F.mod = (float*)(ws + WS_MOD); F.affl = (float*)(ws + WS_AFFL); F.affc = (float*)(ws + WS_AFFC); F.rows = (int*)(ws + WS_ROWS); F.gate = (float*)(ws + WS_GATE);
    F.slot = (int*)(ws + WS_SLOT); F.xc = (float*)(ws + WS_XC); F.sax = (float*)(ws + WS_SAX); F.sah = (float*)(ws + WS_SAH); F.sas = (float*)(ws + WS_SAS); F.wsc = (float*)(ws + WS_WSC); F.shd = (float*)(ws + WS_SHD); F.hid8 = (signed char*)(ws + WS_R2 + 204 * MiB); F.so = (float*)(ws + WS_SO); F.o8 = (signed char*)(ws + WS_R3); F.dlt = (bf16_t*)(ws + WS_DLT);
    F.win = (bf16_t*)(ws + WS_WIN); F.wout = (bf16_t*)(ws + WS_WOUT); F.wgu = (bf16_t*)(ws + WS_WGU); F.wdn = (bf16_t*)(ws + WS_WDN);
    F.r1 = (bf16_t*)(ws + WS_R1); F.r2 = (bf16_t*)(ws + WS_R2); F.hid = (bf16_t*)(ws + WS_R2); F.y = (bf16_t*)(ws + WS_R3); F.y8 = (unsigned char*)(ws + WS_R3); F.k8 = (unsigned char*)(ws + WS_K8); F.v8 = (unsigned char*)(ws + WS_V8); F.k8d = (unsigned char*)(ws + WS_K8D); F.v8d = (unsigned char*)(ws + WS_V8D); F.ob = (float*)(ws + WS_R3);
    return F;
}
__device__ __forceinline__ void transpose_item_i8(const float* __restrict__ src, int K, int N, signed char* __restrict__ dst, int rs, int roff, LAS float* scr, int idx, int lane, const float inv, const bool f8 = false) {
    const int nblk = N >> 6, kb = idx / nblk, nb = idx - kb * nblk, k0 = kb * 64, n0 = nb * 64;
    const int kr = lane >> 4, nc = (lane & 15) * 4;
    const float* s = src + (size_t)(k0 + kr) * N + n0 + nc;
    f32x4 v[16];
#pragma unroll
    for (int i = 0; i < 16; ++i) v[i] = __builtin_nontemporal_load((const f32x4*)(s + (size_t)(4 * i) * N));
#pragma unroll
    for (int i = 0; i < 16; ++i) { LAS float* q = scr + (kr + 4 * i) * 65 + nc; q[0] = v[i].x; q[1] = v[i].y; q[2] = v[i].z; q[3] = v[i].w; }
    LDS_WAIT();
    const int c = lane & 3;
#pragma unroll
    for (int j = 0; j < 4; ++j) { const int n = (lane >> 2) + 16 * j; const LAS float* q = scr + (16 * c) * 65 + n;
        u32x4 o; o.x = pack_q4(q[0], q[65], q[130], q[195], inv, f8); o.y = pack_q4(q[260], q[325], q[390], q[455], inv, f8);
        o.z = pack_q4(q[520], q[585], q[650], q[715], inv, f8); o.w = pack_q4(q[780], q[845], q[910], q[975], inv, f8);
        const int ng = n0 + n; int row;
        if (rs > 0) row = (ng >> 2) * rs + roff + (ng & 3);
        else { const bool roped = ng < 1280 || (ng >= 1536 && ng < 3584); const int d = ng & 127;
            row = roped ? (ng & ~127) + (d & 64) + ((d & 31) >> 2) * 8 + ((d >> 5) & 1) * 4 + (d & 3) : ng; }
        *(u32x4*)(dst + (size_t)row * K + k0 + 16 * c) = o; }
    LDS_WAIT();
}
#ifndef CV_INTERLEAVE
#define CV_INTERLEAVE 1
#endif
constexpr int CV_IN = 32 * 72, CV_OUT = 32 * 32, CV_E = 768, CV_PER_L = CV_IN + CV_OUT + 3 * NEXP * CV_E, CV_TOTAL = 2 * CV_PER_L, CV_FIRST = CV_INTERLEAVE ? CV_IN : CV_TOTAL;
__device__ __forceinline__ void conv_item(const Params& p, const Ctx& F, LAS float* scr, const int it, const int lane) {
    const int l = it / CV_PER_L; int r = it - l * CV_PER_L;
    if (r < CV_IN) { transpose_item_i8(p.w_in + (size_t)l * DM * INW, DM, INW, (signed char*)F.win + (size_t)l * INW * DM, l == 0 ? -1 : 4, 0, scr, r, lane, 1.f / F.wsc[l]); return; } r -= CV_IN;
    if (r < CV_OUT) { transpose_item_i8(p.w_out + (size_t)l * DM * DM, DM, DM, (signed char*)F.wout + (size_t)l * DM * DM, 4, 0, scr, r, lane, 1.f / F.wsc[98 + l], l == 1); return; } r -= CV_OUT;
    const int ty = r / (NEXP * CV_E), e = (r % (NEXP * CV_E)) / CV_E, idx = r % CV_E; const size_t le = (size_t)l * NEXP + e;
    if (ty == 0) transpose_item_i8(p.w_gate + le * DM * DEXP, DM, DEXP, (signed char*)F.wgu + le * 3072 * DM, 8, 0, scr, idx, lane, 1.f / F.wsc[2 + 2 * le]);
    else if (ty == 1) transpose_item_i8(p.w_up + le * DM * DEXP, DM, DEXP, (signed char*)F.wgu + le * 3072 * DM, 8, 4, scr, idx, lane, 1.f / F.wsc[3 + 2 * le]);
    else transpose_item_i8(p.w_down + le * DEXP * DM, DEXP, DM, (signed char*)F.wdn + le * DM * DEXP, 4, 0, scr, idx, lane, 1.f / F.wsc[66 + le], true);
}

__device__ __forceinline__ void conv_some(const Params& p, const Ctx& F, int& cv_it, const int k) {
    int t2 = threadIdx.x; asm volatile("" : "+v"(t2));
    const int lane = t2 & 63, wave = __builtin_amdgcn_readfirstlane(t2 >> 6);
    LAS float* scr = (LAS float*)(F.lds + wave * 16640);
    for (int q = 0; q < k && cv_it < CV_TOTAL; ++q, cv_it += F.NGW) conv_item(p, F, scr, cv_it, lane);
}

__device__ __forceinline__ void phase_prologue(const Params& p, const Ctx& F) {
    for (int item = F.bid; item < 192; item += F.G) {
        LAS float* sl = (LAS float*)F.lds; LAS float* red = (LAS float*)(F.lds + 73728);
        for (int i = F.tid; i < 9 * DM; i += NTHR) { const int r = i >> 11, d = i & 2047; const float v = r < 8 ? p.c[r * DM + d] : p.c_ctx[d]; sl[i] = silu_f(v); }
        __syncthreads();
        const int l = item / 96, cb = item % 96;
        const float* W = p.w_ada + ((size_t)l * DM + F.wave * 256) * MODW + cb * 128 + 2 * F.lane;
        float a0[9], a1[9];
#pragma unroll
        for (int r = 0; r < 9; ++r) { a0[r] = 0.f; a1[r] = 0.f; }
#pragma unroll 8
        for (int d = 0; d < 256; ++d) { const f32x2 w = *(const f32x2*)(W + (size_t)d * MODW);
#pragma unroll
            for (int r = 0; r < 9; ++r) { const float s = sl[r * DM + F.wave * 256 + d]; a0[r] += s * w.x; a1[r] += s * w.y; } }
#pragma unroll
        for (int r = 0; r < 9; ++r) { red[(F.wave * 9 + r) * 128 + 2 * F.lane] = a0[r]; red[(F.wave * 9 + r) * 128 + 2 * F.lane + 1] = a1[r]; }
        __syncthreads();
        for (int i = F.tid; i < 9 * 128; i += NTHR) { const int r = i >> 7, cc = i & 127; float s = p.b_ada[l * MODW + cb * 128 + cc];
#pragma unroll
            for (int w = 0; w < 8; ++w) s += red[(w * 9 + r) * 128 + cc];
            F.mod[(size_t)(l * 9 + r) * MODW + cb * 128 + cc] = s; }
        __syncthreads();
    }
    for (int m = F.bid; m < 100; m += F.G) {
        LAS float* red = (LAS float*)F.lds;
        const float* W; int N;
        if (m < 2) { W = p.w_in + (size_t)m * DM * INW; N = INW; }
        else if (m >= 98) { W = p.w_out + (size_t)(m - 98) * DM * DM; N = DM; }
        else if (m >= 66) { W = p.w_down + (size_t)(m - 66) * DEXP * DM; N = DM; }
        else { const int le = (m - 2) >> 1; W = ((m & 1) ? p.w_up : p.w_gate) + (size_t)le * DM * DEXP; N = DEXP; }
        float ss = 0.f;
        for (int i = F.tid; i < 8 * N; i += NTHR) { const float v = W[i]; ss += v * v; }
        ss = wave_sum(ss);
        if (F.lane == 0) red[F.wave] = ss;
        __syncthreads();
        if (F.tid == 0) { float t = 0.f;
#pragma unroll
            for (int w = 0; w < 8; ++w) t += red[w];
            F.wsc[m] = fmaxf(6.0f * sqrtf(t / (float)(8 * N)) * (1.f / 127.f), 1e-30f); }
        __syncthreads();
    }
}

__device__ __forceinline__ void row_ptrs(const Params& p, const Ctx& F, const int l, const int b, const int t, const float*& xs, float*& xd) {
    const unsigned long long blat = (l <= 1) ? (unsigned long long)p.x : (unsigned long long)p.out, bctx = (l <= 1) ? (unsigned long long)p.ctx : (unsigned long long)F.xc;
    const bool isctx = t < CTXL;
    const size_t roff = isctx ? ((size_t)b * CTXL + t) * DM : ((size_t)b * SEQ + (t - CTXL)) * DM;
    xs = (const float*)(isctx ? bctx : blat) + roff;
    xd = (isctx ? F.xc : p.out) + roff;
}
__device__ __forceinline__ void gather_y1(const Ctx& F, const int s, f32x4 (&acc)[8]) {
#pragma unroll
    for (int j = 0; j < 8; ++j) acc[j] = (f32x4){0.f, 0.f, 0.f, 0.f};
#pragma unroll 2
    for (int e = 0; e < 16; ++e) { const int se = __builtin_amdgcn_readlane(s, e);
        if (se >= 0) { const unsigned char* yr = F.y8 + (size_t)se * DM + 4 * F.lane;
#pragma unroll
            for (int j = 0; j < 8; ++j) { const unsigned w = __builtin_nontemporal_load((const unsigned*)(yr + 256 * j)); acc[j] += unpack_f8x4(w); } } }
}
__device__ __forceinline__ void gather_y(const Ctx& F, const int s, f32x4 (&acc)[8]) {
#pragma unroll
    for (int j = 0; j < 8; ++j) acc[j] = (f32x4){0.f, 0.f, 0.f, 0.f};
    unsigned m = (unsigned)__ballot(s >= 0) & 0xffffu;
    while (m) {
        const int e0 = __builtin_ctz(m); m &= m - 1;
        const bool two = m != 0; const int e1 = two ? __builtin_ctz(m) : e0; if (two) m &= m - 1;
        const int s0 = __builtin_amdgcn_readlane(s, e0), s1 = __builtin_amdgcn_readlane(s, e1);
        const unsigned char* y0 = F.y8 + (size_t)s0 * DM + 4 * F.lane; const unsigned char* y1 = F.y8 + (size_t)s1 * DM + 4 * F.lane;
        unsigned w0[8], w1[8];
#pragma unroll
        for (int j = 0; j < 8; ++j) w0[j] = __builtin_nontemporal_load((const unsigned*)(y0 + 256 * j));
#pragma unroll
        for (int j = 0; j < 8; ++j) w1[j] = __builtin_nontemporal_load((const unsigned*)(y1 + 256 * j));
        const float k1 = two ? 1.f : 0.f;
#pragma unroll
        for (int j = 0; j < 8; ++j) { acc[j] += unpack_f8x4(w0[j]); acc[j] += unpack_f8x4(w1[j]) * k1; }
    }
}
__device__ __forceinline__ void phase_norm1(const Params& p, const Ctx& F, const int l) {
    const bool fin = (l == 2), comb = (l > 0);
    if (l == 0) { LAS float* scr = (LAS float*)(F.lds + F.wave * 16640); for (int it = F.gw; it < CV_FIRST; it += F.NGW) conv_item(p, F, scr, it, F.lane); }
    const int b = F.gw & 7, tstride = F.NGW >> 3;
    int cur_m = -1; f32x4 A[8], Bv[8];
    int t = F.gw >> 3; if (fin) { while (t < CTXL) t += tstride; }
    f32x4 vn[8], accn[8]; u32x2 dn[8]; int sn = -1;
#pragma unroll
    for (int j = 0; j < 8; ++j) dn[j] = (u32x2){0u, 0u};
#pragma unroll
    for (int j = 0; j < 8; ++j) accn[j] = (f32x4){0.f, 0.f, 0.f, 0.f};
    if (t < TPB) { const float* xs; float* xd; row_ptrs(p, F, l, b, t, xs, xd);
#pragma unroll
        for (int j = 0; j < 8; ++j) vn[j] = __builtin_nontemporal_load((const f32x4*)xs + F.lane + 64 * j);
        if (comb) {
#pragma unroll
            for (int j = 0; j < 8; ++j) dn[j] = __builtin_nontemporal_load((const u32x2*)(F.dlt + ((size_t)b * TPB + t) * DM + 4 * F.lane + 256 * j)); }
        if (comb) { int s0 = -1; if (F.lane < 16) s0 = F.slot[(unsigned)((b * 16 + F.lane) * TPB + t)]; { if (fin) gather_y1(F, s0, accn); else gather_y(F, s0, accn); }
            if (t + tstride < TPB && F.lane < 16) sn = F.slot[(unsigned)((b * 16 + F.lane) * TPB + t + tstride)]; } }
    for (; t < TPB; t += tstride) {
        const bool isctx = t < CTXL;
        const int mrow = isctx ? 8 : b;
        const float* xs; float* xd; row_ptrs(p, F, l, b, t, xs, xd);
        f32x4 v[8];
#pragma unroll
        for (int j = 0; j < 8; ++j) v[j] = vn[j] + (f32x4){bflo(dn[j].x), bfhi(dn[j].x), bflo(dn[j].y), bfhi(dn[j].y)};
        if (comb) {
            const float* gt = F.mod + (size_t)((l - 1) * 9 + mrow) * MODW + 5 * DM;
#pragma unroll
            for (int j = 0; j < 8; ++j) { v[j] += *((const f32x4*)gt + F.lane + 64 * j) * accn[j] * (1.f / Y_SCALE); if (!fin) *((f32x4*)xd + F.lane + 64 * j) = v[j]; }
        }
        { const int t2 = t + tstride;
          if (t2 < TPB) { const float* xs2; float* xd2; row_ptrs(p, F, l, b, t2, xs2, xd2);
#pragma unroll
            for (int j = 0; j < 8; ++j) vn[j] = __builtin_nontemporal_load((const f32x4*)xs2 + F.lane + 64 * j);
            if (comb) {
#pragma unroll
                for (int j = 0; j < 8; ++j) dn[j] = __builtin_nontemporal_load((const u32x2*)(F.dlt + ((size_t)b * TPB + t2) * DM + 4 * F.lane + 256 * j)); }
            if (comb) { { if (fin) gather_y1(F, sn, accn); else gather_y(F, sn, accn); } const int t3 = t2 + tstride; sn = -1; if (t3 < TPB && F.lane < 16) sn = F.slot[(unsigned)((b * 16 + F.lane) * TPB + t3)]; } } }
        if (mrow != cur_m) { cur_m = mrow;
            if (!fin) {
                const float* mr = F.mod + (size_t)(l * 9 + mrow) * MODW;
#pragma unroll
                for (int j = 0; j < 8; ++j) { const f32x4 g = *((const f32x4*)(p.g_mix + l * DM) + F.lane + 64 * j), sc = *((const f32x4*)(mr + DM) + F.lane + 64 * j);
                    A[j] = g * (sc + 1.f); Bv[j] = *((const f32x4*)mr + F.lane + 64 * j); }
            }
        }
        float ss = 0.f;
#pragma unroll
        for (int j = 0; j < 8; ++j) ss += (v[j].x * v[j].x + v[j].y * v[j].y) + (v[j].z * v[j].z + v[j].w * v[j].w);
        const float rstd = rsqrtf(wave_sum(ss) * (1.f / DM) + EPS);
        if (fin) {
#pragma unroll
            for (int j = 0; j < 8; ++j) __builtin_nontemporal_store(v[j] * rstd * *((const f32x4*)p.g_final + F.lane + 64 * j), (f32x4*)xd + F.lane + 64 * j);
        } else {
            float am = 0.f;
#pragma unroll
            for (int j = 0; j < 8; ++j) { v[j] = v[j] * rstd * A[j] + Bv[j]; am = fmaxf(am, amax4(v[j])); }
            am = fmaxf(wave_max(am), 1e-20f); const float inv = 127.f / am;
            unsigned* xn = (unsigned*)((signed char*)F.r1 + ((size_t)b * TPB + t) * DM) + F.lane;
#pragma unroll
            for (int j = 0; j < 8; ++j) __builtin_nontemporal_store(pack_i8x4(v[j].x, v[j].y, v[j].z, v[j].w, inv), xn + 64 * j);
            if (F.lane == 0) F.sax[b * TPB + t] = am * (1.f / 127.f);
        }
    }
}

__device__ __forceinline__ void v8_tiles_n(const Ctx& F, const int col0, const int nh, unsigned char* dstb) {
        for (int it = F.gw; it < NB * nh * 68; it += F.NGW) {
            const int tile = it % 68, bk = it / 68, kvh = bk % nh, b = bk / nh;
            const bf16_t* srcv = F.r2 + (size_t)(b * TPB + tile * 64) * INW + col0 + kvh * 128 + 2 * F.lane;
            unsigned w[64];
#pragma unroll
            for (int kk = 0; kk < 64; ++kk) w[kk] = *(const unsigned*)(srcv + (size_t)kk * INW);
            unsigned char* dst = dstb + (size_t)it * 8192 + F.lane * 128;
#pragma unroll
            for (int half = 0; half < 2; ++half)
#pragma unroll
                for (int q = 0; q < 4; ++q) { u32x4 o;
#pragma unroll
                    for (int a = 0; a < 4; ++a) { const int s0 = 16 * q + 4 * a, hi_ = s0 >> 5, j = s0 & 31, key = 32 * (j >> 4) + 8 * ((j >> 2) & 3) + 4 * hi_;
                        float f[4];
#pragma unroll
                        for (int i = 0; i < 4; ++i) f[i] = half ? bfhi(w[key + i]) : bflo(w[key + i]);
                        o[a] = pack_f8x4(f[0], f[1], f[2], f[3], 1.f); }
                    *(u32x4*)(dst + half * 64 + q * 16) = o; }
        }
}
__device__ __forceinline__ void v8_tiles(const Ctx& F) { v8_tiles_n(F, 1280, 2, F.v8); }
__device__ __forceinline__ void phase_qkfix(const Params& p, const Ctx& F, const int l) {
    LAS f32x2* cs = (LAS f32x2*)F.lds;
    for (int i = F.tid; i < 2048; i += NTHR) { const int pp = i >> 5, fi = i & 31; const float inv = exp2f(-(float)fi * (13.287712379549449f / 32.f)); const float ang = (float)pp * inv;
        cs[i] = (f32x2){__cosf(ang), __sinf(ang)}; }
    __syncthreads();
    const int NV = l == 0 ? 26 : 2, nrows = l == 0 ? NB * SEQ : NROWS;
    const long total = (long)nrows * NV;
    const int sub = F.lane >> 4, jl = F.lane & 15, ax = jl >> 3, f0 = (jl & 7) * 4;
    for (long V0 = (long)F.gw * 4; V0 < total; V0 += (long)F.NGW * 4) {
        const long V = V0 + sub; const bool valid = V < total; const long Vc = valid ? V : 0;
        const int rr = (int)(Vc / NV), v = (int)(Vc % NV);
        int R, pos; bool lat;
        if (l == 0) { const int b = rr >> 12, s = rr & 4095; R = b * TPB + CTXL + s; pos = s; lat = true; }
        else { R = rr; const int t = rr % TPB; lat = t >= CTXL; pos = t - CTXL; }
        const int col = l == 0 ? v * 128 + (v >= 10 ? 256 : 0) : (8 + v) * 128;
        bf16_t* ptr = F.r2 + (size_t)R * INW + col + ax * 64 + f0;
        const u32x2 wl = *(const u32x2*)ptr, wh = *(const u32x2*)(ptr + 32);
        float xl[4] = {bflo(wl.x), bfhi(wl.x), bflo(wl.y), bfhi(wl.y)}, xh[4] = {bflo(wh.x), bfhi(wh.x), bflo(wh.y), bfhi(wh.y)};
        if (l == 1) {
            float ss = 0.f;
#pragma unroll
            for (int q = 0; q < 4; ++q) ss += xl[q] * xl[q] + xh[q] * xh[q];
            ss += __shfl_xor(ss, 1); ss += __shfl_xor(ss, 2); ss += __shfl_xor(ss, 4); ss += __shfl_xor(ss, 8);
            const float rstd = rsqrtf(ss * (1.f / 128.f) + EPS);
            const float* g = p.kn + ax * 64 + f0;
#pragma unroll
            for (int q = 0; q < 4; ++q) { xl[q] = xl[q] * rstd * g[q]; xh[q] = xh[q] * rstd * g[32 + q]; }
        }
        if (lat) {
            const int pp = ax == 0 ? (pos >> 6) : (pos & 63);
#pragma unroll
            for (int q = 0; q < 4; ++q) { const f32x2 c = cs[pp * 32 + f0 + q]; const float a = xl[q], bq = xh[q]; xl[q] = a * c.x - bq * c.y; xh[q] = bq * c.x + a * c.y; }
        }
        if (valid) {
            if (l == 0) { u32x2 o; o.x = cvtpk(xl[0], xl[1]); o.y = cvtpk(xl[2], xl[3]); *(u32x2*)ptr = o; o.x = cvtpk(xh[0], xh[1]); o.y = cvtpk(xh[2], xh[3]); *(u32x2*)(ptr + 32) = o; }
            else { unsigned char* k8 = F.k8 + ((size_t)v * NROWS + R) * 128 + ax * 64 + (f0 >> 4) * 32 + (f0 & 15);
                *(unsigned*)k8 = pack_f8x4(xl[0], xl[1], xl[2], xl[3], 1.f); *(unsigned*)(k8 + 16) = pack_f8x4(xh[0], xh[1], xh[2], xh[3], 1.f); } }
    }
}

__device__ __forceinline__ void bfinal_tile(const Params& p, const Ctx& F, const int qrow0, const int h) {
    int t2 = threadIdx.x; asm volatile("" : "+v"(t2));
    const int lane = t2 & 63, wave = __builtin_amdgcn_readfirstlane(t2 >> 6);
    const float lam_init = 0.2f;
    float s1 = p.lq1[lane] * p.lk1[lane] + p.lq1[lane + 64] * p.lk1[lane + 64], s2 = p.lq2[lane] * p.lk2[lane] + p.lq2[lane + 64] * p.lk2[lane + 64];
    s1 = wave_sum(s1); s2 = wave_sum(s2);
    const float lam = expf(s1) - expf(s2) + lam_init;
    const int sub = lane >> 4, jl = lane & 15;
    f32x4 g[4];
#pragma unroll
    for (int q = 0; q < 4; ++q) g[q] = *(const f32x4*)(p.subln + jl * 4 + 64 * q) * (1.f - lam_init);
#pragma unroll
    for (int hb = 0; hb < 2; ++hb) {
        u32x2 a_[4][4], c_[4][4];
#pragma unroll
        for (int i4 = 0; i4 < 4; ++i4) { const int R = qrow0 + wave * 32 + (hb * 4 + i4) * 4 + sub;
            const bf16_t* o1 = (const bf16_t*)F.ob + (size_t)R * DM + h * 512 + jl * 4; const bf16_t* o2 = o1 + 256;
#pragma unroll
            for (int q = 0; q < 4; ++q) { a_[i4][q] = *(const u32x2*)(o1 + 64 * q); c_[i4][q] = *(const u32x2*)(o2 + 64 * q); } }
#pragma unroll
        for (int i4 = 0; i4 < 4; ++i4) { const int R = qrow0 + wave * 32 + (hb * 4 + i4) * 4 + sub;
            f32x4 v[4]; float ss = 0.f;
#pragma unroll
            for (int q = 0; q < 4; ++q) { const u32x2 a1 = a_[i4][q], c1 = c_[i4][q];
                v[q] = (f32x4){bflo(a1.x), bfhi(a1.x), bflo(a1.y), bfhi(a1.y)} - lam * (f32x4){bflo(c1.x), bfhi(c1.x), bflo(c1.y), bfhi(c1.y)}; ss += (v[q].x * v[q].x + v[q].y * v[q].y) + (v[q].z * v[q].z + v[q].w * v[q].w); }
            ss += __shfl_xor(ss, 1); ss += __shfl_xor(ss, 2); ss += __shfl_xor(ss, 4); ss += __shfl_xor(ss, 8);
            const float rstd = rsqrtf(ss * (1.f / 256.f) + EPS);
            bf16_t* o = F.r1 + (size_t)R * DM + 1024 + h * 256 + jl * 4;
#pragma unroll
            for (int q = 0; q < 4; ++q) { const f32x4 y = v[q] * rstd * g[q]; u32x2 w; w.x = cvtpk(y.x, y.y); w.y = cvtpk(y.z, y.w); *(u32x2*)(o + 64 * q) = w; } }
    }
}

__device__ __forceinline__ void phase_attn(const Params& p, const Ctx& F, const int l) {
    LAS char* lds = (LAS char*)F.lds;
    if (l == 1) { LAS float* bt = (LAS float*)(lds + att::BIAS_OFF);
        for (int i = F.tid; i < 8 * 480; i += NTHR) { const int h = i / 480, rem = i % 480, ro = rem >> 5, cc = rem & 31; bt[i] = cc < 31 ? p.rpb[(h * 15 + ro) * 31 + cc] * 1.4426950408889634f : 0.f; }
        __syncthreads(); }
    const int vcu = (F.G % 8 == 0) ? (F.bid % 8) * (F.G / 8) + F.bid / 8 : F.bid;
    constexpr int CV_PER_UNIT = 3;
    int cv_it = CV_FIRST + F.gw, cv_slot = 0;
    unsigned* a8cnt = (unsigned*)(p.ws + WS_CTL) + 8192;
    if (l == 1) {
        phase_qkfix(p, F, 1);
        asm volatile("s_waitcnt vmcnt(0)" ::: "memory"); __syncthreads();
        if (F.tid == 0) { __builtin_amdgcn_fence(__ATOMIC_RELEASE, "agent"); __hip_atomic_fetch_add(a8cnt, 1u, __ATOMIC_RELAXED, __HIP_MEMORY_SCOPE_AGENT); } }
    {
    if (l == 0) {
        for (int su = vcu; su < 544; su += F.G) {
            const bool lat = su < 512; int b, h, qt;
            if (lat) { qt = su & 15; h = (su >> 4) & 3; b = su >> 6; } else { const int uu = su - 512; qt = 0; h = uu & 3; b = uu >> 2; }
            const int qrow0 = b * TPB + (lat ? CTXL + qt * 256 : 0);
            for (int sp = 0; sp < 4; ++sp) {
                att::AUnit u; u.mode = 0; u.pa = 0; u.pb = 0; u.head = 0; u.has_sink = 0; u.sink = 0.f; u.seg2row = CTXL; u.kbase = b * TPB; u.outf32 = 1;
                if (false) {
                    const int mp = 0, rh = sp & 1;
                    u.qrow0 = qrow0 + rh * 128; u.qcol = 1536 + h * 256 + mp * 128; u.kcol = 2560 + h * 256 + mp * 128; u.vcol = 3584 + h * 256; u.NT = 68; u.ocol = h * 512 + mp * 256;
                    att::attn_unit_b(u, F.r2, F.ob, lds);
                } else if (lat) {
                    const int vh = sp & 1, mp = sp >> 1;
                    u.qrow0 = qrow0; u.qcol = 1536 + h * 256 + mp * 128; u.NT = 68; u.ocol = h * 512 + mp * 256 + vh * 128;
                    att::attn_unit_c8<3>(u, F.r2, F.k8d + ((size_t)(h * 2 + mp) * NROWS + u.kbase) * 128, F.v8d + (size_t)(b * 8 + h * 2 + vh) * (68 * 8192), nullptr, (bf16_t*)F.ob, lds);
                } else {
                    const int mp = sp >> 1, vh = sp & 1;
                    u.qrow0 = qrow0; u.qcol = 1536 + h * 256 + mp * 128; u.NT = 4; u.ocol = h * 512 + mp * 256 + vh * 128;
                    att::attn_unit_c8<3>(u, F.r2, F.k8d + ((size_t)(h * 2 + mp) * NROWS + u.kbase) * 128, F.v8d + (size_t)(b * 8 + h * 2 + vh) * (68 * 8192), nullptr, (bf16_t*)F.ob, lds);
                }
                if (((cv_slot++ ^ vcu) & 1) == 0) { conv_some(p, F, cv_it, 2 * CV_PER_UNIT + 1); __syncthreads(); }
            }
            VM_WAIT(); __syncthreads();
            bfinal_tile(p, F, qrow0, h);
        }
        for (int ui = vcu; ui < 64; ui += F.G) {
            att::AUnit u; u.mode = 0; u.pa = 0; u.pb = 0; u.head = 0; u.outf32 = 0; u.seg2row = CTXL;
            const int h = ui & 7, b = ui >> 3;
            u.qrow0 = b * TPB; u.kbase = b * TPB;
            u.qcol = h * 128; u.kcol = 1024 + (h >> 2) * 128; u.vcol = 1280 + (h >> 2) * 128; u.ocol = h * 128;
            u.has_sink = 1; u.sink = p.a_sink[h]; u.NT = 4;
            att::attn_unit_c8<1>(u, F.r2, F.k8 + ((size_t)(h >> 2) * NROWS + u.kbase) * 128, F.v8 + (size_t)(b * 2 + (h >> 2)) * (68 * 8192), nullptr, F.r1, lds);
        }
    } else {
    for (int ui = vcu; ui < 1024; ui += F.G) {
        att::AUnit u; u.mode = 2; u.has_sink = 0; u.sink = 0.f; u.outf32 = 0;
        const int qt = ui & 15, h = (ui >> 4) & 7, b = ui >> 7;
        u.qrow0 = b * TPB + CTXL + qt * 256; u.kbase = b * TPB;
        u.qcol = 1536 + h * 128; u.kcol = 2560 + h * 128; u.vcol = 3584 + h * 128; u.ocol = 1024 + h * 128; u.head = h;
        const int r0 = qt * 4; int lo = min(max(r0 - 4, 0), 56), hi2 = min(max(r0 - 1, 0), 56) + 7; if (((hi2 - lo + 1) & 1) != 0) { if (hi2 < 63) ++hi2; else --lo; }
        u.NT = 4 + (hi2 - lo + 1); u.seg2row = CTXL + lo * 64; u.pa = r0; u.pb = lo;
        att::attn_unit<2, 1>(u, F.r2, (bf16_t*)F.o8, F.ob, lds);
    }
        if (F.tid == 0) { unsigned spn = 0; while (__hip_atomic_load(a8cnt, __ATOMIC_RELAXED, __HIP_MEMORY_SCOPE_AGENT) < (unsigned)F.G) { __builtin_amdgcn_s_sleep(2); if (++spn > (1u << 24)) break; }
            __builtin_amdgcn_fence(__ATOMIC_ACQUIRE, "agent"); }
        __syncthreads();
        for (int ui = vcu; ui < 1024; ui += F.G) {
            att::AUnit u; u.mode = 0; u.pa = 0; u.pb = 0; u.head = 0; u.has_sink = 0; u.sink = 0.f; u.outf32 = 0; u.seg2row = CTXL; u.NT = 68;
            const int qt = ui & 15, h = (ui >> 4) & 7, b = ui >> 7;
            u.qrow0 = b * TPB + CTXL + qt * 256; u.kbase = b * TPB;
            u.qcol = h * 128; u.kcol = 1024 + (h >> 2) * 128; u.vcol = 1280 + (h >> 2) * 128; u.ocol = h * 128;
            u.pa = qt * 256;
            att::attn_unit_c8<0>(u, F.r2, F.k8 + ((size_t)(h >> 2) * NROWS + u.kbase) * 128, F.v8 + (size_t)(b * 2 + (h >> 2)) * (68 * 8192), p.qn, (bf16_t*)F.o8, lds);
        }
    } }
    if (l == 0) {
    for (int ui = vcu; ui < 1024; ui += F.G) {
        att::AUnit u; u.mode = 1; u.head = 0; u.outf32 = 0;
        const int qt = ui & 15, h = (ui >> 4) & 7, b = ui >> 7;
        u.qrow0 = b * TPB + CTXL + qt * 256; u.kbase = b * TPB;
        u.qcol = h * 128; u.kcol = 1024 + (h >> 2) * 128; u.vcol = 1280 + (h >> 2) * 128; u.ocol = h * 128;
        u.has_sink = 1; u.sink = p.a_sink[h];
        const int s0 = qt * 256, lo = max(0, s0 - 128), hi2 = min(SEQ, s0 + 384); u.NT = 4 + (hi2 - lo) / 64; u.seg2row = CTXL + lo; u.pa = s0; u.pb = lo;
        att::attn_unit_c8<1>(u, F.r2, F.k8 + ((size_t)(h >> 2) * NROWS + u.kbase) * 128, F.v8 + (size_t)(b * 2 + (h >> 2)) * (68 * 8192), nullptr, F.r1, lds);
        if (((cv_slot++ ^ vcu) & 1) == 0) { conv_some(p, F, cv_it, 2 * CV_PER_UNIT + 1); __syncthreads(); }
    }
    conv_some(p, F, cv_it, 1 << 20);
    __syncthreads(); }
}

__device__ __forceinline__ void router_tail(const Ctx& F, const float (&lg)[16], const int b, const int t, const bool valid) {
    const bool b5 = (F.lane & 32) != 0, b4 = (F.lane & 16) != 0, b3 = (F.lane & 8) != 0, b2 = (F.lane & 4) != 0;
    float r8[8], r4[4], r2[2];
#pragma unroll
    for (int e = 0; e < 8; ++e) { const float keep = b5 ? lg[e + 8] : lg[e], send = b5 ? lg[e] : lg[e + 8]; r8[e] = keep + __shfl_xor(send, 32); }
#pragma unroll
    for (int e = 0; e < 4; ++e) { const float keep = b4 ? r8[e + 4] : r8[e], send = b4 ? r8[e] : r8[e + 4]; r4[e] = keep + __shfl_xor(send, 16); }
#pragma unroll
    for (int e = 0; e < 2; ++e) { const float keep = b3 ? r4[e + 2] : r4[e], send = b3 ? r4[e] : r4[e + 2]; r2[e] = keep + __shfl_xor(send, 8); }
    float lgt; { const float keep = b2 ? r2[1] : r2[0], send = b2 ? r2[0] : r2[1]; lgt = keep + __shfl_xor(send, 4); }
    lgt += __shfl_xor(lgt, 2); lgt += __shfl_xor(lgt, 1);
    float mx = lgt;
    mx = fmaxf(mx, __shfl_xor(mx, 4)); mx = fmaxf(mx, __shfl_xor(mx, 8)); mx = fmaxf(mx, __shfl_xor(mx, 16)); mx = fmaxf(mx, __shfl_xor(mx, 32));
    const float ex = expf(lgt - mx); float sum = ex;
    sum += __shfl_xor(sum, 4); sum += __shfl_xor(sum, 8); sum += __shfl_xor(sum, 16); sum += __shfl_xor(sum, 32);
    if (valid && (F.lane & 3) == 0) { const float af = ex / sum; const int e = F.lane >> 2;
        if (t < CTXL) F.affc[((size_t)(b * 16 + e)) * CTXL + t] = af; else F.affl[((size_t)(b * 16 + e)) * SEQ + (t - CTXL)] = af; }
}
__device__ __forceinline__ void phase_norm2(const Params& p, const Ctx& F, const int l) {
    LAS float* wr = (LAS float*)F.lds;
    for (int i = F.tid; i < DM * NEXP; i += NTHR) { const int d = i >> 4, e = i & 15; wr[e * DM + d] = p.w_router[(size_t)l * DM * NEXP + i]; }
    __syncthreads();
    const int b = F.gw & 7, tstride = F.NGW >> 3;
    int cur_m = -1; f32x4 A[8], Bv[8];
    int t = F.gw >> 3; if (l == 1) { while (t < CTXL) t += tstride; }
    while (t < TPB) {
        const bool isctx = t < CTXL;
        const int mrow = isctx ? 8 : b;
        const int tB = t + tstride;
        const bool two = !isctx && tB < TPB;
        f32x2 vv[8][4];
        { const float* xlat = l == 0 ? p.x : p.out; const float* xctx = l == 0 ? p.ctx : F.xc;
          const float* xs0 = isctx ? xctx + ((size_t)b * CTXL + t) * DM : xlat + ((size_t)b * SEQ + (t - CTXL)) * DM;
          const float* xs1 = two ? xlat + ((size_t)b * SEQ + (tB - CTXL)) * DM : xs0;
          const bf16_t* d0p = F.dlt + ((size_t)b * TPB + t) * DM + 4 * F.lane; const bf16_t* d1p = F.dlt + ((size_t)b * TPB + (two ? tB : t)) * DM + 4 * F.lane;
#pragma unroll
          for (int j = 0; j < 8; ++j) { f32x4 x0 = __builtin_nontemporal_load((const f32x4*)xs0 + F.lane + 64 * j), x1 = __builtin_nontemporal_load((const f32x4*)xs1 + F.lane + 64 * j);
              const u32x2 e0 = __builtin_nontemporal_load((const u32x2*)(d0p + 256 * j)), e1 = __builtin_nontemporal_load((const u32x2*)(d1p + 256 * j));
              x0 += (f32x4){bflo(e0.x), bfhi(e0.x), bflo(e0.y), bfhi(e0.y)}; x1 += (f32x4){bflo(e1.x), bfhi(e1.x), bflo(e1.y), bfhi(e1.y)};
#pragma unroll
              for (int c = 0; c < 4; ++c) vv[j][c] = (f32x2){x0[c], x1[c]}; } }
        if (mrow != cur_m) { cur_m = mrow; const float* mr = F.mod + (size_t)(l * 9 + mrow) * MODW;
#pragma unroll
            for (int j = 0; j < 8; ++j) { const f32x4 g = *((const f32x4*)(p.g_ffn + l * DM) + F.lane + 64 * j), sc = *((const f32x4*)(mr + 4 * DM) + F.lane + 64 * j);
                A[j] = g * (sc + 1.f); Bv[j] = *((const f32x4*)(mr + 3 * DM) + F.lane + 64 * j); } }
        f32x2 ss = {0.f, 0.f};
#pragma unroll
        for (int j = 0; j < 8; ++j)
#pragma unroll
            for (int c = 0; c < 4; ++c) ss += vv[j][c] * vv[j][c];
        const f32x2 rstd = {rsqrtf(wave_sum(ss.x) * (1.f / DM) + EPS), rsqrtf(wave_sum(ss.y) * (1.f / DM) + EPS)};
        f32x2 am = {0.f, 0.f};
#pragma unroll
        for (int j = 0; j < 8; ++j)
#pragma unroll
            for (int c = 0; c < 4; ++c) { vv[j][c] = vv[j][c] * rstd * A[j][c] + Bv[j][c]; am = __builtin_elementwise_max(am, __builtin_elementwise_abs(vv[j][c])); }
        const float am0 = fmaxf(wave_max(am.x), 1e-20f), am1 = fmaxf(wave_max(am.y), 1e-20f), inv0 = 127.f / am0, inv1 = 127.f / am1;
        unsigned* hn0 = (unsigned*)((signed char*)F.r1 + ((size_t)b * TPB + t) * DM) + F.lane;
        unsigned* hn1 = (unsigned*)((signed char*)F.r1 + ((size_t)b * TPB + (two ? tB : t)) * DM) + F.lane;
#pragma unroll
        for (int j = 0; j < 8; ++j) { __builtin_nontemporal_store(pack_i8x4(vv[j][0].x, vv[j][1].x, vv[j][2].x, vv[j][3].x, inv0), hn0 + 64 * j);
            if (two) __builtin_nontemporal_store(pack_i8x4(vv[j][0].y, vv[j][1].y, vv[j][2].y, vv[j][3].y, inv1), hn1 + 64 * j); }
        if (F.lane == 0) { F.sah[b * TPB + t] = am0 * (1.f / 127.f); if (two) F.sah[b * TPB + tB] = am1 * (1.f / 127.f); }
        f32x2 lg[16];
        unsigned wro = (unsigned)(uintptr_t)wr; asm volatile("" : "+v"(wro));
        const LAS float* wr2 = (const LAS float*)(uintptr_t)wro;
#pragma unroll
        for (int e = 0; e < 16; ++e) { f32x2 a = {0.f, 0.f};
#pragma unroll
            for (int j = 0; j < 8; ++j) { const f32x4 w = *((const LAS f32x4*)(wr2 + e * DM) + F.lane + 64 * j);
#pragma unroll
                for (int c = 0; c < 4; ++c) a += vv[j][c] * w[c]; }
            lg[e] = a; }
        float lg0[16], lg1[16];
#pragma unroll
        for (int e = 0; e < 16; ++e) { lg0[e] = lg[e].x; lg1[e] = lg[e].y; }
        router_tail(F, lg0, b, t, true);
        router_tail(F, lg1, b, tB, two);
        t += two ? 2 * tstride : tstride;
    }
}

__device__ __forceinline__ void phase_oq(const Params& p, const Ctx& F, const int l) {
    for (int R = F.gw; R < NROWS; R += F.NGW) {
        if (l == 1 && (R % TPB) < CTXL) continue;
        const bf16_t* src = F.r1 + (size_t)R * DM + 8 * F.lane;
        u32x4 w[4];
#pragma unroll
        for (int j = 0; j < 4; ++j) w[j] = __builtin_nontemporal_load((const u32x4*)(src + 512 * j));
        float v[4][8], am = 0.f;
#pragma unroll
        for (int j = 0; j < 4; ++j) { v[j][0] = bflo(w[j].x); v[j][1] = bfhi(w[j].x); v[j][2] = bflo(w[j].y); v[j][3] = bfhi(w[j].y); v[j][4] = bflo(w[j].z); v[j][5] = bfhi(w[j].z); v[j][6] = bflo(w[j].w); v[j][7] = bfhi(w[j].w);
#pragma unroll
            for (int q = 0; q < 8; ++q) am = fmaxf(am, fabsf(v[j][q])); }
        am = fmaxf(wave_max(am), 1e-20f); const float inv = 127.f / am;
        signed char* dst = F.o8 + (size_t)R * DM + 8 * F.lane;
#pragma unroll
        for (int j = 0; j < 4; ++j) { u32x2 o; o.x = pack_i8x4(v[j][0], v[j][1], v[j][2], v[j][3], inv); o.y = pack_i8x4(v[j][4], v[j][5], v[j][6], v[j][7], inv); *(u32x2*)(dst + 512 * j) = o; }
        if (F.lane == 0) F.so[R] = am * (1.f / 127.f);
    }
}

__device__ __forceinline__ void phase_hidq(const Params& p, const Ctx& F, const int l) {
    const int nrows = 16 * (l == 0 ? 4352 : 4096);
    for (int R = F.gw; R < nrows; R += F.NGW) {
        const bf16_t* src = F.hid + (size_t)R * DEXP + 8 * F.lane;
        u32x4 w[3]; float v[3][8]; float am = 0.f;
#pragma unroll
        for (int j = 0; j < 3; ++j) w[j] = __builtin_nontemporal_load((const u32x4*)(src + 512 * j));
#pragma unroll
        for (int j = 0; j < 3; ++j) { v[j][0] = bflo(w[j].x); v[j][1] = bfhi(w[j].x); v[j][2] = bflo(w[j].y); v[j][3] = bfhi(w[j].y); v[j][4] = bflo(w[j].z); v[j][5] = bfhi(w[j].z); v[j][6] = bflo(w[j].w); v[j][7] = bfhi(w[j].w);
#pragma unroll
            for (int q = 0; q < 8; ++q) am = fmaxf(am, fabsf(v[j][q])); }
        am = fmaxf(wave_max(am), 1e-20f); const float inv = 127.f / am;
        signed char* dst = F.hid8 + (size_t)R * DEXP + 8 * F.lane;
#pragma unroll
        for (int j = 0; j < 3; ++j) { u32x2 o; o.x = pack_i8x4(v[j][0], v[j][1], v[j][2], v[j][3], inv); o.y = pack_i8x4(v[j][4], v[j][5], v[j][6], v[j][7], inv); *(u32x2*)(dst + 512 * j) = o; }
        if (F.lane == 0) F.shd[R] = am * (1.f / 127.f);
    }
}

__device__ __forceinline__ void phase_topk(const Params& p, const Ctx& F, const int l) {
    LAS unsigned* cnt = (LAS unsigned*)F.lds;
    const int nunits = l == 0 ? 256 : 128, mexp = l == 0 ? 4352 : 4096;
    for (int ui = F.bid; ui < nunits; ui += F.G) {
        const bool lat = ui < 128; const int uu = ui & 127, b = uu >> 4, e = uu & 15;
        const int ntok = lat ? SEQ : CTXL, cap = lat ? 512 : 32;
        const float* aff = lat ? F.affl + (size_t)(b * 16 + e) * SEQ : F.affc + (size_t)(b * 16 + e) * CTXL;
        const int rowbase = l == 0 ? (lat ? 256 + b * 512 : b * 32) : b * 512;
        if (F.tid < 64) cnt[F.tid] = 0u;
        unsigned key[8];
#pragma unroll
        for (int i = 0; i < 8; ++i) { const int n = i * NTHR + F.tid; key[i] = n < ntok ? __float_as_uint(aff[n]) : 0u; }
        __syncthreads();
        unsigned prefix = 0u;
        for (int bit = 30; bit >= 0; --bit) {
            const unsigned cand = prefix | (1u << bit); unsigned c = 0u;
#pragma unroll
            for (int i = 0; i < 8; ++i) c += (unsigned)__popcll(__ballot(key[i] >= cand));
            if (F.lane == 0) __hip_atomic_fetch_add(&cnt[bit], c, __ATOMIC_RELAXED, __HIP_MEMORY_SCOPE_WORKGROUP);
            __syncthreads();
            if (cnt[bit] >= (unsigned)cap) prefix = cand;
        }
#pragma unroll
        for (int i = 0; i < 8; ++i) { const int n = i * NTHR + F.tid;
            if (n < ntok) { int slot = -1;
                if (key[i] > prefix) slot = (int)__hip_atomic_fetch_add(&cnt[32], 1u, __ATOMIC_RELAXED, __HIP_MEMORY_SCOPE_WORKGROUP);
                key[i] = (key[i] > prefix) ? (0x80000000u | (unsigned)slot) : (key[i] == prefix ? 0x40000000u : 0u); } else key[i] = 0u; }
        __syncthreads();
        const unsigned cgt = cnt[32];
#pragma unroll
        for (int i = 0; i < 8; ++i) { const int n = i * NTHR + F.tid;
            if (n < ntok) { int slot = -1;
                if (key[i] & 0x80000000u) slot = (int)(key[i] & 0xffffu);
                else if (key[i] & 0x40000000u) { const unsigned s2 = cgt + __hip_atomic_fetch_add(&cnt[33], 1u, __ATOMIC_RELAXED, __HIP_MEMORY_SCOPE_WORKGROUP); if (s2 < (unsigned)cap) slot = (int)s2; }
                const int t = lat ? CTXL + n : n;
                int yrow = -1;
                if (slot >= 0) { const int rr = rowbase + slot; yrow = e * mexp + rr; F.rows[e * MEXP_MAX + rr] = b * TPB + t; F.gate[e * mexp + rr] = aff[n]; F.sas[e * mexp + rr] = F.sah[b * TPB + t]; }
                F.slot[((size_t)(b * 16 + e)) * TPB + t] = yrow; } }
        __syncthreads();
    }
}

__global__ void __launch_bounds__(NTHR, 2) fwd_kernel(Params p) {
    extern __shared__ __attribute__((aligned(16))) unsigned char lds_raw[];
    unsigned char* ws = p.ws;
    LAS unsigned char* const lds0 = (LAS unsigned char*)lds_raw;
    volatile LAS unsigned* lctl = (volatile LAS unsigned*)(lds0 + LCTL_OFF);
    if (threadIdx.x < 128) lctl[threadIdx.x] = 0u;
    __syncthreads();
#if MK_MULTI
#define GRID_BAR() do { } while (0)
#else
    XcdBarrier bar = xcd_barrier_post((unsigned*)(ws + WS_CTL) + 4096, lctl + 8);
#define GRID_BAR() xcd_barrier(bar)
#endif
    const int lo = p.ph_lo, hi = p.ph_hi;
#define IN(k) (lo <= (k) && (k) < hi)
#define SEAM(k) do { if (IN((k) + 1)) GRID_BAR(); } while (0)
#ifndef PHMASK
#define PHMASK 0xfff
#endif
#define EN(s) (((PHMASK) >> (s)) & 1)
#ifndef REP_PRO
#define REP_PRO 1
#endif
#ifndef REP_HEAVY
#define REP_HEAVY 1
#endif
#ifndef REP_THIN
#define REP_THIN 1
#endif
#ifndef REP_ATT
#define REP_ATT 1
#endif

    if (EN(0) && IN(0)) { for (int rep = 0; rep < REP_PRO; ++rep) { const Ctx F = make_ctx(p, lds0); phase_prologue(p, F); __syncthreads(); } SEAM(0); }

    for (int l = 0; l < 2; ++l) {
        const int pb = 1 + l * 11;
        const int mexp = l == 0 ? 4352 : 4096;
        if (EN(1) && IN(pb + 0)) { for (int rep = 0; rep < (l == 0 ? REP_THIN : 1); ++rep) { const Ctx F = make_ctx(p, lds0); phase_norm1(p, F, l); } SEAM(pb + 0); }
        if (EN(2) && IN(pb + 1)) {
            const Ctx F = make_ctx(p, lds0);
            pg8::DenseOrder S{NROWS / 256, INW / 256, F.G, F.bid, 0, (const char*)F.r1, (const char*)F.win + (size_t)l * INW * DM, (size_t)256 * DM};
            pg8::EpiP E{(unsigned char*)F.k8 - WS_K8, l == 0 ? 1 : 0, F.wsc[l]};
            for (int rep = 0; rep < REP_HEAVY; ++rep) pg8::gemm_phase<pg8::EpiP, pg8::DenseOrder, false, true>(F.tid, F.lds, nullptr, DM, S, E);
            SEAM(pb + 1);
        }
        if (EN(4) && IN(pb + 3)) { for (int rep = 0; rep < REP_ATT; ++rep) { const Ctx F = make_ctx(p, lds0); phase_attn(p, F, l); } SEAM(pb + 3); }
        if (EN(6) && IN(pb + 4) && l == 0) { const Ctx F = make_ctx(p, lds0); phase_oq(p, F, l); SEAM(pb + 4); }
        if (EN(6) && IN(pb + 5)) {
            const Ctx F = make_ctx(p, lds0);
            pg8::DenseOrder S{l == 0 ? NROWS / 256 : NB * 16, DM / 256, F.G, F.bid, l, (const char*)F.o8, (const char*)F.wout + (size_t)l * DM * DM, (size_t)256 * DM};
            if (l == 0) { pg8::EpiDelta E{F.dlt, F.mod + (size_t)l * 9 * MODW, F.so, F.wsc[98 + l]};
                pg8::gemm_phase<pg8::EpiDelta, pg8::DenseOrder, false, true>(F.tid, F.lds, nullptr, DM, S, E); }
            else { pg8::EpiDelta E{F.dlt, F.mod + (size_t)l * 9 * MODW, nullptr, F.wsc[98 + l] * (1.f / O8_SCALE)};
                pg8::gemm_phase<pg8::EpiDelta, pg8::DenseOrder, false, true, true>(F.tid, F.lds, nullptr, DM, S, E); }
            SEAM(pb + 5);
        }
        if (EN(7) && IN(pb + 6)) { for (int rep = 0; rep < REP_THIN; ++rep) { const Ctx F = make_ctx(p, lds0); phase_norm2(p, F, l); __syncthreads(); } SEAM(pb + 6); }
        if (EN(8) && IN(pb + 7)) { for (int rep = 0; rep < REP_THIN; ++rep) { const Ctx F = make_ctx(p, lds0); phase_topk(p, F, l); } SEAM(pb + 7); }
        if (EN(9) && IN(pb + 8)) {
            const Ctx F = make_ctx(p, lds0);
            pg8::MoeOrder S{mexp / 256, 3072 / 256, F.G, F.bid, (const char*)F.r1, 0, (const char*)F.wgu + (size_t)l * NEXP * 3072 * DM, (size_t)3072 * DM, (size_t)256 * DM};
            LAS unsigned* tab = (LAS unsigned*)(F.lds + TAB_OFF);
            { unsigned rv[14];
#pragma unroll
              for (int i = 0; i < 14; ++i) { pg8::Unit u; rv[i] = 0u; if (S.next(i, u) && F.tid < 256) rv[i] = (unsigned)F.rows[u.e * MEXP_MAX + u.pm * 256 + F.tid]; }
#pragma unroll
              for (int i = 0; i < 14; ++i) if (F.tid < 256) tab[i * 256 + F.tid] = rv[i] * (unsigned)DM; }
            __syncthreads();
            pg8::EpiSwiglu E{(unsigned char*)F.hid8, mexp, F.sas, F.wsc + 2 + 32 * l};
            for (int rep = 0; rep < REP_HEAVY; ++rep) pg8::gemm_phase<pg8::EpiSwiglu, pg8::MoeOrder, true, true>(F.tid, F.lds, tab, DM, S, E);
            SEAM(pb + 8);
        }
        if (EN(10) && IN(pb + 10)) {
            const Ctx F = make_ctx(p, lds0);
            pg8::MoeOrder S{mexp / 256, DM / 256, F.G, F.bid, (const char*)F.hid8, (size_t)mexp * DEXP, (const char*)F.wdn + (size_t)l * NEXP * DM * DEXP, (size_t)DM * DEXP, (size_t)256 * DEXP};
            pg8::EpiDown E{F.y8, F.gate, mexp, F.wsc + 66 + 16 * l};
            pg8::gemm_phase<pg8::EpiDown, pg8::MoeOrder, false, true, true>(F.tid, F.lds, nullptr, DEXP, S, E);
            SEAM(pb + 10);
        }
    }
    if (EN(11) && IN(23)) { const Ctx F = make_ctx(p, lds0); phase_norm1(p, F, 2); }
#undef IN
#undef SEAM
}

extern "C" void kernel_launch(void* const* d_in, const int* in_sizes, int n_in, void* d_out, int out_size, void* d_ws, size_t ws_size, hipStream_t stream) {
    static int grid = 0;
    if (grid == 0) {
        if (n_in != 24 || out_size != NB * SEQ * DM || ws_size < WS_END) { fprintf(stderr, "kernel_launch: unexpected shapes: n_in %d out %d ws %zu (need %zu)\n", n_in, out_size, ws_size, (size_t)WS_END); grid = -1; return; }
        int dev = 0, cus = 0, per_cu = 0;
        if (hipGetDevice(&dev) != hipSuccess || hipDeviceGetAttribute(&cus, hipDeviceAttributeMultiprocessorCount, dev) != hipSuccess) { fprintf(stderr, "kernel_launch: device query failed\n"); grid = -1; return; }
        if (hipFuncSetAttribute((const void*)fwd_kernel, hipFuncAttributeMaxDynamicSharedMemorySize, LDS_BYTES) != hipSuccess) { fprintf(stderr, "kernel_launch: hipFuncSetAttribute failed\n"); grid = -1; return; }
        if (hipOccupancyMaxActiveBlocksPerMultiprocessor(&per_cu, (const void*)fwd_kernel, NTHR, LDS_BYTES) != hipSuccess || per_cu < 1) fprintf(stderr, "kernel_launch: note: occupancy query reports %d\n", per_cu);
        (void)hipGetLastError();
        grid = cus;
    }
    if (grid < 0) return;
    if (hipMemsetAsync((char*)d_ws + WS_CTL, 0, CTL_ZERO_BYTES, stream) != hipSuccess) { fprintf(stderr, "kernel_launch: memset failed\n"); return; }
    Params p{};
    const float** pp = (const float**)&p;
    for (int i = 0; i < 24; ++i) pp[i] = (const float*)d_in[i];
    p.out = (float*)d_out; p.ws = (unsigned char*)d_ws;
#if MK_MULTI
    for (int ph = 0; ph < 24; ++ph) { p.ph_lo = ph; p.ph_hi = ph + 1;
        hipLaunchKernelGGL(fwd_kernel, dim3(grid), dim3(NTHR), LDS_BYTES, stream, p); }
#elif defined(PROBE_K)
    p.ph_lo = 0; p.ph_hi = PROBE_K + 1;
    hipLaunchKernelGGL(fwd_kernel, dim3(grid), dim3(NTHR), LDS_BYTES, stream, p);
    (void)hipMemsetAsync((char*)d_ws + WS_CTL, 0, CTL_ZERO_BYTES, stream);
    p.ph_lo = PROBE_K2; p.ph_hi = 24;
    hipLaunchKernelGGL(fwd_kernel, dim3(grid), dim3(NTHR), LDS_BYTES, stream, p);
#else
    p.ph_lo = 0; p.ph_hi = 24;
    hipLaunchKernelGGL(fwd_kernel, dim3(grid), dim3(NTHR), LDS_BYTES, stream, p);
#endif
    const hipError_t le = hipPeekAtLastError();
    if (le != hipSuccess) fprintf(stderr, "kernel_launch: launch failed: %s\n", hipGetErrorName(le));
}
```
